# Optimizing an MI355X kernel written in HIP

```python
import jax
import jax.numpy as jnp
from jax import lax
import numpy as np

D_MODEL = 1024
BATCH = 8
SEQ = 2048
DEPTH = 1
DEC_BATCH = 128
DEC_SEQ = 4
PAST_LEN = 16384
PAGE_SIZE = 128

PLE_DIM = 256
GDN_WIDTH = D_MODEL // 2
GDN_HEAD_DIM = 128
GDN_HEADS = GDN_WIDTH // GDN_HEAD_DIM
GDN_QKV_DIM = 3 * GDN_WIDTH
GDN_CONV = 4
GDN_CHUNK = 64
SC_WIDTH = D_MODEL - GDN_WIDTH
SC_CONV = 3
D_FF = 4 * D_MODEL
EPS = 1e-6
OFF_QKV = 0
OFF_A = OFF_QKV + GDN_QKV_DIM
OFF_B = OFF_A + GDN_HEADS
OFF_Z = OFF_B + GDN_HEADS
OFF_SC_B = OFF_Z + GDN_WIDTH
OFF_SC_C = OFF_SC_B + SC_WIDTH
OFF_SC_H = OFF_SC_C + SC_WIDTH
IN_DIM = OFF_SC_H + SC_WIDTH

kernel_name = "hymba_gdn_shortconv_decode_step"


def rmsnorm(x, w):
    xf = x.astype(jnp.float32)
    y = xf * lax.rsqrt(jnp.mean(xf * xf, axis=-1, keepdims=True) + EPS)
    return (y * w.astype(jnp.float32)).astype(x.dtype)


def l2norm(x):
    xf = x.astype(jnp.float32)
    return xf * lax.rsqrt(jnp.sum(xf * xf, axis=-1, keepdims=True) + EPS)


def causal_dwconv(xp, w):
    width = w.shape[0]
    t = xp.shape[1] - (width - 1)
    out = xp[:, 0:t] * w[0]
    for j in range(1, width):
        out = out + xp[:, j:j + t] * w[j]
    return out


def gated_delta_rule(q, k, v, log_a, beta, s0):
    bsz, t, nh, dk = q.shape
    dv = v.shape[-1]
    c = GDN_CHUNK if t % GDN_CHUNK == 0 else t
    n = t // c

    def to_chunks(a):
        a = a.reshape(bsz, n, c, nh, *a.shape[3:])
        return jnp.moveaxis(a, 3, 1)

    q, k, v, log_a, beta = (to_chunks(a) for a in (q, k, v, log_a, beta))
    g = jnp.cumsum(log_a, axis=-1)
    idx = jnp.arange(c)
    lower = idx[:, None] >= idx[None, :]
    strict = idx[:, None] > idx[None, :]
    diff = g[..., :, None] - g[..., None, :]
    decay = jnp.where(lower, jnp.exp(jnp.where(lower, diff, 0.0)), 0.0)
    kk = jnp.einsum("bhnid,bhnjd->bhnij", k, k)
    a_mat = jnp.eye(c, dtype=jnp.float32) + jnp.where(strict, beta[..., :, None] * kk * decay, 0.0)
    rhs = jnp.concatenate([v * beta[..., None], k * (beta * jnp.exp(g))[..., None]], axis=-1)
    sol = lax.linalg.triangular_solve(a_mat, rhs, left_side=True, lower=True, unit_diagonal=True)
    u, w = sol[..., :dv], sol[..., dv:]
    qk = jnp.einsum("bhnid,bhnjd->bhnij", q, k) * decay

    def step(s, xs):
        q_c, k_c, u_c, w_c, g_c, qk_c = xs
        v_new = u_c - jnp.einsum("bhcd,bhde->bhce", w_c, s)
        o_c = (jnp.einsum("bhcd,bhde->bhce", q_c * jnp.exp(g_c)[..., None], s)
               + jnp.einsum("bhij,bhje->bhie", qk_c, v_new))
        g_last = g_c[..., -1:]
        s = (s * jnp.exp(g_last)[..., None]
             + jnp.einsum("bhcd,bhce->bhde", k_c * jnp.exp(g_last - g_c)[..., None], v_new))
        return s, o_c

    xs = tuple(jnp.moveaxis(a, 2, 0) for a in (q, k, u, w, g, qk))
    s_final, o = lax.scan(step, s0, xs)
    o = jnp.transpose(o, (1, 0, 3, 2, 4)).reshape(bsz, t, nh, dv)
    return o, s_final


def hybrid_layer(x, p, conv_qkv_buf, s0, conv_sc_buf, norm_mix, w_in, w_conv_qkv, a_log, dt_bias,
                 w_gdn_norm, w_conv_sc, w_out, norm_mlp, w_up, w_down, norm_ple, w_ple_gate, w_ple_proj):
    bsz, t, _ = x.shape
    h = rmsnorm(x, norm_mix)
    proj = h @ w_in
    qkv_in = jnp.concatenate([conv_qkv_buf.astype(proj.dtype), proj[..., OFF_QKV:OFF_A]], axis=1)
    qkv = jax.nn.silu(causal_dwconv(qkv_in, w_conv_qkv))
    q, k, v = jnp.split(qkv, 3, axis=-1)
    q = l2norm(q.reshape(bsz, t, GDN_HEADS, GDN_HEAD_DIM)) * (GDN_HEAD_DIM ** -0.5)
    k = l2norm(k.reshape(bsz, t, GDN_HEADS, GDN_HEAD_DIM))
    v = v.reshape(bsz, t, GDN_HEADS, GDN_HEAD_DIM).astype(jnp.float32)
    log_a = -jnp.exp(a_log.astype(jnp.float32)) * jax.nn.softplus(
        proj[..., OFF_A:OFF_B].astype(jnp.float32) + dt_bias.astype(jnp.float32))
    beta = jax.nn.sigmoid(proj[..., OFF_B:OFF_Z].astype(jnp.float32))
    o, s_new = gated_delta_rule(q, k, v, log_a, beta, s0.astype(jnp.float32))
    z = proj[..., OFF_Z:OFF_SC_B].reshape(bsz, t, GDN_HEADS, GDN_HEAD_DIM).astype(jnp.float32)
    o = (rmsnorm(o, w_gdn_norm) * jax.nn.silu(z)).reshape(bsz, t, GDN_WIDTH).astype(x.dtype)
    sc_in = jnp.concatenate([conv_sc_buf.astype(proj.dtype),
                             proj[..., OFF_SC_C:OFF_SC_H] * proj[..., OFF_SC_H:IN_DIM]], axis=1)
    y_sc = proj[..., OFF_SC_B:OFF_SC_C] * causal_dwconv(sc_in, w_conv_sc)
    x = x + jnp.concatenate([o, y_sc.astype(x.dtype)], axis=-1) @ w_out
    u_ff = jax.nn.relu(rmsnorm(x, norm_mlp) @ w_up)
    x = x + (u_ff * u_ff) @ w_down
    gate = jax.nn.sigmoid(rmsnorm(x, norm_ple) @ w_ple_gate)
    x = x + gate * (p @ w_ple_proj)
    return x, qkv_in[:, -(GDN_CONV - 1):], s_new.astype(s0.dtype), sc_in[:, -(SC_CONV - 1):]


def setup_inputs(seed: int = 0) -> dict:
    key = jax.random.key(seed)
    ks = jax.random.split(key, 24)
    f32 = jnp.float32
    nrm = lambda k_, shape, scale: jax.random.normal(k_, shape, f32) * scale
    gain = lambda k_, shape: 1.0 + 0.02 * jax.random.normal(k_, shape, f32)
    a_init = jax.random.uniform(ks[10], (DEPTH, GDN_HEADS), f32, 1.0, 16.0)
    dt = jnp.exp(jax.random.uniform(ks[11], (DEPTH, GDN_HEADS), f32, np.log(1e-3), np.log(1e-1)))
    return {
        "x_prompt": nrm(ks[0], (BATCH, SEQ, D_MODEL), 1.0),
        "x_sample": nrm(ks[1], (DEC_BATCH, DEC_SEQ, D_MODEL), 1.0),
        "state_gdn_conv": nrm(ks[2], (DEPTH, DEC_BATCH, GDN_CONV - 1, GDN_QKV_DIM), 1.0),
        "state_gdn": nrm(ks[3], (DEPTH, DEC_BATCH, GDN_HEADS, GDN_HEAD_DIM, GDN_HEAD_DIM), 0.3),
        "state_sc_conv": nrm(ks[4], (DEPTH, DEC_BATCH, SC_CONV - 1, SC_WIDTH), 1.0),
        "p_prompt": nrm(ks[5], (DEPTH, BATCH, SEQ, PLE_DIM), 1.0),
        "p_sample": nrm(ks[6], (DEPTH, DEC_BATCH, DEC_SEQ, PLE_DIM), 1.0),
        "norm_mix": gain(ks[7], (DEPTH, D_MODEL)),
        "w_in": nrm(ks[8], (DEPTH, D_MODEL, IN_DIM), D_MODEL ** -0.5),
        "w_conv_qkv": nrm(ks[9], (DEPTH, GDN_CONV, GDN_QKV_DIM), GDN_CONV ** -0.5),
        "a_log": jnp.log(a_init),
        "dt_bias": dt + jnp.log(-jnp.expm1(-dt)),
        "w_gdn_norm": gain(ks[12], (DEPTH, GDN_HEAD_DIM)),
        "w_conv_sc": nrm(ks[13], (DEPTH, SC_CONV, SC_WIDTH), SC_CONV ** -0.5),
        "w_out": nrm(ks[14], (DEPTH, D_MODEL, D_MODEL), D_MODEL ** -0.5),
        "norm_mlp": gain(ks[15], (DEPTH, D_MODEL)),
        "w_up": nrm(ks[16], (DEPTH, D_MODEL, D_FF), D_MODEL ** -0.5),
        "w_down": nrm(ks[17], (DEPTH, D_FF, D_MODEL), D_FF ** -0.5),
        "norm_ple": gain(ks[18], (DEPTH, D_MODEL)),
        "w_ple_gate": nrm(ks[19], (DEPTH, D_MODEL, D_MODEL), D_MODEL ** -0.5),
        "w_ple_proj": nrm(ks[20], (DEPTH, PLE_DIM, D_MODEL), PLE_DIM ** -0.5),
        "norm_f": gain(ks[21], (D_MODEL,)),
    }


def reference(x_prompt, x_sample, state_gdn_conv, state_gdn, state_sc_conv, p_prompt, p_sample,
              norm_mix, w_in, w_conv_qkv, a_log, dt_bias, w_gdn_norm, w_conv_sc, w_out,
              norm_mlp, w_up, w_down, norm_ple, w_ple_gate, w_ple_proj, norm_f):
    bp = x_prompt.shape[0]
    dt_ = x_prompt.dtype
    zero_conv_qkv = jnp.zeros((bp, GDN_CONV - 1, GDN_QKV_DIM), dt_)
    zero_s = jnp.zeros((bp, GDN_HEADS, GDN_HEAD_DIM, GDN_HEAD_DIM), dt_)
    zero_conv_sc = jnp.zeros((bp, SC_CONV - 1, SC_WIDTH), dt_)
    hp, hs = x_prompt, x_sample
    pc, ps, psc, sc, ss, ssc = [], [], [], [], [], []
    for i in range(DEPTH):
        wts = (norm_mix[i], w_in[i], w_conv_qkv[i], a_log[i], dt_bias[i], w_gdn_norm[i], w_conv_sc[i],
               w_out[i], norm_mlp[i], w_up[i], w_down[i], norm_ple[i], w_ple_gate[i], w_ple_proj[i])
        hp, c1, s1, c2 = hybrid_layer(hp, p_prompt[i], zero_conv_qkv, zero_s, zero_conv_sc, *wts)
        hs, c3, s3, c4 = hybrid_layer(hs, p_sample[i], state_gdn_conv[i], state_gdn[i], state_sc_conv[i], *wts)
        pc.append(c1); ps.append(s1); psc.append(c2)
        sc.append(c3); ss.append(s3); ssc.append(c4)
    y_prompt = rmsnorm(hp, norm_f)
    y_sample = rmsnorm(hs, norm_f)
    return (y_prompt, y_sample, jnp.stack(pc), jnp.stack(ps), jnp.stack(psc),
            jnp.stack(sc), jnp.stack(ss), jnp.stack(ssc))
```

```cpp
#include <hip/hip_runtime.h>
#include <hip/hip_cooperative_groups.h>
#include <cstdio>
namespace cg = cooperative_groups;
namespace pg8 {
#define PG8_LAS __attribute__((address_space(3)))
typedef unsigned short bf16_t;
typedef short bf16x8 __attribute__((ext_vector_type(8)));
typedef float f32x4 __attribute__((ext_vector_type(4)));
typedef unsigned u32x4 __attribute__((ext_vector_type(4)));
constexpr int BM = 256, BK = 64, HALF = 128, HTB = HALF * BK * 2  , STAGE_BYTES = 8 * HTB, NXCD = 8, WGM = 8;

__host__ __device__ __forceinline__ int lds_byte(int r, int c) { const int st = (r >> 4) * 2 + (c >> 5), rr = r & 15, cc = c & 31, ob = rr * 64 + cc * 2; return st * 1024 + (ob ^ (((ob >> 9) & 1) << 5)); }
__host__ __device__ __forceinline__ void stage_rc(int b, int& R, int& C) { const int st = b / 1024, sb = b % 1024, swz = sb ^ (((sb >> 9) & 1) << 5); R = (st >> 1) * 16 + swz / 64; C = (st & 1) * 32 + (swz % 64) / 2; }
__host__ __device__ __forceinline__ int perm32(int rho) { const int n = rho >> 4, i = rho & 15; return 8 * (i >> 2) + 4 * n + (i & 3); }

struct Unit { int pm, pn; };
struct Gemm { const bf16_t* A; const bf16_t* Bt; int M, N, K; };

struct StaticOrder {
    int nM, nN, nwg, G, c;
    __host__ __device__ void init(int M, int N, int G_, int c_) { nM = M / BM; nN = N / BM; nwg = nM * nN; G = G_; c = c_; }
    __host__ __device__ bool next(int i, Unit& u) const {
        const long L = (long)i * G + c; if (L >= nwg) return false;
        int wgid = (int)L; { const int q = nwg / NXCD, r = nwg % NXCD, xcd = wgid % NXCD, off = wgid / NXCD; wgid = (xcd < r ? xcd * (q + 1) : r * (q + 1) + (xcd - r) * q) + off; }
        const int nig = WGM * nN, gid = wgid / nig, fm = gid * WGM, gsz = (nM - fm) < WGM ? (nM - fm) : WGM;
        u.pm = fm + ((wgid % nig) % gsz); u.pn = (wgid % nig) / gsz; return true;
    }
    __device__ __forceinline__ void a_ready(const Unit&) const {}
    __device__ __forceinline__ void done(const Unit&) const {}
};
template <class Epi, class Sched, bool STAMP = false>
__device__ __forceinline__ void gemm_phase(PG8_LAS unsigned char* lds, const Gemm g, const Sched& S, const Epi& E, unsigned long long* stamps) {
    const int tid = threadIdx.x, wid = __builtin_amdgcn_readfirstlane(tid >> 6), lane = tid & 63, wr = wid >> 2, wc = wid & 3, fr = lane & 15, fq = lane >> 4;
    const int K = g.K, nt = K / BK;
    int ts_lo = 0, ts_hi = 0, nts = 0; const unsigned long long rt_entry = STAMP ? (unsigned long long)wall_clock64() : 0ull;
#define PG8_STAMP() do { if (STAMP && wid == 0 && nts < 64) { const unsigned long long _c = (unsigned long long)clock64(); \
        ts_lo = (lane == nts) ? (int)(unsigned)_c : ts_lo; ts_hi = (lane == nts) ? (int)(unsigned)(_c >> 32) : ts_hi; ++nts; } } while (0)
    PG8_STAMP();
    unsigned voffA[2], voffB[2];
#pragma unroll
    for (int i = 0; i < 2; ++i) { int R, C; stage_rc(tid * 16 + i * 8192, R, C); const int Rb = Epi::PERM ? ((R & ~31) + perm32(R & 31)) : R;
        voffA[i] = (unsigned)(R * K + C) * 2u; voffB[i] = (unsigned)(Rb * K + C) * 2u; }
    const size_t kstep = (size_t)(BK * 2);
    const size_t hstep = (size_t)HALF * K * 2;
    const size_t tstep = 2 * hstep;
    const unsigned ldsw = (unsigned)wid * 1024u;
    const int aoff = lds_byte(wr * 64 + fr, fq * 8), boff = lds_byte(wc * 32 + fr, fq * 8);
#define PG8_SA(b, h) (((b) * 2 + (h)) * HTB)
#define PG8_SB(b, h) ((4 + (b) * 2 + (h)) * HTB)
#define PG8_STAGE(bufoff, gbase, voff) do { _Pragma("unroll") for (int _i = 0; _i < 2; ++_i) \
        __builtin_amdgcn_global_load_lds((const unsigned*)((const char*)(gbase) + (voff)[_i]), (PG8_LAS unsigned*)(lds + (bufoff) + ldsw + _i * 8192), 16, 0, 0); } while (0)
#define PG8_LDA(dst, b, h) do { _Pragma("unroll") for (int m = 0; m < 4; ++m) _Pragma("unroll") for (int k = 0; k < 2; ++k) dst[m][k] = *(const PG8_LAS bf16x8*)(lds + PG8_SA(b, h) + aoff + m * 2048 + k * 1024); } while (0)
#define PG8_LDB(dst, b, h) do { _Pragma("unroll") for (int n = 0; n < 2; ++n) _Pragma("unroll") for (int k = 0; k < 2; ++k) dst[n][k] = *(const PG8_LAS bf16x8*)(lds + PG8_SB(b, h) + boff + n * 2048 + k * 1024); } while (0)
#define PG8_MMA(ai, bj, At, Bt) do { __builtin_amdgcn_s_setprio(1); _Pragma("unroll") for (int m = 0; m < 4; ++m) _Pragma("unroll") for (int n = 0; n < 2; ++n) _Pragma("unroll") for (int k = 0; k < 2; ++k) \
        acc[ai][bj][m][n] = __builtin_amdgcn_mfma_f32_16x16x32_bf16(Bt[n][k], At[m][k], acc[ai][bj][m][n], 0, 0, 0); __builtin_amdgcn_s_setprio(0); } while (0)
#define PG8_WAIT_V(n) asm volatile("s_waitcnt vmcnt(" #n ")" ::: "memory")
#define PG8_WAIT_L(n) asm volatile("s_waitcnt lgkmcnt(" #n ")" ::: "memory")
#define PG8_BAR __builtin_amdgcn_s_barrier()
#define PG8_SCHED __builtin_amdgcn_sched_barrier(0)
    Unit cur, nxt; int ui = 0;
    if (!S.next(0, cur)) return;
    f32x4 acc[2][2][4][2];
#pragma unroll
    for (int a = 0; a < 2; ++a)
#pragma unroll
        for (int b = 0; b < 2; ++b)
#pragma unroll
            for (int m = 0; m < 4; ++m)
#pragma unroll
                for (int n = 0; n < 2; ++n) acc[a][b][m][n] = (f32x4){0.f, 0.f, 0.f, 0.f};
    bf16x8 At[4][2], B0[2][2], B1[2][2];
    const char* cA = (const char*)g.A + (size_t)cur.pm * tstep; const char* cB = (const char*)g.Bt + (size_t)cur.pn * tstep;
    S.a_ready(cur);
    PG8_STAGE(PG8_SB(0, 0), cB, voffB); PG8_STAGE(PG8_SA(0, 0), cA, voffA); PG8_STAGE(PG8_SB(0, 1), cB + hstep, voffB); PG8_STAGE(PG8_SA(0, 1), cA + hstep, voffA);
    if (wr == 1) PG8_BAR;
    PG8_WAIT_V(4); PG8_BAR;
    PG8_STAGE(PG8_SB(1, 0), cB + kstep, voffB); PG8_STAGE(PG8_SA(1, 0), cA + kstep, voffA); PG8_STAGE(PG8_SB(1, 1), cB + hstep + kstep, voffB);
    PG8_WAIT_V(6); PG8_BAR;
    PG8_STAMP();
    for (;;) {
        const bool has_next = S.next(ui + 1, nxt);
        const char* nA = has_next ? (const char*)g.A + (size_t)nxt.pm * tstep : cA; const char* nB = has_next ? (const char*)g.Bt + (size_t)nxt.pn * tstep : cB;
        for (int t = 0; t < nt; t += 2) {
            const bool last = (t == nt - 2);
            const char* a1 = cA + (size_t)(t + 1) * kstep;
            const char* a2 = last ? nA : cA + (size_t)(t + 2) * kstep; const char* b2 = last ? nB : cB + (size_t)(t + 2) * kstep;
            const char* a3 = a2 + kstep; const char* b3 = b2 + kstep;
            if (last && has_next) S.a_ready(nxt);
            PG8_LDB(B0, 0, 0); PG8_SCHED; PG8_LDA(At, 0, 0); PG8_STAGE(PG8_SA(1, 1), a1 + hstep, voffA);
            PG8_WAIT_L(8); PG8_BAR; PG8_WAIT_L(0); PG8_MMA(0, 0, At, B0); PG8_BAR; PG8_SCHED;
            PG8_LDB(B1, 0, 1); PG8_STAGE(PG8_SB(0, 0), b2, voffB);
            PG8_BAR; PG8_WAIT_L(0); PG8_MMA(0, 1, At, B1); PG8_BAR;
            PG8_LDA(At, 0, 1); PG8_STAGE(PG8_SA(0, 0), a2, voffA);
            PG8_BAR; PG8_WAIT_L(0); PG8_MMA(1, 0, At, B0); PG8_BAR; PG8_SCHED;
            PG8_STAGE(PG8_SB(0, 1), b2 + hstep, voffB);
            PG8_WAIT_V(6); PG8_BAR; PG8_MMA(1, 1, At, B1); PG8_BAR;
            PG8_LDB(B0, 1, 0); PG8_SCHED; PG8_LDA(At, 1, 0); PG8_STAGE(PG8_SA(0, 1), a2 + hstep, voffA);
            PG8_WAIT_L(8); PG8_BAR; PG8_WAIT_L(0); PG8_MMA(0, 0, At, B0); PG8_BAR; PG8_SCHED;
            PG8_LDB(B1, 1, 1); PG8_STAGE(PG8_SB(1, 0), b3, voffB);
            PG8_BAR; PG8_WAIT_L(0); PG8_MMA(0, 1, At, B1); PG8_BAR;
            PG8_LDA(At, 1, 1); PG8_STAGE(PG8_SA(1, 0), a3, voffA);
            PG8_BAR; PG8_WAIT_L(0); PG8_MMA(1, 0, At, B0); PG8_BAR; PG8_SCHED;
            PG8_STAGE(PG8_SB(1, 1), b3 + hstep, voffB);
            PG8_WAIT_V(6); PG8_BAR; PG8_MMA(1, 1, At, B1); PG8_BAR;
        }
        PG8_STAMP();
        if constexpr (!Epi::AFTER_DRAIN) { E(acc, cur, wr, wc, fr, fq); S.done(cur); }
        PG8_STAMP();
        if (!has_next) break;
#pragma unroll
        for (int a = 0; a < 2; ++a)
#pragma unroll
            for (int b = 0; b < 2; ++b)
#pragma unroll
                for (int m = 0; m < 4; ++m)
#pragma unroll
                    for (int n = 0; n < 2; ++n) acc[a][b][m][n] = (f32x4){0.f, 0.f, 0.f, 0.f};
        cur = nxt; cA = nA; cB = nB; ++ui;
    }
    PG8_WAIT_V(0);
    if (wr == 0) PG8_BAR;
    PG8_BAR;
    if constexpr (Epi::AFTER_DRAIN) { E.fused(acc, cur, wr, wc, fr, fq, lds, wid, lane); S.done(cur); }
    PG8_STAMP();
    if (STAMP && wid == 0) { stamps[lane] = lane < nts ? (((unsigned long long)(unsigned)ts_hi << 32) | (unsigned)ts_lo) : 0ull;
        if (lane == 62) stamps[62] = rt_entry; if (lane == 63) stamps[63] = (unsigned long long)wall_clock64(); }
#undef PG8_STAMP
#undef PG8_SA
#undef PG8_SB
#undef PG8_STAGE
#undef PG8_LDA
#undef PG8_LDB
#undef PG8_MMA
#undef PG8_WAIT_V
#undef PG8_WAIT_L
#undef PG8_BAR
#undef PG8_SCHED
}
}
#define LAS __attribute__((address_space(3)))
using pg8::bf16_t; using pg8::bf16x8; using pg8::f32x4; using pg8::u32x4;
typedef float f32x16 __attribute__((ext_vector_type(16)));
typedef float f32x2v __attribute__((ext_vector_type(2)));
typedef __bf16 bf16x2v __attribute__((ext_vector_type(2)));
typedef unsigned u32x2 __attribute__((ext_vector_type(2)));
#define DI __device__ __forceinline__
#define MFMA32(a, b, c) __builtin_amdgcn_mfma_f32_32x32x16_bf16((a), (b), (c), 0, 0, 0)

constexpr int D = 1024, NTP = 16384, NTS = 512, NT = NTP + NTS;
constexpr int NPROJ = 3584, INDIM = 3592, DFF = 4096, PLE = 256;
constexpr float EPS = 1e-6f;
constexpr int NTHREADS = 512;
constexpr int LDS_BYTES = 131072;
constexpr size_t WS_WIN = 0;
constexpr size_t WS_WOUT = WS_WIN + (size_t)NPROJ * D * 2;
constexpr size_t WS_WUP = WS_WOUT + (size_t)D * D * 2;
constexpr size_t WS_WDN = WS_WUP + (size_t)DFF * D * 2;
constexpr size_t WS_WG = WS_WDN + (size_t)D * DFF * 2;
constexpr size_t WS_WP = WS_WG + (size_t)D * D * 2;
constexpr size_t WS_CTL = WS_WP + (size_t)D * PLE * 2;
constexpr size_t CTL_RS0 = 0, CTL_SS1 = NT, CTL_SS2 = 2 * NT, CTL_SS3 = 3 * NT, CTL_LA = 4 * NT, CTL_BETA = 8 * NT, CTL_GL = 12 * NT, CTL_FLOATS = 12 * NT + 1024;
constexpr size_t WS_PB = WS_CTL + ((CTL_FLOATS * 4 + 4095) / 4096) * 4096;
constexpr size_t WS_A = WS_PB + (size_t)NT * PLE * 2;
constexpr size_t WS_B = WS_A + (size_t)NT * D * 2;
constexpr size_t WS_C = WS_B + (size_t)NT * DFF * 2;
constexpr size_t WS_END = WS_C + (size_t)NT * D * 2;
constexpr size_t OFF_Y = 0, OFF_GCP = 17301504, OFF_GP = 17338368, OFF_SCP = 17862656, OFF_GCS = 17870848, OFF_GS = 18460672, OFF_SCS = 26849280;

struct Ctx {
    const float* x_prompt; const float* x_sample; const float* state_gdn_conv; const float* state_gdn; const float* state_sc_conv; const float* p_prompt; const float* p_sample;
    const float* norm_mix; const float* w_in; const float* w_conv_qkv; const float* a_log; const float* dt_bias; const float* w_gdn_norm; const float* w_conv_sc; const float* w_out;
    const float* norm_mlp; const float* w_up; const float* w_down; const float* norm_ple; const float* w_ple_gate; const float* w_ple_proj; const float* norm_f;
    float* out; unsigned char* ws; int ph_lo, ph_hi;
};

DI unsigned pk2(float lo, float hi) { f32x2v v = {lo, hi}; return __builtin_bit_cast(unsigned, __builtin_convertvector(v, bf16x2v)); }
DI bf16_t f2bf(float f) { return (bf16_t)(pk2(f, 0.f) & 0xffffu); }
DI float bf2f(bf16_t b) { return __uint_as_float((unsigned)b << 16); }
DI float bflo(unsigned u) { return __uint_as_float(u << 16); }
DI float bfhi(unsigned u) { return __uint_as_float(u & 0xffff0000u); }
DI void unpack8(const u32x4 v, float* f) { f[0] = bflo(v.x); f[1] = bfhi(v.x); f[2] = bflo(v.y); f[3] = bfhi(v.y); f[4] = bflo(v.z); f[5] = bfhi(v.z); f[6] = bflo(v.w); f[7] = bfhi(v.w); }
DI u32x4 pack8(const float* f) { u32x4 w; w.x = pk2(f[0], f[1]); w.y = pk2(f[2], f[3]); w.z = pk2(f[4], f[5]); w.w = pk2(f[6], f[7]); return w; }
DI int crow(int reg, int h) { return (reg & 3) + 8 * (reg >> 2) + 4 * h; }
DI int swap23(int p) { return (p & ~12) | ((p & 4) << 1) | ((p & 8) >> 1); }
DI bf16x8 pack_step(const f32x16& x, int s) {
    u32x4 p; p.x = pk2(x[8 * s], x[8 * s + 1]); p.y = pk2(x[8 * s + 2], x[8 * s + 3]); p.z = pk2(x[8 * s + 4], x[8 * s + 5]); p.w = pk2(x[8 * s + 6], x[8 * s + 7]);
    return __builtin_bit_cast(bf16x8, p);
}
DI float sigmoidf_(float x) { return 1.0f / (1.0f + __expf(-x)); }
DI float siluf_(float x) { return x / (1.0f + __expf(-x)); }

struct EpiProj {
    static constexpr bool PERM = true, AFTER_DRAIN = false;
    bf16_t* O; int ldc; const float* rs;
    DI void operator()(const f32x4 (&acc)[2][2][4][2], const pg8::Unit& u, int wr, int wc, int fr, int fq) const {
        const int row0 = u.pm * 256 + wr * 64 + fr, col0 = u.pn * 256 + wc * 32 + 8 * fq;
#pragma unroll
        for (int ai = 0; ai < 2; ++ai)
#pragma unroll
            for (int m = 0; m < 4; ++m) { const int row = row0 + ai * 128 + m * 16; const float r = rs ? rs[row] : 1.0f; bf16_t* rowp = O + (size_t)row * ldc + col0;
#pragma unroll
                for (int bj = 0; bj < 2; ++bj) { const f32x4 v0 = acc[ai][bj][m][0] * r, v1 = acc[ai][bj][m][1] * r;
                    u32x4 w; w.x = pk2(v0[0], v0[1]); w.y = pk2(v0[2], v0[3]); w.z = pk2(v1[0], v1[1]); w.w = pk2(v1[2], v1[3]);
                    *(u32x4*)(rowp + bj * 128) = w; } }
    }
};
struct EpiUp {
    static constexpr bool PERM = true, AFTER_DRAIN = false;
    bf16_t* O; const float* ss;
    DI void operator()(const f32x4 (&acc)[2][2][4][2], const pg8::Unit& u, int wr, int wc, int fr, int fq) const {
        const int row0 = u.pm * 256 + wr * 64 + fr, col0 = u.pn * 256 + wc * 32 + 8 * fq;
#pragma unroll
        for (int ai = 0; ai < 2; ++ai)
#pragma unroll
            for (int m = 0; m < 4; ++m) { const int row = row0 + ai * 128 + m * 16; const float r = rsqrtf(ss[row] * (1.0f / 1024.0f) + EPS); bf16_t* rowp = O + (size_t)row * DFF + col0;
#pragma unroll
                for (int bj = 0; bj < 2; ++bj) { f32x4 v0 = acc[ai][bj][m][0] * r, v1 = acc[ai][bj][m][1] * r;
#pragma unroll
                    for (int j = 0; j < 4; ++j) { v0[j] = fmaxf(v0[j], 0.f); v0[j] *= v0[j]; v1[j] = fmaxf(v1[j], 0.f); v1[j] *= v1[j]; }
                    u32x4 w; w.x = pk2(v0[0], v0[1]); w.y = pk2(v0[2], v0[3]); w.z = pk2(v1[0], v1[1]); w.w = pk2(v1[2], v1[3]);
                    *(u32x4*)(rowp + bj * 128) = w; } }
    }
};
template <int MODE> struct EpiRes {
    static constexpr bool PERM = true, AFTER_DRAIN = false;
    const float* xp; const float* xs; float* X; bf16_t* XB; float* ssn; const float* ssp; const bf16_t* PP;
    DI void operator()(const f32x4 (&acc)[2][2][4][2], const pg8::Unit& u, int wr, int wc, int fr, int fq) const {
        const int row0 = u.pm * 256 + wr * 64 + fr, col0 = u.pn * 256 + wc * 32 + 8 * fq;
#pragma unroll
        for (int ai = 0; ai < 2; ++ai)
#pragma unroll
            for (int m = 0; m < 4; ++m) { const int row = row0 + ai * 128 + m * 16; const size_t off = (size_t)row * D + col0;
                const float* bp = (MODE == 0) ? (row < NTP ? xp + off : xs + (off - (size_t)NTP * D)) : X + off;
                float r = 1.f; if (MODE == 2) r = rsqrtf(ssp[row] * (1.0f / 1024.0f) + EPS);
                float sq = 0.f;
#pragma unroll
                for (int bj = 0; bj < 2; ++bj) { f32x4 v0 = acc[ai][bj][m][0], v1 = acc[ai][bj][m][1];
                    if (MODE == 2) { const u32x4 pq = *(const u32x4*)(PP + off + bj * 128); float pf[8]; unpack8(pq, pf);
#pragma unroll
                        for (int j = 0; j < 4; ++j) { v0[j] = sigmoidf_(v0[j] * r) * pf[j]; v1[j] = sigmoidf_(v1[j] * r) * pf[4 + j]; } }
                    const f32x4 b0 = *(const f32x4*)(bp + bj * 128), b1 = *(const f32x4*)(bp + bj * 128 + 4);
                    v0 += b0; v1 += b1;
                    *(f32x4*)(X + off + bj * 128) = v0; *(f32x4*)(X + off + bj * 128 + 4) = v1;
                    if (MODE != 2) { u32x4 w; w.x = pk2(v0[0], v0[1]); w.y = pk2(v0[2], v0[3]); w.z = pk2(v1[0], v1[1]); w.w = pk2(v1[2], v1[3]); *(u32x4*)(XB + off + bj * 128) = w; }
                    sq += (v0[0] * v0[0] + v0[1] * v0[1]) + (v0[2] * v0[2] + v0[3] * v0[3]) + (v1[0] * v1[0] + v1[1] * v1[1]) + (v1[2] * v1[2] + v1[3] * v1[3]); }
                sq += __shfl_xor(sq, 16); sq += __shfl_xor(sq, 32);
                if (fq == 0) atomicAdd(ssn + row, sq); }
    }
};
DI void transpose_tile(const float* W, int ldw, int k0, int n0src, const float* nrm, bf16_t* Wt, int K, int n0dst, LAS float* tile) {
    const int tid = threadIdx.x;
#pragma unroll
    for (int i = 0; i < 8; ++i) { const int kk = i * 8 + (tid >> 6), nn = tid & 63; float v = W[(size_t)(k0 + kk) * ldw + n0src + nn]; if (nrm) v *= nrm[k0 + kk]; tile[kk * 65 + nn] = v; }
    __syncthreads();
    { const int nn = tid >> 3, kq = tid & 7; float f[8];
#pragma unroll
      for (int e = 0; e < 8; ++e) f[e] = tile[(kq * 8 + e) * 65 + nn];
      *(u32x4*)(Wt + (size_t)(n0dst + nn) * K + k0 + kq * 8) = pack8(f); }
    __syncthreads();
}
DI void p0_phase(const Ctx& c, LAS unsigned char* lds) {
    const int tid = threadIdx.x, lane = tid & 63, wid = tid >> 6;
    unsigned char* ws = c.ws;
    float* ctl = (float*)(ws + WS_CTL);
    bf16_t* XB = (bf16_t*)(ws + WS_A); bf16_t* PB = (bf16_t*)(ws + WS_PB);
    LAS float* wab = (LAS float*)lds;
    for (int i = tid; i < 1024 * 8; i += NTHREADS) { const int k = i >> 3, j = i & 7; wab[i] = c.w_in[(size_t)k * INDIM + 1536 + j] * c.norm_mix[k]; }
    __syncthreads();
    for (int row = blockIdx.x * 8 + wid; row < NT; row += gridDim.x * 8) {
        const float* xr = row < NTP ? c.x_prompt + (size_t)row * D : c.x_sample + (size_t)(row - NTP) * D;
        const float* pr = row < NTP ? c.p_prompt + (size_t)row * PLE : c.p_sample + (size_t)(row - NTP) * PLE;
        float ss = 0.f, dot[8];
#pragma unroll
        for (int j = 0; j < 8; ++j) dot[j] = 0.f;
#pragma unroll 4
        for (int i = 0; i < 16; ++i) { const int k = i * 64 + lane; const float xv = xr[k]; ss += xv * xv;
            const f32x4 w0 = *(const LAS f32x4*)(wab + k * 8), w1 = *(const LAS f32x4*)(wab + k * 8 + 4);
            dot[0] += xv * w0[0]; dot[1] += xv * w0[1]; dot[2] += xv * w0[2]; dot[3] += xv * w0[3]; dot[4] += xv * w1[0]; dot[5] += xv * w1[1]; dot[6] += xv * w1[2]; dot[7] += xv * w1[3]; }
#pragma unroll
        for (int o = 32; o >= 1; o >>= 1) { ss += __shfl_xor(ss, o);
#pragma unroll
            for (int j = 0; j < 8; ++j) dot[j] += __shfl_xor(dot[j], o); }
        const float rs = rsqrtf(ss * (1.0f / 1024.0f) + EPS);
#pragma unroll
        for (int i = 0; i < 4; ++i) { const int k0 = i * 256 + lane * 4; const f32x4 v = *(const f32x4*)(xr + k0); u32x2 w; w.x = pk2(v[0], v[1]); w.y = pk2(v[2], v[3]); *(u32x2*)(XB + (size_t)row * D + k0) = w; }
        { const f32x4 v = *(const f32x4*)(pr + lane * 4); u32x2 w; w.x = pk2(v[0], v[1]); w.y = pk2(v[2], v[3]); *(u32x2*)(PB + (size_t)row * PLE + lane * 4) = w; }
        if (lane == 0) { ctl[CTL_RS0 + row] = rs; ctl[CTL_SS1 + row] = 0.f; ctl[CTL_SS2 + row] = 0.f; ctl[CTL_SS3 + row] = 0.f; }
        if (lane < 4) { const float da = lane == 0 ? dot[0] : lane == 1 ? dot[1] : lane == 2 ? dot[2] : dot[3]; const float db = lane == 0 ? dot[4] : lane == 1 ? dot[5] : lane == 2 ? dot[6] : dot[7];
            const float xa = da * rs + c.dt_bias[lane]; const float sp = xa > 20.f ? xa : log1pf(__expf(xa));
            ctl[CTL_LA + (size_t)row * 4 + lane] = -__expf(c.a_log[lane]) * sp; ctl[CTL_BETA + (size_t)row * 4 + lane] = sigmoidf_(db * rs); }
    }
    __syncthreads();
    LAS float* tile = (LAS float*)lds;
    for (int tl = blockIdx.x; tl < 3520; tl += gridDim.x) {
        int t = tl;
        if (t < 896) { const int kt = t / 56, nt = t % 56, n0 = nt * 64; transpose_tile(c.w_in, INDIM, kt * 64, n0 < 1536 ? n0 : n0 + 8, c.norm_mix, (bf16_t*)(ws + WS_WIN), D, n0, tile); continue; }
        t -= 896;
        if (t < 256) { transpose_tile(c.w_out, D, (t / 16) * 64, (t % 16) * 64, nullptr, (bf16_t*)(ws + WS_WOUT), D, (t % 16) * 64, tile); continue; }
        t -= 256;
        if (t < 1024) { transpose_tile(c.w_up, DFF, (t / 64) * 64, (t % 64) * 64, c.norm_mlp, (bf16_t*)(ws + WS_WUP), D, (t % 64) * 64, tile); continue; }
        t -= 1024;
        if (t < 1024) { transpose_tile(c.w_down, D, (t / 16) * 64, (t % 16) * 64, nullptr, (bf16_t*)(ws + WS_WDN), DFF, (t % 16) * 64, tile); continue; }
        t -= 1024;
        if (t < 256) { transpose_tile(c.w_ple_gate, D, (t / 16) * 64, (t % 16) * 64, c.norm_ple, (bf16_t*)(ws + WS_WG), D, (t % 16) * 64, tile); continue; }
        t -= 256;
        transpose_tile(c.w_ple_proj, D, (t / 16) * 64, (t % 16) * 64, nullptr, (bf16_t*)(ws + WS_WP), PLE, (t % 16) * 64, tile);
    }
}

constexpr int L_QH = 0, L_KH = 17408, L_RT = 34816, L_AM = 71680, L_TB = 89088, L_G = 98304;
DI void prep_chunk(const Ctx& c, LAS unsigned char* lds, int ch) {
    const int tid = threadIdx.x, lane = tid & 63, wid = tid >> 6;
    const int h = ch & 3, n = (ch >> 2) & 31, b = ch >> 7;
    const int row0 = b * 2048 + n * 64;
    float* ctl = (float*)(c.ws + WS_CTL);
    const bf16_t* PROJ = (const bf16_t*)(c.ws + WS_B);
    bf16_t* QP = (bf16_t*)c.out + (size_t)ch * 8192; bf16_t* WP = (bf16_t*)c.out + (size_t)(1024 + ch) * 8192; bf16_t* KTP = (bf16_t*)c.out + (size_t)(2048 + ch) * 8192;
    bf16_t* UT = (bf16_t*)(c.ws + WS_C) + (size_t)ch * 8192; bf16_t* QKP = (bf16_t*)(c.ws + WS_C) + (size_t)1024 * 8192 + (size_t)ch * 4096;
    LAS float* G = (LAS float*)(lds + L_G); LAS float* BT = G + 64;
    if (wid == 0) {
        float la = ctl[CTL_LA + (size_t)(row0 + lane) * 4 + h];
#pragma unroll
        for (int o = 1; o < 64; o <<= 1) { const float t = __shfl_up(la, o); if (lane >= o) la += t; }
        G[lane] = la; BT[lane] = ctl[CTL_BETA + (size_t)(row0 + lane) * 4 + h];
        if (lane == 63) ctl[CTL_GL + ch] = la;
    }
    __syncthreads();
    {
        const int tok = tid >> 3, cg8 = tid & 7;
        const float g = G[tok], bt = BT[tok], glast = G[63];
        const float eg = __expf(g), egl = __expf(glast - g);
        const int t_abs = n * 64 + tok;
#ifdef NOCONV
        for (int ten = 0; ten < 0; ++ten) {
#else
#pragma unroll 1
        for (int ten = 0; ten < 3; ++ten) {
#endif
            const int colbase = ten * 512 + h * 128 + cg8 * 16;
            float a[16];
#pragma unroll
            for (int e = 0; e < 16; ++e) a[e] = 0.f;
#pragma unroll
            for (int j = 0; j < 4; ++j) {
                const int tt = t_abs - 3 + j;
                if (tt >= 0) {
                    const bf16_t* src = PROJ + (size_t)(b * 2048 + tt) * NPROJ + colbase;
                    float x[16]; unpack8(*(const u32x4*)src, x); unpack8(*(const u32x4*)(src + 8), x + 8);
                    const float* wj = c.w_conv_qkv + j * 1536 + colbase;
#pragma unroll
                    for (int q = 0; q < 4; ++q) { const f32x4 w = *(const f32x4*)(wj + 4 * q); a[4 * q] += x[4 * q] * w[0]; a[4 * q + 1] += x[4 * q + 1] * w[1]; a[4 * q + 2] += x[4 * q + 2] * w[2]; a[4 * q + 3] += x[4 * q + 3] * w[3]; }
                }
            }
#pragma unroll
            for (int e = 0; e < 16; ++e) a[e] = siluf_(a[e]);
            if (ten < 2) { float ss = 0.f;
#pragma unroll
                for (int e = 0; e < 16; ++e) ss += a[e] * a[e];
                ss += __shfl_xor(ss, 1); ss += __shfl_xor(ss, 2); ss += __shfl_xor(ss, 4);
                const float sc = rsqrtf(ss + EPS) * (ten == 0 ? 0.08838834764831845f : 1.0f);
#pragma unroll
                for (int e = 0; e < 16; ++e) a[e] *= sc; }
            if (ten == 0) {
                LAS unsigned char* q = lds + L_QH + tok * 272 + cg8 * 32;
                *(LAS u32x4*)q = pack8(a); *(LAS u32x4*)(q + 16) = pack8(a + 8);
                float p[16];
#pragma unroll
                for (int e = 0; e < 16; ++e) p[swap23(e)] = a[e] * eg;
                bf16_t* dst = QP + tok * 128 + cg8 * 16; *(u32x4*)dst = pack8(p); *(u32x4*)(dst + 8) = pack8(p + 8);
            } else if (ten == 1) {
                LAS unsigned char* q = lds + L_KH + tok * 272 + cg8 * 32;
                *(LAS u32x4*)q = pack8(a); *(LAS u32x4*)(q + 16) = pack8(a + 8);
                const float f = bt * eg; const int pt = swap23(tok);
#pragma unroll
                for (int e = 0; e < 16; ++e) { *(LAS bf16_t*)(lds + L_RT + (128 + cg8 * 16 + e) * 144 + tok * 2) = f2bf(a[e] * f); KTP[(cg8 * 16 + e) * 64 + pt] = f2bf(a[e] * egl); }
            } else {
#pragma unroll
                for (int e = 0; e < 16; ++e) *(LAS bf16_t*)(lds + L_RT + (cg8 * 16 + e) * 144 + tok * 2) = f2bf(a[e] * bt);
            }
        }
    }
    __syncthreads();
    {
        int r = lane & 31, hh = lane >> 5; asm volatile("" : "+v"(r), "+v"(hh));
        const int blk = wid & 3, I = (blk == 1 || blk == 2) ? 1 : 0, J = (blk == 2 || blk == 3) ? 1 : 0; const bool isq = wid >= 4;
        f32x16 x;
#pragma unroll
        for (int i = 0; i < 16; ++i) x[i] = 0.f;
        if (blk != 3) {
            LAS unsigned char* Ab = lds + (isq ? L_QH : L_KH) + (32 * I + r) * 272 + hh * 16; LAS unsigned char* Bb = lds + L_KH + (32 * J + r) * 272 + hh * 16;
#pragma unroll
            for (int s = 0; s < 8; ++s) { const bf16x8 av = *(LAS bf16x8*)(Ab + s * 32), bv = *(LAS bf16x8*)(Bb + s * 32); x = MFMA32(av, bv, x); }
        }
        const int jj = 32 * J + r; const float gj = G[jj];
#pragma unroll
        for (int i = 0; i < 16; ++i) { const int ii = 32 * I + crow(i, hh); const float d = __expf(fminf(G[ii] - gj, 0.f));
            if (!isq) { if (blk != 3) ((LAS float*)(lds + L_AM))[ii * 68 + jj] = (ii > jj) ? BT[ii] * x[i] * d : 0.f; }
            else { QKP[ii * 64 + 32 * J + swap23(r)] = f2bf((ii >= jj && blk != 3) ? x[i] * d : 0.f); } }
    }
    __syncthreads();
#ifndef NOINV
    if (wid == 0) {
        float t[64]; const float lanef = (float)lane;
        int zoff; asm volatile("v_mov_b32 %0, 0" : "=v"(zoff));
        LAS float* AM = (LAS float*)(lds + L_AM) + zoff;
#pragma unroll
        for (int i = 0; i < 64; ++i) { float acc = fmaxf(1.0f - fabsf(lanef - (float)i), 0.f);
#pragma unroll
            for (int j4 = 0; j4 < i; j4 += 4) { const f32x4 av = *(LAS f32x4*)(AM + i * 68 + j4);
                acc -= av[0] * t[j4]; if (j4 + 1 < i) acc -= av[1] * t[j4 + 1]; if (j4 + 2 < i) acc -= av[2] * t[j4 + 2]; if (j4 + 3 < i) acc -= av[3] * t[j4 + 3]; }
            t[i] = acc; if ((i & 3) == 3) asm volatile("" ::: "memory"); }
#pragma unroll
        for (int i = 0; i < 64; ++i) *(LAS bf16_t*)(lds + L_TB + i * 144 + lane * 2) = f2bf(t[i]);
    }
#endif
    __syncthreads();
    {
        int r = lane & 31, hh = lane >> 5; asm volatile("" : "+v"(r), "+v"(hh));
#pragma unroll
        for (int tb = 0; tb < 2; ++tb) {
            f32x16 x;
#pragma unroll
            for (int i = 0; i < 16; ++i) x[i] = 0.f;
#pragma unroll
            for (int s = 0; s < 4; ++s) if (s < 2 || tb == 1) {
                const bf16x8 tf = *(LAS bf16x8*)(lds + L_TB + (32 * tb + r) * 144 + (16 * s + 8 * hh) * 2), rf = *(LAS bf16x8*)(lds + L_RT + (32 * wid + r) * 144 + (16 * s + 8 * hh) * 2);
                x = (wid < 4) ? MFMA32(tf, rf, x) : MFMA32(rf, tf, x); }
            float f[16];
#pragma unroll
            for (int i = 0; i < 16; ++i) f[i] = x[i];
            bf16_t* dst = (wid < 4) ? UT + (32 * wid + r) * 64 + 32 * tb : WP + (32 * tb + r) * 128 + 32 * (wid - 4);
            *(u32x4*)(dst + 8 * hh) = pack8(f); *(u32x4*)(dst + 16 + 8 * hh) = pack8(f + 8);
        }
    }
    __syncthreads();
}

DI void sample_gdn(const Ctx& c, LAS unsigned char* lds, int item) {
    const int tid = threadIdx.x, lane = tid & 63, wid = tid >> 6;
    const int b = item >> 2, h = item & 3;
    float* ctl = (float*)(c.ws + WS_CTL);
    const bf16_t* PROJ = (const bf16_t*)(c.ws + WS_B); bf16_t* OY = (bf16_t*)(c.ws + WS_A);
    LAS float* vals = (LAS float*)lds;
    LAS float* red = vals + 1536;
    LAS float* red2 = red + 512;
    LAS float* os = red2 + 512;
    const int row0 = NTP + b * 4;
    for (int i = tid; i < 1536; i += NTHREADS) { const int ten = i >> 9, tok = (i >> 7) & 3, ch = i & 127; const int col = ten * 512 + h * 128 + ch; float a = 0.f;
#pragma unroll
        for (int j = 0; j < 4; ++j) { const int idx = tok + j; const float xv = idx < 3 ? c.state_gdn_conv[((size_t)b * 3 + idx) * 1536 + col] : bf2f(PROJ[(size_t)(row0 + idx - 3) * NPROJ + col]); a += xv * c.w_conv_qkv[j * 1536 + col]; }
        vals[i] = siluf_(a); }
    __syncthreads();
    { const int ten = wid >> 2, tok = wid & 3; LAS float* v = vals + ten * 512 + tok * 128; const float a0 = v[lane], a1 = v[lane + 64]; float ss = a0 * a0 + a1 * a1;
#pragma unroll
      for (int o = 32; o >= 1; o >>= 1) ss += __shfl_xor(ss, o);
      const float sc = rsqrtf(ss + EPS) * (ten == 0 ? 0.08838834764831845f : 1.0f); v[lane] = a0 * sc; v[lane + 64] = a1 * sc; }
    __syncthreads();
    const int e = tid & 127, part = tid >> 7;
    float s[32];
    const float* S0 = c.state_gdn + ((size_t)item * 128 + part * 32) * 128 + e;
#pragma unroll
    for (int i = 0; i < 32; ++i) s[i] = S0[(size_t)i * 128];
#pragma unroll 1
    for (int t = 0; t < 4; ++t) {
        const float a = __expf(ctl[CTL_LA + (size_t)(row0 + t) * 4 + h]), bt = ctl[CTL_BETA + (size_t)(row0 + t) * 4 + h];
        LAS float* qv = vals + t * 128 + part * 32; LAS float* kv = vals + 512 + t * 128 + part * 32;
        float p = 0.f;
#pragma unroll
        for (int i = 0; i < 32; ++i) { s[i] *= a; p += s[i] * kv[i]; }
        red[part * 128 + e] = p;
        __syncthreads();
        const float rr = bt * (vals[1024 + t * 128 + e] - (red[e] + red[128 + e] + red[256 + e] + red[384 + e]));
        float po = 0.f;
#pragma unroll
        for (int i = 0; i < 32; ++i) { s[i] += kv[i] * rr; po += s[i] * qv[i]; }
        red2[part * 128 + e] = po;
        __syncthreads();
        if (part == 0) os[t * 128 + e] = red2[e] + red2[128 + e] + red2[256 + e] + red2[384 + e];
    }
    float* Sout = c.out + OFF_GS + ((size_t)item * 128 + part * 32) * 128 + e;
#pragma unroll
    for (int i = 0; i < 32; ++i) Sout[(size_t)i * 128] = s[i];
    __syncthreads();
    { const int tok = tid >> 7; float ss = 0.f;
      for (int i = 0; i < 128; ++i) { const float v = os[tok * 128 + i]; ss += v * v; }
      const float rs = rsqrtf(ss * (1.0f / 128.0f) + EPS); const int row = row0 + tok;
      const float z = bf2f(PROJ[(size_t)row * NPROJ + 1536 + h * 128 + e]);
      OY[(size_t)row * D + h * 128 + e] = f2bf(os[tok * 128 + e] * rs * c.w_gdn_norm[e] * siluf_(z)); }
    __syncthreads();
}

DI void p2_phase(const Ctx& c, LAS unsigned char* lds) {
    const int tid = threadIdx.x;
    const bf16_t* PROJ = (const bf16_t*)(c.ws + WS_B); bf16_t* OY = (bf16_t*)(c.ws + WS_A);
#if !defined(P2SUB) || P2SUB == 1
    for (int ch = blockIdx.x; ch < 1024; ch += gridDim.x) prep_chunk(c, lds, ch);
#endif
#if !defined(P2SUB) || P2SUB == 2
    for (int it = blockIdx.x; it < 512; it += gridDim.x) sample_gdn(c, lds, it);
#endif
    for (int item = blockIdx.x * NTHREADS + tid; item < NT * 64; item += gridDim.x * NTHREADS) {
        const int row = item >> 6, c8 = (item & 63) * 8;
        const bool prm = row < NTP; const int sb = prm ? (row >> 11) : ((row - NTP) >> 2); const int t = prm ? (row & 2047) : ((row - NTP) & 3); const int T = prm ? 2048 : 4;
        float bv[8]; unpack8(*(const u32x4*)(PROJ + (size_t)row * NPROJ + 2048 + c8), bv);
        float acc[8], cur[8];
#pragma unroll
        for (int e = 0; e < 8; ++e) { acc[e] = 0.f; cur[e] = 0.f; }
#pragma unroll
        for (int d = 0; d < 3; ++d) { const int tt = t - 2 + d; float sc[8];
            if (tt >= 0) { float cv[8], hv[8]; const bf16_t* src = PROJ + (size_t)(row - (2 - d)) * NPROJ + c8; unpack8(*(const u32x4*)(src + 2560), cv); unpack8(*(const u32x4*)(src + 3072), hv);
#pragma unroll
                for (int e = 0; e < 8; ++e) sc[e] = cv[e] * hv[e]; }
            else if (!prm) { const float* sp = c.state_sc_conv + ((size_t)sb * 2 + (2 + tt)) * 512 + c8; const f32x4 s0 = *(const f32x4*)sp, s1 = *(const f32x4*)(sp + 4);
#pragma unroll
                for (int e = 0; e < 4; ++e) { sc[e] = s0[e]; sc[4 + e] = s1[e]; } }
            else {
#pragma unroll
                for (int e = 0; e < 8; ++e) sc[e] = 0.f; }
            const float* wp = c.w_conv_sc + d * 512 + c8; const f32x4 w0 = *(const f32x4*)wp, w1 = *(const f32x4*)(wp + 4);
#pragma unroll
            for (int e = 0; e < 4; ++e) { acc[e] += sc[e] * w0[e]; acc[4 + e] += sc[4 + e] * w1[e]; }
            if (d == 2) {
#pragma unroll
                for (int e = 0; e < 8; ++e) cur[e] = sc[e]; } }
#pragma unroll
        for (int e = 0; e < 8; ++e) acc[e] *= bv[e];
        *(u32x4*)(OY + (size_t)row * D + 512 + c8) = pack8(acc);
        if (t >= T - 2) { float* dst = (prm ? c.out + OFF_SCP : c.out + OFF_SCS) + ((size_t)sb * 2 + (t - (T - 2))) * 512 + c8;
            *(f32x4*)dst = (f32x4){cur[0], cur[1], cur[2], cur[3]}; *(f32x4*)(dst + 4) = (f32x4){cur[4], cur[5], cur[6], cur[7]}; }
    }
    for (int idx = blockIdx.x * NTHREADS + tid; idx < 136 * 4608; idx += gridDim.x * NTHREADS) {
        const int seq = idx / 4608, rem = idx % 4608, j = rem / 1536, col = rem % 1536;
        if (seq < 8) c.out[OFF_GCP + idx] = bf2f(PROJ[(size_t)(seq * 2048 + 2045 + j) * NPROJ + col]);
        else c.out[OFF_GCS + (idx - 8 * 4608)] = bf2f(PROJ[(size_t)(NTP + (seq - 8) * 4 + 1 + j) * NPROJ + col]);
    }
}

DI void scan_seq(const Ctx& c, LAS unsigned char* lds, int bh) {
    const int tid = threadIdx.x, lane = tid & 63, wid = tid >> 6, r = lane & 31, hh = lane >> 5;
    const int b = bh >> 2, h = bh & 3;
    const float* ctl = (const float*)(c.ws + WS_CTL);
    const bf16_t* PROJ = (const bf16_t*)(c.ws + WS_B); bf16_t* OY = (bf16_t*)(c.ws + WS_A);
    LAS float* OB = (LAS float*)lds;
    f32x16 S[4];
#pragma unroll
    for (int kt = 0; kt < 4; ++kt)
#pragma unroll
        for (int i = 0; i < 16; ++i) S[kt][i] = 0.f;
    const int e0 = 32 * wid;
#pragma unroll 1
    for (int n = 0; n < 32; ++n) {
        const int ch = (b * 32 + n) * 4 + h;
        if (wid < 4) {
            const bf16_t* QP = (const bf16_t*)c.out + (size_t)ch * 8192; const bf16_t* WP = (const bf16_t*)c.out + (size_t)(1024 + ch) * 8192; const bf16_t* KTP = (const bf16_t*)c.out + (size_t)(2048 + ch) * 8192;
            const bf16_t* UT = (const bf16_t*)(c.ws + WS_C) + (size_t)ch * 8192; const bf16_t* QKP = (const bf16_t*)(c.ws + WS_C) + (size_t)1024 * 8192 + (size_t)ch * 4096;
            f32x16 P[2], O[2];
#pragma unroll
            for (int mi = 0; mi < 2; ++mi)
#pragma unroll
                for (int i = 0; i < 16; ++i) { P[mi][i] = 0.f; O[mi][i] = 0.f; }
#pragma unroll
            for (int kt = 0; kt < 4; ++kt)
#pragma unroll
                for (int s = 0; s < 2; ++s) { const bf16x8 sb = pack_step(S[kt], s);
#pragma unroll
                    for (int mi = 0; mi < 2; ++mi) { const int off = (32 * mi + r) * 128 + 32 * kt + 16 * s + 8 * hh;
                        P[mi] = MFMA32(*(const bf16x8*)(WP + off), sb, P[mi]); O[mi] = MFMA32(*(const bf16x8*)(QP + off), sb, O[mi]); } }
            bf16x8 vb[2][2];
#pragma unroll
            for (int tb = 0; tb < 2; ++tb) { float u[16]; const bf16_t* up = UT + (e0 + r) * 64 + 32 * tb + 8 * hh; unpack8(*(const u32x4*)up, u); unpack8(*(const u32x4*)(up + 16), u + 8);
                f32x16 vn;
#pragma unroll
                for (int i = 0; i < 16; ++i) vn[i] = u[i] - P[tb][i];
                vb[tb][0] = pack_step(vn, 0); vb[tb][1] = pack_step(vn, 1); }
#pragma unroll
            for (int mi = 0; mi < 2; ++mi)
#pragma unroll
                for (int tb = 0; tb <= mi; ++tb)
#pragma unroll
                    for (int s = 0; s < 2; ++s) O[mi] = MFMA32(*(const bf16x8*)(QKP + (32 * mi + r) * 64 + 32 * tb + 16 * s + 8 * hh), vb[tb][s], O[mi]);
            const float dec = __expf(ctl[CTL_GL + ch]);
#pragma unroll
            for (int kt = 0; kt < 4; ++kt) { S[kt] *= dec;
#pragma unroll
                for (int tb = 0; tb < 2; ++tb)
#pragma unroll
                    for (int s = 0; s < 2; ++s) S[kt] = MFMA32(*(const bf16x8*)(KTP + (32 * kt + r) * 64 + 32 * tb + 16 * s + 8 * hh), vb[tb][s], S[kt]); }
#pragma unroll
            for (int mi = 0; mi < 2; ++mi)
#pragma unroll
                for (int i = 0; i < 16; ++i) OB[(32 * mi + crow(i, hh)) * 132 + e0 + r] = O[mi][i];
        }
        __syncthreads();
        { const int tok = tid >> 3, pt = tid & 7; const int row = b * 2048 + n * 64 + tok; LAS float* op = OB + tok * 132 + pt * 16;
          float o[16]; float ss = 0.f;
#pragma unroll
          for (int q = 0; q < 4; ++q) { const f32x4 v = *(LAS f32x4*)(op + 4 * q); o[4 * q] = v[0]; o[4 * q + 1] = v[1]; o[4 * q + 2] = v[2]; o[4 * q + 3] = v[3]; ss += (v[0] * v[0] + v[1] * v[1]) + (v[2] * v[2] + v[3] * v[3]); }
          ss += __shfl_xor(ss, 1); ss += __shfl_xor(ss, 2); ss += __shfl_xor(ss, 4);
          const float rs = rsqrtf(ss * (1.0f / 128.0f) + EPS);
          float z[16]; const bf16_t* zp = PROJ + (size_t)row * NPROJ + 1536 + h * 128 + pt * 16; unpack8(*(const u32x4*)zp, z); unpack8(*(const u32x4*)(zp + 8), z + 8);
          const float* wn = c.w_gdn_norm + pt * 16;
#pragma unroll
          for (int e = 0; e < 16; ++e) o[e] = o[e] * rs * wn[e] * siluf_(z[e]);
          bf16_t* dst = OY + (size_t)row * D + h * 128 + pt * 16; *(u32x4*)dst = pack8(o); *(u32x4*)(dst + 8) = pack8(o + 8); }
        __syncthreads();
    }
    if (wid < 4) { float* So = c.out + OFF_GP + (size_t)bh * 16384;
#pragma unroll
        for (int kt = 0; kt < 4; ++kt)
#pragma unroll
            for (int i = 0; i < 16; ++i) So[(32 * kt + crow(i, hh)) * 128 + e0 + r] = S[kt][i]; }
}

__global__ void __launch_bounds__(NTHREADS, 2) mega(Ctx c) {
    extern __shared__ __attribute__((aligned(16))) unsigned char shm[];
    LAS unsigned char* lds = (LAS unsigned char*)shm;
    cg::grid_group grid = cg::this_grid();
    unsigned char* ws = c.ws; float* ctl = (float*)(ws + WS_CTL);
    const int lo = c.ph_lo, hi = c.ph_hi;
#ifdef ONLY
#define IN(k) ((k) == ONLY)
#else
#define IN(k) (lo <= (k) && (k) < hi)
#endif
#define SEAM(k) do { if (IN(k) && IN((k) + 1)) grid.sync(); } while (0)
    if (IN(0)) p0_phase(c, lds);
    SEAM(0);
    if (IN(1)) { pg8::Gemm g{(const bf16_t*)(ws + WS_A), (const bf16_t*)(ws + WS_WIN), NT, NPROJ, D}; pg8::StaticOrder S; S.init(NT, NPROJ, gridDim.x, blockIdx.x);
        EpiProj E{(bf16_t*)(ws + WS_B), NPROJ, ctl + CTL_RS0}; pg8::gemm_phase<EpiProj, pg8::StaticOrder, false>(lds, g, S, E, nullptr); }
    SEAM(1);
    if (IN(2)) p2_phase(c, lds);
    SEAM(2);
    if (IN(3)) { for (int bh = blockIdx.x; bh < 32; bh += gridDim.x) scan_seq(c, lds, bh); }
    SEAM(3);
    if (IN(4)) { pg8::Gemm g{(const bf16_t*)(ws + WS_A), (const bf16_t*)(ws + WS_WOUT), NT, D, D}; pg8::StaticOrder S; S.init(NT, D, gridDim.x, blockIdx.x);
        EpiRes<0> E{c.x_prompt, c.x_sample, c.out, (bf16_t*)(ws + WS_C), ctl + CTL_SS1, nullptr, nullptr}; pg8::gemm_phase<EpiRes<0>, pg8::StaticOrder, false>(lds, g, S, E, nullptr); }
    SEAM(4);
    if (IN(5)) { pg8::Gemm g{(const bf16_t*)(ws + WS_C), (const bf16_t*)(ws + WS_WUP), NT, DFF, D}; pg8::StaticOrder S; S.init(NT, DFF, gridDim.x, blockIdx.x);
        EpiUp E{(bf16_t*)(ws + WS_B), ctl + CTL_SS1}; pg8::gemm_phase<EpiUp, pg8::StaticOrder, false>(lds, g, S, E, nullptr); }
    SEAM(5);
    if (IN(6)) {
        { pg8::Gemm g{(const bf16_t*)(ws + WS_B), (const bf16_t*)(ws + WS_WDN), NT, D, DFF}; pg8::StaticOrder S; S.init(NT, D, gridDim.x, blockIdx.x);
          EpiRes<1> E{nullptr, nullptr, c.out, (bf16_t*)(ws + WS_C), ctl + CTL_SS2, nullptr, nullptr}; pg8::gemm_phase<EpiRes<1>, pg8::StaticOrder, false>(lds, g, S, E, nullptr); }
        { pg8::Gemm g{(const bf16_t*)(ws + WS_PB), (const bf16_t*)(ws + WS_WP), NT, D, PLE}; pg8::StaticOrder S; S.init(NT, D, gridDim.x, (blockIdx.x + 8) % gridDim.x);
          EpiProj E{(bf16_t*)(ws + WS_A), D, nullptr}; pg8::gemm_phase<EpiProj, pg8::StaticOrder, false>(lds, g, S, E, nullptr); }
    }
    SEAM(6);
    if (IN(7)) { pg8::Gemm g{(const bf16_t*)(ws + WS_C), (const bf16_t*)(ws + WS_WG), NT, D, D}; pg8::StaticOrder S; S.init(NT, D, gridDim.x, blockIdx.x);
        EpiRes<2> E{nullptr, nullptr, c.out, nullptr, ctl + CTL_SS3, ctl + CTL_SS2, (const bf16_t*)(ws + WS_A)}; pg8::gemm_phase<EpiRes<2>, pg8::StaticOrder, false>(lds, g, S, E, nullptr); }
    SEAM(7);
    if (IN(8)) {
        for (size_t i = (size_t)blockIdx.x * NTHREADS + threadIdx.x; i < (size_t)NT * 256; i += (size_t)gridDim.x * NTHREADS) {
            const int row = (int)(i >> 8), c4 = (int)(i & 255) * 4; const float rs = rsqrtf(ctl[CTL_SS3 + row] * (1.0f / 1024.0f) + EPS);
            f32x4 v = *(f32x4*)(c.out + i * 4); const f32x4 w = *(const f32x4*)(c.norm_f + c4); v = v * rs * w; *(f32x4*)(c.out + i * 4) = v; }
    }
#undef IN
#undef SEAM
}

#ifndef N_LAUNCH_MODE
#define N_LAUNCH_MODE 1
#endif
extern "C" void kernel_launch(void* const* d_in, const int* in_sizes, int n_in, void* d_out, int out_size, void* d_ws, size_t ws_size, hipStream_t stream) {
    static int grid = 0;
    if (grid == 0) {
        int dev = 0, cus = 0, per_cu = 0;
        if (ws_size < WS_END) { fprintf(stderr, "kernel_launch: workspace too small: %zu < %zu\n", ws_size, (size_t)WS_END); grid = -1; return; }
        hipGetDevice(&dev); hipDeviceGetAttribute(&cus, hipDeviceAttributeMultiprocessorCount, dev);
        if (hipFuncSetAttribute((const void*)mega, hipFuncAttributeMaxDynamicSharedMemorySize, LDS_BYTES) != hipSuccess) { fprintf(stderr, "kernel_launch: hipFuncSetAttribute failed\n"); grid = -1; return; }
        if (hipOccupancyMaxActiveBlocksPerMultiprocessor(&per_cu, (const void*)mega, NTHREADS, LDS_BYTES) != hipSuccess || per_cu < 1) { fprintf(stderr, "kernel_launch: occupancy query says %d\n", per_cu); per_cu = 1; }
        (void)hipGetLastError();
        grid = cus * 1;
    }
    if (grid < 0) return;
    Ctx a{};
    const float** ap = (const float**)&a;
    for (int i = 0; i < 22; ++i) ap[i] = (const float*)d_in[i];
    a.out = (float*)d_out; a.ws = (unsigned char*)d_ws;
#if N_LAUNCH_MODE == 1
    a.ph_lo = 0; a.ph_hi = 9;
    void* args[] = {&a};
    hipError_t e = hipLaunchCooperativeKernel((const void*)mega, dim3(grid), dim3(NTHREADS), args, LDS_BYTES, stream);
    if (e != hipSuccess) fprintf(stderr, "cooperative launch failed: %s (grid %d)\n", hipGetErrorString(e), grid);
#else
    for (int ph = 0; ph < 9; ++ph) { a.ph_lo = ph; a.ph_hi = ph + 1; hipLaunchKernelGGL(mega, dim3(grid), dim3(NTHREADS), LDS_BYTES, stream, a); }
#endif
}
```

```cpp
#include <hip/hip_runtime.h>
#include <hip/hip_cooperative_groups.h>
#include <cstdio>
namespace cg = cooperative_groups;

constexpr int L_WTAB = 149008;
static __device__ __forceinline__ unsigned mk_lane() { return __builtin_amdgcn_mbcnt_hi(~0u, __builtin_amdgcn_mbcnt_lo(~0u, 0u)); }
static __device__ __forceinline__ unsigned mk_slot() { return (unsigned)__builtin_amdgcn_s_getreg(0x2804) & 63u; }
static __device__ __forceinline__ unsigned mk_tid() {
    extern __shared__ __attribute__((aligned(16))) unsigned char mk_shm[];
    const unsigned w = ((__attribute__((address_space(3))) unsigned*)((__attribute__((address_space(3))) unsigned char*)mk_shm + L_WTAB))[mk_slot()];
    return (unsigned)__builtin_amdgcn_readfirstlane((int)w) * 64u + mk_lane();
}
namespace pg8 {
#define PG8_LAS __attribute__((address_space(3)))
typedef unsigned short bf16_t;
typedef short bf16x8 __attribute__((ext_vector_type(8)));
typedef float f32x4 __attribute__((ext_vector_type(4)));
typedef unsigned u32x4 __attribute__((ext_vector_type(4)));
constexpr int BM = 256, BK = 64, HALF = 128, HTB = HALF * BK * 2  , STAGE_BYTES = 8 * HTB, NXCD = 8, WGM = 8;

__host__ __device__ __forceinline__ int lds_byte(int r, int c) { const int st = (r >> 4) * 2 + (c >> 5), rr = r & 15, cc = c & 31, ob = rr * 64 + cc * 2; return st * 1024 + (ob ^ (((ob >> 9) & 1) << 5)); }
__host__ __device__ __forceinline__ void stage_rc(int b, int& R, int& C) { const int st = b / 1024, sb = b % 1024, swz = sb ^ (((sb >> 9) & 1) << 5); R = (st >> 1) * 16 + swz / 64; C = (st & 1) * 32 + (swz % 64) / 2; }
__host__ __device__ __forceinline__ int perm32(int rho) { const int n = rho >> 4, i = rho & 15; return 8 * (i >> 2) + 4 * n + (i & 3); }

struct Unit { int pm, pn; };
struct Gemm { const bf16_t* A; const bf16_t* Bt; int M, N, K; int ld; };

struct StaticOrder {
    int nM, nN, nwg, G, c;
    __host__ __device__ void init(int M, int N, int G_, int c_) { nM = M / BM; nN = N / BM; nwg = nM * nN; G = G_; c = c_; }
    __host__ __device__ bool next(int i, Unit& u) const {
        const long L = (long)i * G + c; if (L >= nwg) return false;
        int wgid = (int)L; { const int q = nwg / NXCD, r = nwg % NXCD, xcd = wgid % NXCD, off = wgid / NXCD; wgid = (xcd < r ? xcd * (q + 1) : r * (q + 1) + (xcd - r) * q) + off; }
        const int nig = WGM * nN, gid = wgid / nig, fm = gid * WGM, gsz = (nM - fm) < WGM ? (nM - fm) : WGM;
        u.pm = fm + ((wgid % nig) % gsz); u.pn = (wgid % nig) / gsz; return true;
    }
    __device__ __forceinline__ void a_ready(const Unit&) const {}
    __device__ __forceinline__ void done(const Unit&) const {}
};
template <class Epi, class Sched, bool STAMP = false>
__device__ __forceinline__ void gemm_phase(PG8_LAS unsigned char* lds, const Gemm g, const Sched& S, const Epi& E, unsigned long long* stamps) {
    int tid = mk_tid(); asm volatile("" : "+v"(tid));
    const int wid = __builtin_amdgcn_readfirstlane(tid >> 6), lane = tid & 63, wr = wid >> 2, wc = wid & 3, fr = lane & 15, fq = lane >> 4;
    const int K = g.K, nt = K / BK, LD = g.ld ? g.ld : g.K;
    int ts_lo = 0, ts_hi = 0, nts = 0; const unsigned long long rt_entry = STAMP ? (unsigned long long)wall_clock64() : 0ull;
#define PG8_STAMP() do { if (STAMP && wid == 0 && nts < 64) { const unsigned long long _c = (unsigned long long)clock64(); \
        ts_lo = (lane == nts) ? (int)(unsigned)_c : ts_lo; ts_hi = (lane == nts) ? (int)(unsigned)(_c >> 32) : ts_hi; ++nts; } } while (0)
    PG8_STAMP();
    unsigned voffA[2], voffB[2];
#pragma unroll
    for (int i = 0; i < 2; ++i) { int R, C; stage_rc(tid * 16 + i * 8192, R, C); const int Rb = Epi::PERM ? ((R & ~31) + perm32(R & 31)) : R;
        voffA[i] = (unsigned)(R * LD + C) * 2u; voffB[i] = (unsigned)(Rb * LD + C) * 2u; }
    const size_t kstep = (size_t)(BK * 2);
    const size_t hstep = (size_t)HALF * LD * 2;
    const size_t tstep = 2 * hstep;
    const unsigned ldsw = (unsigned)wid * 1024u;
    const int aoff = lds_byte(wr * 64 + fr, fq * 8), boff = lds_byte(wc * 32 + fr, fq * 8);
#define PG8_SA(b, h) (((b) * 2 + (h)) * HTB)
#define PG8_SB(b, h) ((4 + (b) * 2 + (h)) * HTB)
#define PG8_STAGE(bufoff, gbase, voff) do { _Pragma("unroll") for (int _i = 0; _i < 2; ++_i) \
        __builtin_amdgcn_global_load_lds((const unsigned*)((const char*)(gbase) + (voff)[_i]), (PG8_LAS unsigned*)(lds + (bufoff) + ldsw + _i * 8192), 16, 0, 0); } while (0)
#define PG8_LDA(dst, b, h) do { _Pragma("unroll") for (int m = 0; m < 4; ++m) _Pragma("unroll") for (int k = 0; k < 2; ++k) dst[m][k] = *(const PG8_LAS bf16x8*)(lds + PG8_SA(b, h) + aoff + m * 2048 + k * 1024); } while (0)
#define PG8_LDB(dst, b, h) do { _Pragma("unroll") for (int n = 0; n < 2; ++n) _Pragma("unroll") for (int k = 0; k < 2; ++k) dst[n][k] = *(const PG8_LAS bf16x8*)(lds + PG8_SB(b, h) + boff + n * 2048 + k * 1024); } while (0)
#define PG8_MMA(ai, bj, At, Bt) do { __builtin_amdgcn_s_setprio(1); _Pragma("unroll") for (int m = 0; m < 4; ++m) _Pragma("unroll") for (int n = 0; n < 2; ++n) _Pragma("unroll") for (int k = 0; k < 2; ++k) \
        acc[ai][bj][m][n] = __builtin_amdgcn_mfma_f32_16x16x32_bf16(Bt[n][k], At[m][k], acc[ai][bj][m][n], 0, 0, 0); __builtin_amdgcn_s_setprio(0); } while (0)
#define PG8_WAIT_V(n) asm volatile("s_waitcnt vmcnt(" #n ")" ::: "memory")
#define PG8_WAIT_L(n) asm volatile("s_waitcnt lgkmcnt(" #n ")" ::: "memory")
#define PG8_BAR __builtin_amdgcn_s_barrier()
#define PG8_SCHED __builtin_amdgcn_sched_barrier(0)
    Unit cur, nxt; int ui = 0;
    if (!S.next(0, cur)) return;
    f32x4 acc[2][2][4][2];
#pragma unroll
    for (int a = 0; a < 2; ++a)
#pragma unroll
        for (int b = 0; b < 2; ++b)
#pragma unroll
            for (int m = 0; m < 4; ++m)
#pragma unroll
                for (int n = 0; n < 2; ++n) acc[a][b][m][n] = (f32x4){0.f, 0.f, 0.f, 0.f};
    bf16x8 At[4][2], B0[2][2], B1[2][2];
    const char* cA = (const char*)g.A + (size_t)cur.pm * tstep; const char* cB = (const char*)g.Bt + (size_t)cur.pn * tstep;
    S.a_ready(cur);
    PG8_STAGE(PG8_SB(0, 0), cB, voffB); PG8_STAGE(PG8_SA(0, 0), cA, voffA); PG8_STAGE(PG8_SB(0, 1), cB + hstep, voffB); PG8_STAGE(PG8_SA(0, 1), cA + hstep, voffA);
    if (wr == 1) PG8_BAR;
    PG8_WAIT_V(4); PG8_BAR;
    PG8_STAGE(PG8_SB(1, 0), cB + kstep, voffB); PG8_STAGE(PG8_SA(1, 0), cA + kstep, voffA); PG8_STAGE(PG8_SB(1, 1), cB + hstep + kstep, voffB);
    PG8_WAIT_V(6); PG8_BAR;
    PG8_STAMP();
    for (;;) {
        const bool has_next = S.next(ui + 1, nxt);
        const char* nA = has_next ? (const char*)g.A + (size_t)nxt.pm * tstep : cA; const char* nB = has_next ? (const char*)g.Bt + (size_t)nxt.pn * tstep : cB;
        for (int t = 0; t < nt; t += 2) {
            const bool last = (t == nt - 2);
            const char* a1 = cA + (size_t)(t + 1) * kstep;
            const char* a2 = last ? nA : cA + (size_t)(t + 2) * kstep; const char* b2 = last ? nB : cB + (size_t)(t + 2) * kstep;
            const char* a3 = a2 + kstep; const char* b3 = b2 + kstep;
            if (last && has_next) S.a_ready(nxt);
            PG8_LDB(B0, 0, 0); PG8_SCHED; PG8_LDA(At, 0, 0); PG8_STAGE(PG8_SA(1, 1), a1 + hstep, voffA);
            PG8_WAIT_L(8); PG8_BAR; PG8_WAIT_L(0); PG8_MMA(0, 0, At, B0); PG8_BAR; PG8_SCHED;
            PG8_LDB(B1, 0, 1); PG8_STAGE(PG8_SB(0, 0), b2, voffB);
            PG8_BAR; PG8_WAIT_L(0); PG8_MMA(0, 1, At, B1); PG8_BAR;
            PG8_LDA(At, 0, 1); PG8_STAGE(PG8_SA(0, 0), a2, voffA);
            PG8_BAR; PG8_WAIT_L(0); PG8_MMA(1, 0, At, B0); PG8_BAR; PG8_SCHED;
            PG8_STAGE(PG8_SB(0, 1), b2 + hstep, voffB);
            PG8_WAIT_V(6); PG8_BAR; PG8_MMA(1, 1, At, B1); PG8_BAR;
            PG8_LDB(B0, 1, 0); PG8_SCHED; PG8_LDA(At, 1, 0); PG8_STAGE(PG8_SA(0, 1), a2 + hstep, voffA);
            PG8_WAIT_L(8); PG8_BAR; PG8_WAIT_L(0); PG8_MMA(0, 0, At, B0); PG8_BAR; PG8_SCHED;
            PG8_LDB(B1, 1, 1); PG8_STAGE(PG8_SB(1, 0), b3, voffB);
            PG8_BAR; PG8_WAIT_L(0); PG8_MMA(0, 1, At, B1); PG8_BAR;
            PG8_LDA(At, 1, 1); PG8_STAGE(PG8_SA(1, 0), a3, voffA);
            PG8_BAR; PG8_WAIT_L(0); PG8_MMA(1, 0, At, B0); PG8_BAR; PG8_SCHED;
            PG8_STAGE(PG8_SB(1, 1), b3 + hstep, voffB);
            PG8_WAIT_V(6); PG8_BAR; PG8_MMA(1, 1, At, B1); PG8_BAR;
        }
        PG8_STAMP();
        if constexpr (!Epi::AFTER_DRAIN) { E(acc, cur, wr, wc, fr, fq); S.done(cur); }
        PG8_STAMP();
        if (!has_next) break;
#pragma unroll
        for (int a = 0; a < 2; ++a)
#pragma unroll
            for (int b = 0; b < 2; ++b)
#pragma unroll
                for (int m = 0; m < 4; ++m)
#pragma unroll
                    for (int n = 0; n < 2; ++n) acc[a][b][m][n] = (f32x4){0.f, 0.f, 0.f, 0.f};
        cur = nxt; cA = nA; cB = nB; ++ui;
    }
    PG8_WAIT_V(0);
    if (wr == 0) PG8_BAR;
    PG8_BAR;
    if constexpr (Epi::AFTER_DRAIN) { E.fused(acc, cur, wr, wc, fr, fq, lds, wid, lane); S.done(cur); }
    PG8_STAMP();
    if (STAMP && wid == 0) { stamps[lane] = lane < nts ? (((unsigned long long)(unsigned)ts_hi << 32) | (unsigned)ts_lo) : 0ull;
        if (lane == 62) stamps[62] = rt_entry; if (lane == 63) stamps[63] = (unsigned long long)wall_clock64(); }
#undef PG8_STAMP
#undef PG8_SA
#undef PG8_SB
#undef PG8_STAGE
#undef PG8_LDA
#undef PG8_LDB
#undef PG8_MMA
#undef PG8_WAIT_V
#undef PG8_WAIT_L
#undef PG8_BAR
#undef PG8_SCHED
}
}
#define LAS __attribute__((address_space(3)))
using pg8::bf16_t; using pg8::bf16x8; using pg8::f32x4; using pg8::u32x4;
typedef float f32x16 __attribute__((ext_vector_type(16)));
typedef float f32x2v __attribute__((ext_vector_type(2)));
typedef __bf16 bf16x2v __attribute__((ext_vector_type(2)));
typedef unsigned u32x2 __attribute__((ext_vector_type(2)));
#define DI __device__ __forceinline__
#define MFMA32(a, b, c) __builtin_amdgcn_mfma_f32_32x32x16_bf16((a), (b), (c), 0, 0, 0)

constexpr int D = 1024, NTP = 16384, NTS = 512, NT = NTP + NTS;
constexpr int NPROJ = 3584, INDIM = 3592, DFF = 4096, PLE = 256;
constexpr float EPS = 1e-6f;
constexpr int NTHREADS = 512;
constexpr int LDS_BYTES = 149008 + 256;
constexpr size_t WS_WIN = 0;
constexpr size_t WS_WOUT = WS_WIN + (size_t)NPROJ * D * 2;
constexpr size_t WS_WUP = WS_WOUT + (size_t)D * D * 2;
constexpr size_t WS_WDN = WS_WUP + (size_t)DFF * D * 2;
constexpr size_t WS_WG = WS_WDN + (size_t)D * DFF * 2;
constexpr size_t WS_WP = WS_WG + (size_t)D * D * 2;
constexpr size_t WS_CTL = WS_WP + (size_t)D * PLE * 2;
constexpr size_t CTL_RS0 = 0, CTL_SS1 = NT, CTL_SS2 = 2 * NT, CTL_SS3 = 3 * NT, CTL_LA = 4 * NT, CTL_BETA = 8 * NT, CTL_GL = 12 * NT, CTL_FLOATS = 12 * NT + 1024;
constexpr size_t WS_PB = WS_CTL + ((CTL_FLOATS * 4 + 4095) / 4096) * 4096;
constexpr size_t WS_A = WS_PB + (size_t)NT * PLE * 2;
constexpr size_t WS_B = WS_A + (size_t)NT * D * 2;
constexpr size_t WS_C = WS_B + (size_t)NT * DFF * 2;
constexpr size_t WS_BAR = WS_C + (size_t)NT * D * 2;
constexpr size_t WS_FLAGS = WS_BAR + 16384;
constexpr size_t WS_PCNT = WS_BAR + 20480;
constexpr size_t WS_PPS = WS_BAR + 32768;
constexpr size_t WS_END = WS_PPS + (size_t)NTS * D * 2;
constexpr size_t OFF_Y = 0, OFF_GCP = 17301504, OFF_GP = 17338368, OFF_SCP = 17862656, OFF_GCS = 17870848, OFF_GS = 18460672, OFF_SCS = 26849280;

struct Ctx {
    const float* x_prompt; const float* x_sample; const float* state_gdn_conv; const float* state_gdn; const float* state_sc_conv; const float* p_prompt; const float* p_sample;
    const float* norm_mix; const float* w_in; const float* w_conv_qkv; const float* a_log; const float* dt_bias; const float* w_gdn_norm; const float* w_conv_sc; const float* w_out;
    const float* norm_mlp; const float* w_up; const float* w_down; const float* norm_ple; const float* w_ple_gate; const float* w_ple_proj; const float* norm_f;
    float* out; unsigned char* ws; int ph_lo, ph_hi;
};

DI unsigned pk2(float lo, float hi) { f32x2v v = {lo, hi}; return __builtin_bit_cast(unsigned, __builtin_convertvector(v, bf16x2v)); }
DI bf16_t f2bf(float f) { return (bf16_t)(pk2(f, 0.f) & 0xffffu); }
DI float bf2f(bf16_t b) { return __uint_as_float((unsigned)b << 16); }
DI float bflo(unsigned u) { return __uint_as_float(u << 16); }
DI float bfhi(unsigned u) { return __uint_as_float(u & 0xffff0000u); }
DI void unpack8(const u32x4 v, float* f) { f[0] = bflo(v.x); f[1] = bfhi(v.x); f[2] = bflo(v.y); f[3] = bfhi(v.y); f[4] = bflo(v.z); f[5] = bfhi(v.z); f[6] = bflo(v.w); f[7] = bfhi(v.w); }
DI u32x4 pack8(const float* f) { u32x4 w; w.x = pk2(f[0], f[1]); w.y = pk2(f[2], f[3]); w.z = pk2(f[4], f[5]); w.w = pk2(f[6], f[7]); return w; }
DI void st16_wt(void* ptr, const u32x4 v) { asm volatile("global_store_dwordx4 %0, %1, off sc0 sc1\n\ts_nop 2" :: "v"(ptr), "v"(v) : "memory"); }
DI int crow(int reg, int h) { return (reg & 3) + 8 * (reg >> 2) + 4 * h; }
DI int swap23(int p) { return (p & ~12) | ((p & 4) << 1) | ((p & 8) >> 1); }
DI bf16x8 pack_step(const f32x16& x, int s) {
    u32x4 p; p.x = pk2(x[8 * s], x[8 * s + 1]); p.y = pk2(x[8 * s + 2], x[8 * s + 3]); p.z = pk2(x[8 * s + 4], x[8 * s + 5]); p.w = pk2(x[8 * s + 6], x[8 * s + 7]);
    return __builtin_bit_cast(bf16x8, p);
}
DI float sigmoidf_(float x) { return __builtin_amdgcn_rcpf(1.0f + __expf(-x)); }
DI float siluf_(float x) { return x * __builtin_amdgcn_rcpf(1.0f + __expf(-x)); }

struct EpiProj {
    static constexpr bool PERM = true, AFTER_DRAIN = false;
    bf16_t* O; int ldc; const float* rs;
    DI void operator()(const f32x4 (&acc)[2][2][4][2], const pg8::Unit& u, int wr, int wc, int fr, int fq) const {
        const int row0 = u.pm * 256 + wr * 64 + fr, col0 = u.pn * 256 + wc * 32 + 8 * fq;
#pragma unroll
        for (int ai = 0; ai < 2; ++ai)
#pragma unroll
            for (int m = 0; m < 4; ++m) { const int row = row0 + ai * 128 + m * 16; const float r = rs ? rs[row] : 1.0f; bf16_t* rowp = O + (size_t)row * ldc + col0;
#pragma unroll
                for (int bj = 0; bj < 2; ++bj) { const f32x4 v0 = acc[ai][bj][m][0] * r, v1 = acc[ai][bj][m][1] * r;
                    u32x4 w; w.x = pk2(v0[0], v0[1]); w.y = pk2(v0[2], v0[3]); w.z = pk2(v1[0], v1[1]); w.w = pk2(v1[2], v1[3]);
                    *(u32x4*)(rowp + bj * 128) = w; } }
    }
};
struct EpiUp {
    static constexpr bool PERM = true, AFTER_DRAIN = false;
    bf16_t* O; const float* ss;
    DI void operator()(const f32x4 (&acc)[2][2][4][2], const pg8::Unit& u, int wr, int wc, int fr, int fq) const {
        const int row0 = u.pm * 256 + wr * 64 + fr, col0 = u.pn * 256 + wc * 32 + 8 * fq;
#pragma unroll
        for (int ai = 0; ai < 2; ++ai)
#pragma unroll
            for (int m = 0; m < 4; ++m) { const int row = row0 + ai * 128 + m * 16; const float r = rsqrtf(ss[row] * (1.0f / 1024.0f) + EPS); bf16_t* rowp = O + (size_t)row * DFF + col0;
#pragma unroll
                for (int bj = 0; bj < 2; ++bj) { f32x4 v0 = acc[ai][bj][m][0] * r, v1 = acc[ai][bj][m][1] * r;
#pragma unroll
                    for (int j = 0; j < 4; ++j) { v0[j] = fmaxf(v0[j], 0.f); v0[j] *= v0[j]; v1[j] = fmaxf(v1[j], 0.f); v1[j] *= v1[j]; }
                    u32x4 w; w.x = pk2(v0[0], v0[1]); w.y = pk2(v0[2], v0[3]); w.z = pk2(v1[0], v1[1]); w.w = pk2(v1[2], v1[3]);
                    *(u32x4*)(rowp + bj * 128) = w; } }
    }
};
template <int MODE> struct EpiRes {
    static constexpr bool PERM = true, AFTER_DRAIN = false;
    const float* xp; const float* xs; bf16_t* XB; bf16_t* XO; float* ssn; const float* ssp; const bf16_t* PP;
    DI void operator()(const f32x4 (&acc)[2][2][4][2], const pg8::Unit& u, int wr, int wc, int fr, int fq) const {
        const int row0 = u.pm * 256 + wr * 64 + fr, col0 = u.pn * 256 + wc * 32 + 8 * fq;
#pragma unroll
        for (int ai = 0; ai < 2; ++ai)
#pragma unroll
            for (int m = 0; m < 4; ++m) { const int row = row0 + ai * 128 + m * 16; const size_t off = (size_t)row * D + col0;
                float r = 1.f; if (MODE == 2) r = rsqrtf(ssp[row] * (1.0f / 1024.0f) + EPS);
                float sq = 0.f;
#pragma unroll
                for (int bj = 0; bj < 2; ++bj) { float v[8];
#pragma unroll
                    for (int j = 0; j < 4; ++j) { v[j] = acc[ai][bj][m][0][j]; v[4 + j] = acc[ai][bj][m][1][j]; }
                    if (MODE == 2) { float pf[8]; unpack8(*(const u32x4*)(PP + off + bj * 128), pf);
#pragma unroll
                        for (int j = 0; j < 8; ++j) v[j] = sigmoidf_(v[j] * r) * pf[j]; }
                    if (MODE == 0) { const float* bp = (row < NTP ? xp + off : xs + (off - (size_t)NTP * D)) + bj * 128; const f32x4 b0 = *(const f32x4*)bp, b1 = *(const f32x4*)(bp + 4);
#pragma unroll
                        for (int j = 0; j < 4; ++j) { v[j] += b0[j]; v[4 + j] += b1[j]; } }
                    else { float bf[8]; unpack8(*(const u32x4*)(XB + off + bj * 128), bf);
#pragma unroll
                        for (int j = 0; j < 8; ++j) v[j] += bf[j]; }
                    *(u32x4*)((MODE == 2 ? XO : XB) + off + bj * 128) = pack8(v);
#pragma unroll
                    for (int j = 0; j < 8; ++j) sq += v[j] * v[j]; }
                sq += __shfl_xor(sq, 16); sq += __shfl_xor(sq, 32);
                if (fq == 0) atomicAdd(ssn + row, sq); }
    }
};
struct SubOrder {
    int pm0, nM, nN, G, c;
    DI bool next(int i, pg8::Unit& u) const { const int L = i * G + c; if (c < 0 || L >= nM * nN) return false; u.pm = pm0 + L % nM; u.pn = L / nM; return true; }
    DI void a_ready(const pg8::Unit&) const {}
    DI void done(const pg8::Unit&) const {}
};
constexpr size_t SLAB_OFF = 123000064;
constexpr size_t SLAB_FLOATS = (size_t)NTS * D;
struct EpiSplitK {
    static constexpr bool PERM = true, AFTER_DRAIN = true;
    float* SLAB; int kq; bf16_t* XB; float* ssn; unsigned* cnt;
    DI void fused(f32x4 (&acc)[2][2][4][2], const pg8::Unit& u, int wr, int wc, int fr, int fq, LAS unsigned char* lds, int wid, int lane) const {
        const int row0 = u.pm * 256 + wr * 64 + fr, col0 = u.pn * 256 + wc * 32 + 8 * fq;
        float* mine = SLAB + (size_t)kq * SLAB_FLOATS - (size_t)NTP * D;
#pragma unroll
        for (int ai = 0; ai < 2; ++ai)
#pragma unroll
            for (int m = 0; m < 4; ++m) { float* rowp = mine + (size_t)(row0 + ai * 128 + m * 16) * D + col0;
#pragma unroll
                for (int bj = 0; bj < 2; ++bj) { st16_wt(rowp + bj * 128, __builtin_bit_cast(u32x4, acc[ai][bj][m][0])); st16_wt(rowp + bj * 128 + 4, __builtin_bit_cast(u32x4, acc[ai][bj][m][1])); } }
        asm volatile("s_waitcnt vmcnt(0)" ::: "memory");
        __syncthreads();
        volatile LAS unsigned* flag = (volatile LAS unsigned*)lds;
        if (wid == 0 && lane == 0) { const unsigned t = __hip_atomic_fetch_add(cnt + ((u.pm - 64) * 4 + u.pn) * 32, 1u, __ATOMIC_RELAXED, __HIP_MEMORY_SCOPE_AGENT);
            __builtin_amdgcn_fence(__ATOMIC_ACQUIRE, "agent"); asm volatile("s_waitcnt vmcnt(0)" ::: "memory"); flag[0] = (t == 3u) ? 1u : 0u; }
        __syncthreads();
        if (flag[0] != 0u) {
#pragma unroll
            for (int ai = 0; ai < 2; ++ai)
#pragma unroll
                for (int m = 0; m < 4; ++m) { const int row = row0 + ai * 128 + m * 16; const size_t off = (size_t)row * D + col0; float sq = 0.f;
#pragma unroll
                    for (int bj = 0; bj < 2; ++bj) { float v[8]; unpack8(*(const u32x4*)(XB + off + bj * 128), v);
#pragma unroll
                        for (int q = 0; q < 4; ++q) { const float* sp = SLAB + (size_t)q * SLAB_FLOATS + (off - (size_t)NTP * D) + bj * 128; const f32x4 a0 = *(const f32x4*)sp, a1 = *(const f32x4*)(sp + 4);
#pragma unroll
                            for (int j = 0; j < 4; ++j) { v[j] += a0[j]; v[4 + j] += a1[j]; } }
                        *(u32x4*)(XB + off + bj * 128) = pack8(v);
#pragma unroll
                        for (int j = 0; j < 8; ++j) sq += v[j] * v[j]; }
                    sq += __shfl_xor(sq, 16); sq += __shfl_xor(sq, 32);
                    if (fq == 0) atomicAdd(ssn + row, sq); }
        }
    }
};
struct EpiFinal {
    static constexpr bool PERM = true, AFTER_DRAIN = true;
    const bf16_t* XB; const bf16_t* PP; const float* ssp; float* ssn; unsigned* cnt; const float* normf; float* Y;
    DI void fused(f32x4 (&acc)[2][2][4][2], const pg8::Unit& u, int wr, int wc, int fr, int fq, LAS unsigned char* lds, int wid, int lane) const {
        const int row0 = u.pm * 256 + wr * 64 + fr, col0 = u.pn * 256 + wc * 32 + 8 * fq;
#pragma unroll
        for (int ai = 0; ai < 2; ++ai)
#pragma unroll
            for (int m = 0; m < 4; ++m) { const int row = row0 + ai * 128 + m * 16; const size_t off = (size_t)row * D + col0;
                const float r = rsqrtf(ssp[row] * (1.0f / 1024.0f) + EPS); float sq = 0.f;
#pragma unroll
                for (int bj = 0; bj < 2; ++bj) { float pf[8], bf[8]; unpack8(*(const u32x4*)(PP + off + bj * 128), pf); unpack8(*(const u32x4*)(XB + off + bj * 128), bf);
#pragma unroll
                    for (int j = 0; j < 4; ++j) { const float a = sigmoidf_(acc[ai][bj][m][0][j] * r) * pf[j] + bf[j], b = sigmoidf_(acc[ai][bj][m][1][j] * r) * pf[4 + j] + bf[4 + j];
                        acc[ai][bj][m][0][j] = a; acc[ai][bj][m][1][j] = b; sq += a * a + b * b; } }
                sq += __shfl_xor(sq, 16); sq += __shfl_xor(sq, 32);
                if (fq == 0) atomicAdd(ssn + row, sq); }
        asm volatile("s_waitcnt vmcnt(0)" ::: "memory");
        __syncthreads();
        if (mk_tid() == 0) { unsigned* cw = cnt + u.pm * 32; (void)__hip_atomic_fetch_add(cw, 1u, __ATOMIC_RELAXED, __HIP_MEMORY_SCOPE_AGENT);
            unsigned sp = 0u; while (__hip_atomic_load(cw, __ATOMIC_RELAXED, __HIP_MEMORY_SCOPE_AGENT) < 4u) { __builtin_amdgcn_s_sleep(1); if (++sp > (1u << 22)) break; }
            __builtin_amdgcn_fence(__ATOMIC_ACQUIRE, "agent"); asm volatile("s_waitcnt vmcnt(0)" ::: "memory"); }
        __syncthreads();
#pragma unroll
        for (int ai = 0; ai < 2; ++ai)
#pragma unroll
            for (int m = 0; m < 4; ++m) { const int row = row0 + ai * 128 + m * 16; const size_t off = (size_t)row * D + col0;
                const float rs = rsqrtf(__hip_atomic_load(ssn + row, __ATOMIC_RELAXED, __HIP_MEMORY_SCOPE_AGENT) * (1.0f / 1024.0f) + EPS);
#pragma unroll
                for (int bj = 0; bj < 2; ++bj) { const f32x4 w0 = *(const f32x4*)(normf + col0 + bj * 128), w1 = *(const f32x4*)(normf + col0 + bj * 128 + 4);
                    *(f32x4*)(Y + off + bj * 128) = acc[ai][bj][m][0] * rs * w0; *(f32x4*)(Y + off + bj * 128 + 4) = acc[ai][bj][m][1] * rs * w1; } }
    }
};
#define XB_TMO      128
#define XB_XCNT(j)  (256  + 64 * (j))
#define XB_XSUB(j)  (1280 + 64 * (j))
#define XB_XGEN(j)  (2304 + 64 * (j))
#define XB_TOP      3328
#define XB_TOPGEN   3392
#define XCD_BAR_WORDS 3456
#define XB_SPIN_CAP (1u << 18)

__device__ __forceinline__ unsigned xb_ld(unsigned* p)              { return __hip_atomic_load(p, __ATOMIC_RELAXED, __HIP_MEMORY_SCOPE_AGENT); }
__device__ __forceinline__ unsigned xb_add(unsigned* p, unsigned v) { return __hip_atomic_fetch_add(p, v, __ATOMIC_RELAXED, __HIP_MEMORY_SCOPE_AGENT); }
__device__ __forceinline__ unsigned xb_xcc_id() { return (unsigned)__builtin_amdgcn_s_getreg((3 << 11) | 20) & 0xFu; }
#define XB_SPIN(cond, bar) do { unsigned _sp = 0; while (cond) { __builtin_amdgcn_s_sleep(1); \
    if ((++_sp & 255u) == 0u) { if (xb_ld(&(bar)[XB_TMO])) break; if (_sp > XB_SPIN_CAP) { atomicAdd(&(bar)[XB_TMO], 1u); break; } } } } while (0)

struct XcdBarrier {
    unsigned* bar; unsigned x;
    volatile LAS unsigned* st;
};

__device__ __forceinline__ XcdBarrier xcd_barrier_post(unsigned* bar, volatile LAS unsigned* st) {
    XcdBarrier b; b.bar = bar; b.x = xb_xcc_id(); b.st = st;
    if (mk_tid() == 0) (void)xb_add(&bar[XB_XCNT(b.x)], 1u);
    return b;
}
__device__ __forceinline__ void xcd_barrier_complete(unsigned* bar, unsigned x, unsigned& nloc, unsigned& nx) {
    const unsigned G = gridDim.x * gridDim.y * gridDim.z;
    unsigned sum, cnt, mine, sp = 0u;
    for (;;) {
        sum = 0u; cnt = 0u; mine = 0u;
#pragma unroll
        for (unsigned j = 0; j < 16; ++j) { const unsigned c = xb_ld(&bar[XB_XCNT(j)]); sum += c; cnt += (c > 0u) ? 1u : 0u; mine = (j == x) ? c : mine; }
        if (sum == G) break;
        __builtin_amdgcn_s_sleep(1);
        if ((++sp & 255u) == 0u) { if (xb_ld(&bar[XB_TMO])) break; if (sp > XB_SPIN_CAP) { atomicAdd(&bar[XB_TMO], 1u); break; } }
    }
    nloc = mine > 0u ? mine : 1u; nx = cnt > 0u ? cnt : 1u;
}

__device__ __forceinline__ void xcd_barrier(const XcdBarrier& b) {
    asm volatile("s_waitcnt vmcnt(0)" ::: "memory");
    __syncthreads();
    if (mk_tid() == 0) {
        unsigned* bar = b.bar;
        __builtin_amdgcn_s_waitcnt(0);
        unsigned nloc = b.st[0], nx = b.st[1];
        if (nloc == 0u) { xcd_barrier_complete(bar, b.x, nloc, nx); b.st[0] = nloc; b.st[1] = nx; }
        const unsigned old = xb_add(&bar[XB_XSUB(b.x)], 1u);
        const unsigned gen = old / nloc;
        if (old + 1u == (gen + 1u) * nloc) {
            __builtin_amdgcn_fence(__ATOMIC_RELEASE, "agent");
            asm volatile("s_waitcnt vmcnt(0)" ::: "memory");
            const unsigned og = xb_add(&bar[XB_TOP], 1u);
            const unsigned tg = og / nx;
            if (og + 1u == (tg + 1u) * nx) xb_add(&bar[XB_TOPGEN], 1u);
            else XB_SPIN(xb_ld(&bar[XB_TOPGEN]) == tg, bar);
            __builtin_amdgcn_fence(__ATOMIC_ACQUIRE, "agent");
            xb_add(&bar[XB_XGEN(b.x)], 1u);
            asm volatile("s_waitcnt vmcnt(0)" ::: "memory");
        } else {
            XB_SPIN(xb_ld(&bar[XB_XGEN(b.x)]) == gen, bar);
            __builtin_amdgcn_fence(__ATOMIC_ACQUIRE, "agent");
            asm volatile("s_waitcnt vmcnt(0)" ::: "memory");
        }
    }
    __syncthreads();
}
struct TileDesc { const float* W; const float* nrm; bf16_t* Wt; int ldw, K, k0, n0src, n0dst; };
DI TileDesc p0_tile(const Ctx& c, unsigned char* ws, int t) {
    TileDesc d;
    if (t < 896) { const int kt = t / 56, nt = t % 56, n0 = nt * 64; d = TileDesc{c.w_in, c.norm_mix, (bf16_t*)(ws + WS_WIN), INDIM, D, kt * 64, n0 < 1536 ? n0 : n0 + 8, n0}; return d; }
    t -= 896;
    if (t < 256) { d = TileDesc{c.w_out, nullptr, (bf16_t*)(ws + WS_WOUT), D, D, (t / 16) * 64, (t % 16) * 64, (t % 16) * 64}; return d; }
    t -= 256;
    if (t < 1024) { d = TileDesc{c.w_up, c.norm_mlp, (bf16_t*)(ws + WS_WUP), DFF, D, (t / 64) * 64, (t % 64) * 64, (t % 64) * 64}; return d; }
    t -= 1024;
    if (t < 1024) { d = TileDesc{c.w_down, nullptr, (bf16_t*)(ws + WS_WDN), D, DFF, (t / 16) * 64, (t % 16) * 64, (t % 16) * 64}; return d; }
    t -= 1024;
    if (t < 256) { d = TileDesc{c.w_ple_gate, c.norm_ple, (bf16_t*)(ws + WS_WG), D, D, (t / 16) * 64, (t % 16) * 64, (t % 16) * 64}; return d; }
    t -= 256;
    d = TileDesc{c.w_ple_proj, nullptr, (bf16_t*)(ws + WS_WP), D, PLE, (t / 16) * 64, (t % 16) * 64, (t % 16) * 64}; return d;
}
DI void tile_load(const TileDesc& d, float (&v)[8]) {
    const int tid = mk_tid();
#pragma unroll
    for (int i = 0; i < 8; ++i) { const int kk = i * 8 + (tid >> 6), nn = tid & 63; float x = d.W[(size_t)(d.k0 + kk) * d.ldw + d.n0src + nn]; if (d.nrm) x *= d.nrm[d.k0 + kk]; v[i] = x; }
}
DI void tile_store(const TileDesc& d, const float (&v)[8], LAS float* tile) {
    const int tid = mk_tid();
#pragma unroll
    for (int i = 0; i < 8; ++i) { const int kk = i * 8 + (tid >> 6), nn = tid & 63; tile[kk * 65 + nn] = v[i]; }
    __syncthreads();
    { const int nn = tid >> 3, kq = tid & 7; float f[8];
#pragma unroll
      for (int e = 0; e < 8; ++e) f[e] = tile[(kq * 8 + e) * 65 + nn];
      *(u32x4*)(d.Wt + (size_t)(d.n0dst + nn) * d.K + d.k0 + kq * 8) = pack8(f); }
    __syncthreads();
}
DI void p0_phase(const Ctx& c, LAS unsigned char* lds) {
    const int tid = mk_tid(), lane = tid & 63, wid = tid >> 6;
    unsigned char* ws = c.ws;
    float* ctl = (float*)(ws + WS_CTL);
    bf16_t* XB = (bf16_t*)(ws + WS_A); bf16_t* PB = (bf16_t*)(ws + WS_PB);
    LAS float* wab = (LAS float*)lds;
    for (int i = tid; i < 1024 * 8; i += NTHREADS) { const int k = i >> 3, j = i & 7; wab[i] = c.w_in[(size_t)k * INDIM + 1536 + j] * c.norm_mix[k]; }
    __syncthreads();
    float xn[16];
    { const int row = blockIdx.x * 8 + wid; if (row < NT) { const float* xr = row < NTP ? c.x_prompt + (size_t)row * D : c.x_sample + (size_t)(row - NTP) * D;
#pragma unroll
        for (int i = 0; i < 16; ++i) xn[i] = xr[i * 64 + lane]; } }
    for (int row = blockIdx.x * 8 + wid; row < NT; row += gridDim.x * 8) {
        const float* xr = row < NTP ? c.x_prompt + (size_t)row * D : c.x_sample + (size_t)(row - NTP) * D;
        const float* pr = row < NTP ? c.p_prompt + (size_t)row * PLE : c.p_sample + (size_t)(row - NTP) * PLE;
        float xc[16];
#pragma unroll
        for (int i = 0; i < 16; ++i) xc[i] = xn[i];
        { const int rown = row + gridDim.x * 8; if (rown < NT) { const float* xq = rown < NTP ? c.x_prompt + (size_t)rown * D : c.x_sample + (size_t)(rown - NTP) * D;
#pragma unroll
            for (int i = 0; i < 16; ++i) xn[i] = xq[i * 64 + lane]; } }
        float ss = 0.f, dot[8];
#pragma unroll
        for (int j = 0; j < 8; ++j) dot[j] = 0.f;
#pragma unroll
        for (int i = 0; i < 16; ++i) { const int k = i * 64 + lane; const float xv = xc[i]; ss += xv * xv;
            const f32x4 w0 = *(const LAS f32x4*)(wab + k * 8), w1 = *(const LAS f32x4*)(wab + k * 8 + 4);
            dot[0] += xv * w0[0]; dot[1] += xv * w0[1]; dot[2] += xv * w0[2]; dot[3] += xv * w0[3]; dot[4] += xv * w1[0]; dot[5] += xv * w1[1]; dot[6] += xv * w1[2]; dot[7] += xv * w1[3]; }
#pragma unroll
        for (int o = 32; o >= 1; o >>= 1) { ss += __shfl_xor(ss, o);
#pragma unroll
            for (int j = 0; j < 8; ++j) dot[j] += __shfl_xor(dot[j], o); }
        const float rs = rsqrtf(ss * (1.0f / 1024.0f) + EPS);
#pragma unroll
        for (int i = 0; i < 4; ++i) { const int k0 = i * 256 + lane * 4; const f32x4 v = *(const f32x4*)(xr + k0); u32x2 w; w.x = pk2(v[0], v[1]); w.y = pk2(v[2], v[3]); *(u32x2*)(XB + (size_t)row * D + k0) = w; }
        { const f32x4 v = *(const f32x4*)(pr + lane * 4); u32x2 w; w.x = pk2(v[0], v[1]); w.y = pk2(v[2], v[3]); *(u32x2*)(PB + (size_t)row * PLE + lane * 4) = w; }
        if (lane == 0) { ctl[CTL_RS0 + row] = rs; ctl[CTL_SS1 + row] = 0.f; ctl[CTL_SS2 + row] = 0.f; ctl[CTL_SS3 + row] = 0.f; }
        if (lane < 4) { const float da = lane == 0 ? dot[0] : lane == 1 ? dot[1] : lane == 2 ? dot[2] : dot[3]; const float db = lane == 0 ? dot[4] : lane == 1 ? dot[5] : lane == 2 ? dot[6] : dot[7];
            const float xa = da * rs + c.dt_bias[lane]; const float sp = xa > 20.f ? xa : log1pf(__expf(xa));
            ctl[CTL_LA + (size_t)row * 4 + lane] = -__expf(c.a_log[lane]) * sp; ctl[CTL_BETA + (size_t)row * 4 + lane] = sigmoidf_(db * rs); }
    }
    __syncthreads();
    LAS float* tile = (LAS float*)lds;
    {
        int tl = blockIdx.x; float va[8], vb[8];
        if (tl < 3520) { TileDesc d = p0_tile(c, ws, tl); tile_load(d, va);
            for (;;) {
                const int tn = tl + gridDim.x; TileDesc dn = d;
                if (tn < 3520) { dn = p0_tile(c, ws, tn); tile_load(dn, vb); }
                tile_store(d, va, tile);
                if (tn >= 3520) break;
#pragma unroll
                for (int i = 0; i < 8; ++i) va[i] = vb[i];
                d = dn; tl = tn;
            } }
    }
}

constexpr int L_QH = 0, L_KH = 17408, L_RT = 34816, L_AM = 71680, L_TB = 89088, L_G = 98304, L_WC = 98816, L_SSP = 104960;
DI void prep_chunk(const Ctx& c, LAS unsigned char* lds, int ch) {
    int tid = mk_tid(); asm volatile("" : "+v"(tid));
    const int lane = tid & 63, wid = __builtin_amdgcn_readfirstlane(tid >> 6);
    const int h = ch & 3, n = (ch >> 2) & 31, b = ch >> 7;
    const int row0 = b * 2048 + n * 64;
    float* ctl = (float*)(c.ws + WS_CTL);
    const bf16_t* PROJ = (const bf16_t*)(c.ws + WS_B);
    bf16_t* QP = (bf16_t*)c.out + (size_t)ch * 8192; bf16_t* WP = (bf16_t*)c.out + (size_t)(1024 + ch) * 8192; bf16_t* KTP = (bf16_t*)c.out + (size_t)(2048 + ch) * 8192;
    bf16_t* UT = (bf16_t*)(c.ws + WS_C) + (size_t)ch * 8192; bf16_t* QKP = (bf16_t*)(c.ws + WS_C) + (size_t)1024 * 8192 + (size_t)ch * 4096;
    LAS float* G = (LAS float*)(lds + L_G); LAS float* BT = G + 64;
    LAS float* WC = (LAS float*)(lds + L_WC);
    LAS float* SSP = (LAS float*)(lds + L_SSP);
    for (int i = tid; i < 1536; i += NTHREADS) { const int ten = i >> 9, jj = (i >> 7) & 3, cc = i & 127; WC[i] = c.w_conv_qkv[jj * 1536 + ten * 512 + h * 128 + cc]; }
    if (wid == 0) {
        float la = ctl[CTL_LA + (size_t)(row0 + lane) * 4 + h];
#pragma unroll
        for (int o = 1; o < 64; o <<= 1) { const float t = __int_as_float(__builtin_amdgcn_ds_bpermute(((lane - o) & 63) * 4, __float_as_int(la))); if (lane >= o) la += t; }
        G[lane] = la; BT[lane] = ctl[CTL_BETA + (size_t)(row0 + lane) * 4 + h];
        if (lane == 63) __hip_atomic_store(ctl + CTL_GL + ch, la, __ATOMIC_RELAXED, __HIP_MEMORY_SCOPE_AGENT);
    }
    {
        const int tok = lane, cg8 = wid;
        const int t_abs = n * 64 + tok;
        u32x4 xr[3][4][2];
#pragma unroll
        for (int ten = 0; ten < 3; ++ten)
#pragma unroll
            for (int j = 0; j < 4; ++j) { const int tt = t_abs - 3 + j;
                if (tt >= 0) { const bf16_t* src = PROJ + (size_t)(b * 2048 + tt) * NPROJ + ten * 512 + h * 128 + cg8 * 16; xr[ten][j][0] = *(const u32x4*)src; xr[ten][j][1] = *(const u32x4*)(src + 8); }
                else { xr[ten][j][0] = (u32x4){0u, 0u, 0u, 0u}; xr[ten][j][1] = (u32x4){0u, 0u, 0u, 0u}; } }
        __syncthreads();
        const float g = G[tok], bt = BT[tok];
        const float eg = __expf(g);
        float a[3][16];
#pragma unroll
        for (int ten = 0; ten < 3; ++ten) {
#pragma unroll
            for (int e = 0; e < 16; ++e) a[ten][e] = 0.f;
#pragma unroll
            for (int j = 0; j < 4; ++j) { float x[16]; unpack8(xr[ten][j][0], x); unpack8(xr[ten][j][1], x + 8);
                const LAS float* wj = WC + (ten * 4 + j) * 128 + cg8 * 16;
#pragma unroll
                for (int q = 0; q < 4; ++q) { const f32x4 w = *(const LAS f32x4*)(wj + 4 * q); a[ten][4 * q] += x[4 * q] * w[0]; a[ten][4 * q + 1] += x[4 * q + 1] * w[1]; a[ten][4 * q + 2] += x[4 * q + 2] * w[2]; a[ten][4 * q + 3] += x[4 * q + 3] * w[3]; } }
#pragma unroll
            for (int e = 0; e < 16; ++e) a[ten][e] = siluf_(a[ten][e]);
        }
        { float sq = 0.f, sk = 0.f;
#pragma unroll
          for (int e = 0; e < 16; ++e) { sq += a[0][e] * a[0][e]; sk += a[1][e] * a[1][e]; }
          SSP[cg8 * 64 + tok] = sq; SSP[512 + cg8 * 64 + tok] = sk; }
        __syncthreads();
        { float sq = 0.f, sk = 0.f;
#pragma unroll
          for (int w = 0; w < 8; ++w) { sq += SSP[w * 64 + tok]; sk += SSP[512 + w * 64 + tok]; }
          const float scq = rsqrtf(sq + EPS) * 0.08838834764831845f, sck = rsqrtf(sk + EPS);
#pragma unroll
          for (int e = 0; e < 16; ++e) { a[0][e] *= scq; a[1][e] *= sck; } }
        {
            LAS unsigned char* q = lds + L_QH + tok * 272 + cg8 * 32;
            *(LAS u32x4*)q = pack8(a[0]); *(LAS u32x4*)(q + 16) = pack8(a[0] + 8);
            float p[16];
#pragma unroll
            for (int e = 0; e < 16; ++e) p[swap23(e)] = a[0][e] * eg;
            bf16_t* dst = QP + tok * 128 + cg8 * 16; st16_wt(dst, pack8(p)); st16_wt(dst + 8, pack8(p + 8));
        }
        {
            LAS unsigned char* q = lds + L_KH + tok * 272 + cg8 * 32;
            *(LAS u32x4*)q = pack8(a[1]); *(LAS u32x4*)(q + 16) = pack8(a[1] + 8);
            const float f = bt * eg;
#pragma unroll
            for (int e = 0; e < 16; ++e) *(LAS bf16_t*)(lds + L_RT + (128 + cg8 * 16 + e) * 144 + tok * 2) = f2bf(a[1][e] * f);
        }
#pragma unroll
        for (int e = 0; e < 16; ++e) *(LAS bf16_t*)(lds + L_RT + (cg8 * 16 + e) * 144 + tok * 2) = f2bf(a[2][e] * bt);
    }
    __syncthreads();
    {
        int r = lane & 31, hh = lane >> 5; asm volatile("" : "+v"(r), "+v"(hh));
        const int blk = wid & 3, I = (blk == 1 || blk == 2) ? 1 : 0, J = (blk == 2 || blk == 3) ? 1 : 0; const bool isq = wid >= 4;
        f32x16 x;
#pragma unroll
        for (int i = 0; i < 16; ++i) x[i] = 0.f;
        if (blk != 3) {
            LAS unsigned char* Ab = lds + (isq ? L_QH : L_KH) + (32 * I + r) * 272 + hh * 16; LAS unsigned char* Bb = lds + L_KH + (32 * J + r) * 272 + hh * 16;
#pragma unroll
            for (int s = 0; s < 8; ++s) { const bf16x8 av = *(LAS bf16x8*)(Ab + s * 32), bv = *(LAS bf16x8*)(Bb + s * 32); x = isq ? MFMA32(bv, av, x) : MFMA32(av, bv, x); }
        }
        if (!isq) {
            const int jj = 32 * J + r; const float gj = G[jj];
            if (blk != 3) {
#pragma unroll
                for (int i = 0; i < 16; ++i) { const int ii = 32 * I + crow(i, hh); const float d = __expf(fminf(G[ii] - gj, 0.f)); ((LAS float*)(lds + L_AM))[ii * 68 + jj] = (ii > jj) ? BT[ii] * x[i] * d : 0.f; } }
        } else {
            const int ii = 32 * I + r; const float gi = G[ii]; float f[16];
#pragma unroll
            for (int i = 0; i < 16; ++i) { const int jj = 32 * J + crow(i, hh); const float d = __expf(fminf(gi - G[jj], 0.f)); f[i] = (ii >= jj && blk != 3) ? x[i] * d : 0.f; }
            bf16_t* dst = QKP + ii * 64 + 32 * J; st16_wt(dst + 8 * hh, pack8(f)); st16_wt(dst + 16 + 8 * hh, pack8(f + 8));
        }
    }
    {
        const int dk = tid & 127, tq = tid >> 7; const float glast = G[63]; float f[16];
#pragma unroll
        for (int t = 0; t < 16; ++t) { const int tk = 16 * tq + t; f[swap23(t)] = bf2f(*(LAS bf16_t*)(lds + L_KH + tk * 272 + dk * 2)) * __expf(glast - G[tk]); }
        bf16_t* dst = KTP + dk * 64 + 16 * tq; st16_wt(dst, pack8(f)); st16_wt(dst + 8, pack8(f + 8));
    }
    __syncthreads();
#ifndef NOINV
    if (wid == 0) {
        f32x2v t2[32]; f32x4 ab[2][16]; float lanef = (float)lane; asm volatile("" : "+v"(lanef));
        int zoff; asm volatile("v_mov_b32 %0, 0" : "=v"(zoff));
        LAS float* AM = (LAS float*)(lds + L_AM) + zoff;
        t2[0].x = fmaxf(1.0f - fabsf(lanef), 0.f); t2[0].y = 0.f;
        ab[1][0] = *(LAS f32x4*)(AM + 68);
#pragma unroll
        for (int i = 1; i < 64; ++i) {
            if (i + 1 < 64) {
#pragma unroll
                for (int q = 0; q < (i + 4) / 4; ++q) ab[(i + 1) & 1][q] = *(LAS f32x4*)(AM + (i + 1) * 68 + 4 * q); }
            __builtin_amdgcn_sched_barrier(0);
            f32x2v acc2 = {fmaxf(1.0f - fabsf(lanef - (float)i), 0.f), 0.f};
#pragma unroll
            for (int q = 0; q < (i + 3) / 4; ++q) { const f32x4 av = ab[i & 1][q]; const int j = 4 * q;
                if (j + 1 < i) acc2 -= (f32x2v){av[0], av[1]} * t2[j / 2]; else acc2.x -= av[0] * t2[j / 2].x;
                if (j + 3 < i) acc2 -= (f32x2v){av[2], av[3]} * t2[j / 2 + 1]; else if (j + 2 < i) acc2.x -= av[2] * t2[j / 2 + 1].x; }
            const float ti = acc2.x + acc2.y;
            if (i & 1) t2[i / 2].y = ti; else { t2[i / 2].x = ti; t2[i / 2].y = 0.f; }
            __builtin_amdgcn_sched_barrier(0);
        }
#pragma unroll
        for (int i = 0; i < 32; ++i) { *(LAS bf16_t*)(lds + L_TB + (2 * i) * 144 + lane * 2) = f2bf(t2[i].x); *(LAS bf16_t*)(lds + L_TB + (2 * i + 1) * 144 + lane * 2) = f2bf(t2[i].y); }
    }
#endif
    __syncthreads();
    {
        int r = lane & 31, hh = lane >> 5; asm volatile("" : "+v"(r), "+v"(hh));
#pragma unroll
        for (int tb = 0; tb < 2; ++tb) {
            f32x16 x;
#pragma unroll
            for (int i = 0; i < 16; ++i) x[i] = 0.f;
#pragma unroll
            for (int s = 0; s < 4; ++s) if (s < 2 || tb == 1) {
                const bf16x8 tf = *(LAS bf16x8*)(lds + L_TB + (32 * tb + r) * 144 + (16 * s + 8 * hh) * 2), rf = *(LAS bf16x8*)(lds + L_RT + (32 * wid + r) * 144 + (16 * s + 8 * hh) * 2);
                x = (wid < 4) ? MFMA32(tf, rf, x) : MFMA32(rf, tf, x); }
            float f[16];
#pragma unroll
            for (int i = 0; i < 16; ++i) f[i] = x[i];
            bf16_t* dst = (wid < 4) ? UT + (32 * wid + r) * 64 + 32 * tb : WP + (32 * tb + r) * 128 + 32 * (wid - 4);
            st16_wt(dst + 8 * hh, pack8(f)); st16_wt(dst + 16 + 8 * hh, pack8(f + 8));
        }
    }
    asm volatile("s_waitcnt vmcnt(0)" ::: "memory");
    __syncthreads();
    if (tid == 0) __hip_atomic_store((unsigned*)(c.ws + WS_FLAGS) + ch, 1u, __ATOMIC_RELAXED, __HIP_MEMORY_SCOPE_AGENT);
}

DI void sample_gdn2(const Ctx& c, LAS unsigned char* lds, int pair) {
    const int tid = mk_tid(), lane = tid & 63, half = tid >> 8, ht = tid & 255, hw = (tid >> 6) & 3;
    const int item = pair * 2 + half, b = item >> 2, h = item & 3;
    float* ctl = (float*)(c.ws + WS_CTL);
    const bf16_t* PROJ = (const bf16_t*)(c.ws + WS_B); bf16_t* OY = (bf16_t*)(c.ws + WS_A);
    LAS float* vals = (LAS float*)lds + half * 3072;
    LAS float* red = vals + 1536;
    LAS float* red2 = red + 256;
    LAS float* os = red2 + 256;
    const int row0 = NTP + b * 4;
    for (int i = ht; i < 1536; i += 256) { const int ten = i >> 9, tok = (i >> 7) & 3, ch = i & 127; const int col = ten * 512 + h * 128 + ch; float a = 0.f;
#pragma unroll
        for (int j = 0; j < 4; ++j) { const int idx = tok + j; const float xv = idx < 3 ? c.state_gdn_conv[((size_t)b * 3 + idx) * 1536 + col] : bf2f(PROJ[(size_t)(row0 + idx - 3) * NPROJ + col]); a += xv * c.w_conv_qkv[j * 1536 + col]; }
        vals[i] = siluf_(a); }
    __syncthreads();
#pragma unroll
    for (int rep = 0; rep < 2; ++rep) { const int pr = hw * 2 + rep, ten = pr >> 2, tok = pr & 3; LAS float* v = vals + ten * 512 + tok * 128; const float a0 = v[lane], a1 = v[lane + 64]; float ss = a0 * a0 + a1 * a1;
#pragma unroll
        for (int o = 32; o >= 1; o >>= 1) ss += __shfl_xor(ss, o);
        const float sc = rsqrtf(ss + EPS) * (ten == 0 ? 0.08838834764831845f : 1.0f); v[lane] = a0 * sc; v[lane + 64] = a1 * sc; }
    __syncthreads();
    const int e = ht & 127, part = ht >> 7;
    float s[64];
    const float* S0 = c.state_gdn + ((size_t)item * 128 + part * 64) * 128 + e;
#pragma unroll
    for (int i = 0; i < 64; ++i) s[i] = S0[(size_t)i * 128];
#pragma unroll 1
    for (int t = 0; t < 4; ++t) {
        const float a = __expf(ctl[CTL_LA + (size_t)(row0 + t) * 4 + h]), bt = ctl[CTL_BETA + (size_t)(row0 + t) * 4 + h];
        LAS float* qv = vals + t * 128 + part * 64; LAS float* kv = vals + 512 + t * 128 + part * 64;
        float p = 0.f;
#pragma unroll
        for (int i = 0; i < 64; ++i) { s[i] *= a; p += s[i] * kv[i]; }
        red[part * 128 + e] = p;
        __syncthreads();
        const float rr = bt * (vals[1024 + t * 128 + e] - (red[e] + red[128 + e]));
        float po = 0.f;
#pragma unroll
        for (int i = 0; i < 64; ++i) { s[i] += kv[i] * rr; po += s[i] * qv[i]; }
        red2[part * 128 + e] = po;
        __syncthreads();
        if (part == 0) os[t * 128 + e] = red2[e] + red2[128 + e];
    }
    float* Sout = c.out + OFF_GS + ((size_t)item * 128 + part * 64) * 128 + e;
#pragma unroll
    for (int i = 0; i < 64; ++i) Sout[(size_t)i * 128] = s[i];
    __syncthreads();
#pragma unroll
    for (int rep = 0; rep < 2; ++rep) { const int tok = part * 2 + rep; float ss = 0.f;
        for (int i = 0; i < 128; ++i) { const float v = os[tok * 128 + i]; ss += v * v; }
        const float rs = rsqrtf(ss * (1.0f / 128.0f) + EPS); const int row = row0 + tok;
        const float z = bf2f(PROJ[(size_t)row * NPROJ + 1536 + h * 128 + e]);
        OY[(size_t)row * D + h * 128 + e] = f2bf(os[tok * 128 + e] * rs * c.w_gdn_norm[e] * siluf_(z)); }
    __syncthreads();
}

DI void shortconv_items(const Ctx& c, int item_lo, int item_hi, int bfirst, int bcount) {
    const int tid = mk_tid();
    const bf16_t* PROJ = (const bf16_t*)(c.ws + WS_B); bf16_t* OY = (bf16_t*)(c.ws + WS_A);
    for (int item = item_lo + bfirst * NTHREADS + tid; item < item_hi; item += bcount * NTHREADS) {
        const int row = item >> 6, c8 = (item & 63) * 8;
        const bool prm = row < NTP; const int sb = prm ? (row >> 11) : ((row - NTP) >> 2); const int t = prm ? (row & 2047) : ((row - NTP) & 3); const int T = prm ? 2048 : 4;
        float bv[8]; unpack8(*(const u32x4*)(PROJ + (size_t)row * NPROJ + 2048 + c8), bv);
        float acc[8], cur[8];
#pragma unroll
        for (int e = 0; e < 8; ++e) { acc[e] = 0.f; cur[e] = 0.f; }
#pragma unroll
        for (int d = 0; d < 3; ++d) { const int tt = t - 2 + d; float sc[8];
            if (tt >= 0) { float cv[8], hv[8]; const bf16_t* src = PROJ + (size_t)(row - (2 - d)) * NPROJ + c8; unpack8(*(const u32x4*)(src + 2560), cv); unpack8(*(const u32x4*)(src + 3072), hv);
#pragma unroll
                for (int e = 0; e < 8; ++e) sc[e] = cv[e] * hv[e]; }
            else if (!prm) { const float* sp = c.state_sc_conv + ((size_t)sb * 2 + (2 + tt)) * 512 + c8; const f32x4 s0 = *(const f32x4*)sp, s1 = *(const f32x4*)(sp + 4);
#pragma unroll
                for (int e = 0; e < 4; ++e) { sc[e] = s0[e]; sc[4 + e] = s1[e]; } }
            else {
#pragma unroll
                for (int e = 0; e < 8; ++e) sc[e] = 0.f; }
            const float* wp = c.w_conv_sc + d * 512 + c8; const f32x4 w0 = *(const f32x4*)wp, w1 = *(const f32x4*)(wp + 4);
#pragma unroll
            for (int e = 0; e < 4; ++e) { acc[e] += sc[e] * w0[e]; acc[4 + e] += sc[4 + e] * w1[e]; }
            if (d == 2) {
#pragma unroll
                for (int e = 0; e < 8; ++e) cur[e] = sc[e]; } }
#pragma unroll
        for (int e = 0; e < 8; ++e) acc[e] *= bv[e];
        *(u32x4*)(OY + (size_t)row * D + 512 + c8) = pack8(acc);
        if (t >= T - 2) { float* dst = (prm ? c.out + OFF_SCP : c.out + OFF_SCS) + ((size_t)sb * 2 + (t - (T - 2))) * 512 + c8;
            *(f32x4*)dst = (f32x4){cur[0], cur[1], cur[2], cur[3]}; *(f32x4*)(dst + 4) = (f32x4){cur[4], cur[5], cur[6], cur[7]}; }
    }
}
DI void conv_state_copies(const Ctx& c, int bfirst, int bcount) {
    const int tid = mk_tid();
    const bf16_t* PROJ = (const bf16_t*)(c.ws + WS_B);
    for (int idx = bfirst * NTHREADS + tid; idx < 136 * 4608; idx += bcount * NTHREADS) {
        const int seq = idx / 4608, rem = idx % 4608, j = rem / 1536, col = rem % 1536;
        if (seq < 8) c.out[OFF_GCP + idx] = bf2f(PROJ[(size_t)(seq * 2048 + 2045 + j) * NPROJ + col]);
        else c.out[OFF_GCS + (idx - 8 * 4608)] = bf2f(PROJ[(size_t)(NTP + (seq - 8) * 4 + 1 + j) * NPROJ + col]);
    }
}

constexpr int P3_BUF = 57344, P3_OB = 114688, L_XST = 148480, P3_WN = 148496;
DI void scan_seq(const Ctx& c, LAS unsigned char* lds, int bh) {
    const int tid = mk_tid(), lane = tid & 63, wid = tid >> 6, r = lane & 31, hh = lane >> 5;
    const int b = bh >> 2, h = bh & 3;
    const bool loader = wid >= 4; const int lt = tid & 255;
    const float* ctl = (const float*)(c.ws + WS_CTL);
    const bf16_t* PROJ = (const bf16_t*)(c.ws + WS_B); bf16_t* OY = (bf16_t*)(c.ws + WS_A);
    LAS float* OB = (LAS float*)(lds + P3_OB);
    const int ch0 = b * 128 + h;
    const u32x4* gQ = (const u32x4*)((const bf16_t*)c.out) ; const u32x4* gW = gQ + (size_t)1024 * 1024; const u32x4* gKT = gQ + (size_t)2048 * 1024;
    const u32x4* gQK = (const u32x4*)((const bf16_t*)(c.ws + WS_C) + (size_t)1024 * 8192);
    const bf16_t* gUT = (const bf16_t*)(c.ws + WS_C);
    f32x16 S[4];
#pragma unroll
    for (int kt = 0; kt < 4; ++kt)
#pragma unroll
        for (int i = 0; i < 16; ++i) S[kt][i] = 0.f;
    const int e0 = 32 * (wid & 3);
    u32x4 zr[4]; u32x4 un[4]; float decn = 1.f;
#define P3_DMA(gp, ldsp) __builtin_amdgcn_global_load_lds((const unsigned*)(gp), (LAS unsigned*)(ldsp), 16, 0, 0)
    const int lw = (wid & 3) * 1024;
    int srcA[4], srcB[4];
#pragma unroll
    for (int i = 0; i < 4; ++i) { const int q = lt + 256 * i; const int rowA = q >> 4, rowB = q >> 3; srcA[i] = rowA * 16 + ((q & 15) ^ (rowA & 15)); srcB[i] = rowB * 8 + ((q & 7) ^ ((rowB >> 1) & 7)); }
    const int gtok = lt >> 2, gpart = lt & 3;
    if (tid < 128) ((LAS float*)(lds + P3_WN))[tid] = c.w_gdn_norm[tid];
    unsigned* const flags = (unsigned*)(c.ws + WS_FLAGS);
#define P3_WAIT(chx) do { unsigned sp_ = 0u; while (__hip_atomic_load(flags + (chx), __ATOMIC_RELAXED, __HIP_MEMORY_SCOPE_AGENT) == 0u) { __builtin_amdgcn_s_sleep(2); if (++sp_ > (1u << 22)) break; } __builtin_amdgcn_fence(__ATOMIC_ACQUIRE, "agent"); } while (0)
    P3_WAIT(ch0);
    if (loader) {
        const size_t t0 = (size_t)ch0 * 1024;
#pragma unroll
        for (int i = 0; i < 4; ++i) { P3_DMA(gW + t0 + srcA[i], lds + lw + 4096 * i); P3_DMA(gQ + t0 + srcA[i], lds + 16384 + lw + 4096 * i); P3_DMA(gKT + t0 + srcB[i], lds + 32768 + lw + 4096 * i); }
#pragma unroll
        for (int i = 0; i < 2; ++i) P3_DMA(gQK + (size_t)ch0 * 512 + srcB[i], lds + 49152 + lw + 4096 * i);
        asm volatile("s_waitcnt vmcnt(0)" ::: "memory");
    } else {
        const bf16_t* up = gUT + (size_t)ch0 * 8192 + (e0 + r) * 64 + 8 * hh;
        un[0] = *(const u32x4*)up; un[1] = *(const u32x4*)(up + 16); un[2] = *(const u32x4*)(up + 32); un[3] = *(const u32x4*)(up + 48);
        decn = __expf(__hip_atomic_load(ctl + CTL_GL + ch0, __ATOMIC_RELAXED, __HIP_MEMORY_SCOPE_AGENT));
    }
    const int rw = r & 15, rk = (r >> 1) & 7;
    if (loader) {
#pragma unroll 1
        for (int n = 0; n <= 32; ++n) {
            __syncthreads();
            if (n < 31) { P3_WAIT(ch0 + 4 * (n + 1)); const size_t t1 = (size_t)(ch0 + 4 * (n + 1)) * 1024; LAS unsigned char* Bn = lds + ((n + 1) & 1) * P3_BUF;
#pragma unroll
                for (int i = 0; i < 4; ++i) { P3_DMA(gW + t1 + srcA[i], Bn + lw + 4096 * i); P3_DMA(gQ + t1 + srcA[i], Bn + 16384 + lw + 4096 * i); P3_DMA(gKT + t1 + srcB[i], Bn + 32768 + lw + 4096 * i); }
#pragma unroll
                for (int i = 0; i < 2; ++i) P3_DMA(gQK + (size_t)(ch0 + 4 * (n + 1)) * 512 + srcB[i], Bn + 49152 + lw + 4096 * i); }
            if (n >= 1) {
                const int row = b * 2048 + (n - 1) * 64 + gtok; LAS float* op = OB + gtok * 132 + gpart * 32;
                float o[32]; float ss = 0.f;
#pragma unroll
                for (int q = 0; q < 8; ++q) { const f32x4 v = *(LAS f32x4*)(op + 4 * q); o[4 * q] = v[0]; o[4 * q + 1] = v[1]; o[4 * q + 2] = v[2]; o[4 * q + 3] = v[3]; ss += (v[0] * v[0] + v[1] * v[1]) + (v[2] * v[2] + v[3] * v[3]); }
                ss += __shfl_xor(ss, 1); ss += __shfl_xor(ss, 2);
                const float rs = rsqrtf(ss * (1.0f / 128.0f) + EPS);
                float z[32]; unpack8(zr[0], z); unpack8(zr[1], z + 8); unpack8(zr[2], z + 16); unpack8(zr[3], z + 24);
#pragma unroll
                for (int e = 0; e < 32; ++e) o[e] = o[e] * rs * ((LAS float*)(lds + P3_WN))[gpart * 32 + e] * siluf_(z[e]);
                bf16_t* dst = OY + (size_t)row * D + h * 128 + gpart * 32;
                *(u32x4*)dst = pack8(o); *(u32x4*)(dst + 8) = pack8(o + 8); *(u32x4*)(dst + 16) = pack8(o + 16); *(u32x4*)(dst + 24) = pack8(o + 24);
            }
            __syncthreads();
            asm volatile("s_waitcnt vmcnt(0)" ::: "memory");
            if (n < 32) { const bf16_t* zp = PROJ + (size_t)(b * 2048 + n * 64 + gtok) * NPROJ + 1536 + h * 128 + gpart * 32;
                zr[0] = *(const u32x4*)zp; zr[1] = *(const u32x4*)(zp + 8); zr[2] = *(const u32x4*)(zp + 16); zr[3] = *(const u32x4*)(zp + 24); }
        }
    } else {
#pragma unroll 1
        for (int n = 0; n <= 32; ++n) {
            __syncthreads();
            LAS unsigned char* B = lds + (n & 1) * P3_BUF;
            f32x16 O[2];
            if (n < 32) {
                const f32x16 zero16 = {0.f, 0.f, 0.f, 0.f, 0.f, 0.f, 0.f, 0.f, 0.f, 0.f, 0.f, 0.f, 0.f, 0.f, 0.f, 0.f};
                f32x16 P[2]; P[0] = zero16; P[1] = zero16; O[0] = zero16; O[1] = zero16;
#pragma unroll
                for (int kt = 0; kt < 4; ++kt)
#pragma unroll
                    for (int s = 0; s < 2; ++s) { const bf16x8 sb = pack_step(S[kt], s);
#pragma unroll
                        for (int mi = 0; mi < 2; ++mi) { const int off = ((32 * mi + r) * 16 + ((4 * kt + 2 * s + hh) ^ rw)) * 16;
                            P[mi] = MFMA32(*(LAS bf16x8*)(B + off), sb, P[mi]); O[mi] = MFMA32(*(LAS bf16x8*)(B + 16384 + off), sb, O[mi]); } }
                bf16x8 vb[2][2];
#pragma unroll
                for (int tb = 0; tb < 2; ++tb) { float u[16]; unpack8(un[2 * tb], u); unpack8(un[2 * tb + 1], u + 8);
                    f32x16 vn;
#pragma unroll
                    for (int i = 0; i < 16; ++i) vn[i] = u[i] - P[tb][i];
                    vb[tb][0] = pack_step(vn, 0); vb[tb][1] = pack_step(vn, 1); }
                const float dec = decn;
                if (n < 31) { P3_WAIT(ch0 + 4 * (n + 1)); const bf16_t* up = gUT + (size_t)(ch0 + 4 * (n + 1)) * 8192 + (e0 + r) * 64 + 8 * hh;
                    un[0] = *(const u32x4*)up; un[1] = *(const u32x4*)(up + 16); un[2] = *(const u32x4*)(up + 32); un[3] = *(const u32x4*)(up + 48);
                    decn = __expf(__hip_atomic_load(ctl + CTL_GL + ch0 + 4 * (n + 1), __ATOMIC_RELAXED, __HIP_MEMORY_SCOPE_AGENT)); }
#pragma unroll
                for (int mi = 0; mi < 2; ++mi)
#pragma unroll
                    for (int tb = 0; tb <= mi; ++tb)
#pragma unroll
                        for (int s = 0; s < 2; ++s) O[mi] = MFMA32(*(LAS bf16x8*)(B + 49152 + ((32 * mi + r) * 8 + ((4 * tb + 2 * s + hh) ^ rk)) * 16), vb[tb][s], O[mi]);
#pragma unroll
                for (int kt = 0; kt < 4; ++kt) { S[kt] *= dec;
#pragma unroll
                    for (int tb = 0; tb < 2; ++tb)
#pragma unroll
                        for (int s = 0; s < 2; ++s) S[kt] = MFMA32(*(LAS bf16x8*)(B + 32768 + ((32 * kt + r) * 8 + ((4 * tb + 2 * s + hh) ^ rk)) * 16), vb[tb][s], S[kt]); }
            }
            __syncthreads();
            if (n < 32) {
#pragma unroll
                for (int mi = 0; mi < 2; ++mi)
#pragma unroll
                    for (int i = 0; i < 16; ++i) OB[(32 * mi + crow(i, hh)) * 132 + e0 + r] = O[mi][i];
            }
        }
    }
    if (!loader) { float* So = c.out + OFF_GP + (size_t)bh * 16384;
#pragma unroll
        for (int kt = 0; kt < 4; ++kt)
#pragma unroll
            for (int i = 0; i < 16; ++i) So[(32 * kt + crow(i, hh)) * 128 + e0 + r] = S[kt][i]; }
    __syncthreads();
}

DI void sub_barrier(unsigned* cnt, unsigned target) {
    asm volatile("s_waitcnt vmcnt(0)" ::: "memory");
    __syncthreads();
    if (mk_tid() == 0) {
        __builtin_amdgcn_fence(__ATOMIC_RELEASE, "agent");
        asm volatile("s_waitcnt vmcnt(0)" ::: "memory");
        (void)xb_add(cnt, 1u);
        unsigned sp = 0u; while (xb_ld(cnt) < target) { __builtin_amdgcn_s_sleep(1); if (++sp > (1u << 22)) break; }
        __builtin_amdgcn_fence(__ATOMIC_ACQUIRE, "agent");
        asm volatile("s_waitcnt vmcnt(0)" ::: "memory");
    }
    __syncthreads();
}

__global__ void __launch_bounds__(NTHREADS, 2) mega(Ctx c) {
    extern __shared__ __attribute__((aligned(16))) unsigned char shm[];
    LAS unsigned char* lds = (LAS unsigned char*)shm;
    { const unsigned t0 = threadIdx.x; if ((t0 & 63u) == 0u) ((LAS unsigned*)(lds + L_WTAB))[mk_slot()] = t0 >> 6; }
    __syncthreads();
    unsigned char* ws = c.ws; float* ctl = (float*)(ws + WS_CTL);
    const int lo = c.ph_lo, hi = c.ph_hi;
    if (hi > 1000) cg::this_grid().sync();
    volatile LAS unsigned* xst = (volatile LAS unsigned*)(lds + L_XST);
    if (mk_tid() < 4) xst[mk_tid()] = 0u;
    __syncthreads();
    XcdBarrier bar = xcd_barrier_post((unsigned*)(ws + WS_BAR), xst);
#ifdef ONLY
#define IN(k) ((k) == ONLY)
#else
#define IN(k) (lo <= (k) && (k) < hi)
#endif
#define SEAM(k) do { if (IN(k) && IN((k) + 1)) xcd_barrier(bar); } while (0)
    if (IN(0)) p0_phase(c, lds);
    SEAM(0);
    if (IN(1)) { pg8::Gemm g{(const bf16_t*)(ws + WS_A), (const bf16_t*)(ws + WS_WIN), NT, NPROJ, D, 0}; pg8::StaticOrder S; S.init(NT, NPROJ, gridDim.x, blockIdx.x);
        EpiProj E{(bf16_t*)(ws + WS_B), NPROJ, ctl + CTL_RS0}; pg8::gemm_phase<EpiProj, pg8::StaticOrder, false>(lds, g, S, E, nullptr); }
    SEAM(1);
    if (IN(3)) {
        unsigned* const chw = (unsigned*)(ws + WS_BAR) + 96;
        if (blockIdx.x < 32 || blockIdx.x >= 64) {
            const int q = blockIdx.x < 32 ? (int)blockIdx.x : (int)blockIdx.x - 32, nq = (int)gridDim.x - 32;
            for (int it = q; it < 256; it += nq) sample_gdn2(c, lds, it);
            shortconv_items(c, NTP * 64, NT * 64, q, nq);
            asm volatile("s_waitcnt vmcnt(0)" ::: "memory");
            __syncthreads();
            if (mk_tid() == 0) { __builtin_amdgcn_fence(__ATOMIC_RELEASE, "agent"); asm volatile("s_waitcnt vmcnt(0)" ::: "memory"); (void)xb_add(chw, 1u); }
        }
        if (blockIdx.x < 32) scan_seq(c, lds, blockIdx.x);
        else if (blockIdx.x < 64) {
            if (mk_tid() == 0) { unsigned sp = 0u; while (xb_ld(chw) < gridDim.x - 32u) { __builtin_amdgcn_s_sleep(2); if (++sp > (1u << 22)) break; } __builtin_amdgcn_fence(__ATOMIC_ACQUIRE, "agent"); asm volatile("s_waitcnt vmcnt(0)" ::: "memory"); }
            __syncthreads();
            const int j = blockIdx.x - 32; unsigned* sc = (unsigned*)(ws + WS_BAR) + 64;
            { pg8::Gemm g{(const bf16_t*)(ws + WS_A), (const bf16_t*)(ws + WS_WOUT), NT, D, D, 0}; SubOrder S{64, 2, 4, 8, j < 8 ? j : -1};
              EpiRes<0> E{c.x_prompt, c.x_sample, (bf16_t*)(ws + WS_C), nullptr, ctl + CTL_SS1, nullptr, nullptr}; pg8::gemm_phase<EpiRes<0>, SubOrder, false>(lds, g, S, E, nullptr); }
            { pg8::Gemm g{(const bf16_t*)(ws + WS_PB), (const bf16_t*)(ws + WS_WP), NT, D, PLE, 0}; SubOrder S{64, 2, 4, 8, (j >= 8 && j < 16) ? j - 8 : -1};
              EpiProj E{(bf16_t*)(ws + WS_PPS) - (size_t)NTP * D, D, nullptr}; pg8::gemm_phase<EpiProj, SubOrder, false>(lds, g, S, E, nullptr); }
            sub_barrier(sc, 32u);
            { pg8::Gemm g{(const bf16_t*)(ws + WS_C), (const bf16_t*)(ws + WS_WUP), NT, DFF, D, 0}; SubOrder S{64, 2, 16, 32, j};
              EpiUp E{(bf16_t*)(ws + WS_B), ctl + CTL_SS1}; pg8::gemm_phase<EpiUp, SubOrder, false>(lds, g, S, E, nullptr); }
            sub_barrier(sc, 64u);
            { const int kq = j >> 3; pg8::Gemm g{(const bf16_t*)(ws + WS_B) + kq * 1024, (const bf16_t*)(ws + WS_WDN) + kq * 1024, NT, D, 1024, DFF}; SubOrder S{64, 2, 4, 8, j & 7};
              EpiSplitK E{(float*)(ws + WS_B + SLAB_OFF), kq, (bf16_t*)(ws + WS_C), ctl + CTL_SS2, (unsigned*)(ws + WS_PCNT) + 66 * 32}; pg8::gemm_phase<EpiSplitK, SubOrder, false>(lds, g, S, E, nullptr); }
            sub_barrier(sc, 96u);
            { pg8::Gemm g{(const bf16_t*)(ws + WS_C), (const bf16_t*)(ws + WS_WG), NT, D, D, 0}; SubOrder S{64, 2, 4, 8, j < 8 ? j : -1};
              EpiFinal E{(const bf16_t*)(ws + WS_C), (const bf16_t*)(ws + WS_PPS) - (size_t)NTP * D, ctl + CTL_SS2, ctl + CTL_SS3, (unsigned*)(ws + WS_PCNT), c.norm_f, c.out}; pg8::gemm_phase<EpiFinal, SubOrder, false>(lds, g, S, E, nullptr); }
        }
        else { const int q = (int)blockIdx.x - 64, nq = (int)gridDim.x - 64;
            for (int i = q; i < 1024; i += nq) { const int n = i >> 5, bh = i & 31; prep_chunk(c, lds, ((bh >> 2) * 32 + n) * 4 + (bh & 3)); }
            shortconv_items(c, 0, NTP * 64, q, nq);
            conv_state_copies(c, q, nq); }
    }
    SEAM(3);
    if (IN(4)) { pg8::Gemm g{(const bf16_t*)(ws + WS_A), (const bf16_t*)(ws + WS_WOUT), NT, D, D, 0}; pg8::StaticOrder S; S.init(NTP, D, gridDim.x, blockIdx.x);
        EpiRes<0> E{c.x_prompt, c.x_sample, (bf16_t*)(ws + WS_C), nullptr, ctl + CTL_SS1, nullptr, nullptr}; pg8::gemm_phase<EpiRes<0>, pg8::StaticOrder, false>(lds, g, S, E, nullptr); }
    SEAM(4);
    if (IN(5)) { pg8::Gemm g{(const bf16_t*)(ws + WS_C), (const bf16_t*)(ws + WS_WUP), NT, DFF, D, 0}; pg8::StaticOrder S; S.init(NTP, DFF, gridDim.x, blockIdx.x);
        EpiUp E{(bf16_t*)(ws + WS_B), ctl + CTL_SS1}; pg8::gemm_phase<EpiUp, pg8::StaticOrder, false>(lds, g, S, E, nullptr); }
    SEAM(5);
    if (IN(6)) {
        { pg8::Gemm g{(const bf16_t*)(ws + WS_B), (const bf16_t*)(ws + WS_WDN), NT, D, DFF, 0}; pg8::StaticOrder S; S.init(NTP, D, gridDim.x, blockIdx.x);
          EpiRes<1> E{nullptr, nullptr, (bf16_t*)(ws + WS_C), nullptr, ctl + CTL_SS2, nullptr, nullptr}; pg8::gemm_phase<EpiRes<1>, pg8::StaticOrder, false>(lds, g, S, E, nullptr); }
        { pg8::Gemm g{(const bf16_t*)(ws + WS_PB), (const bf16_t*)(ws + WS_WP), NT, D, PLE, 0}; pg8::StaticOrder S; S.init(NTP, D, gridDim.x, blockIdx.x);
          EpiProj E{(bf16_t*)(ws + WS_A), D, nullptr}; pg8::gemm_phase<EpiProj, pg8::StaticOrder, false>(lds, g, S, E, nullptr); }
    }
    SEAM(6);
    if (IN(7)) { pg8::Gemm g{(const bf16_t*)(ws + WS_C), (const bf16_t*)(ws + WS_WG), NT, D, D, 0}; pg8::StaticOrder S; S.init(NTP, D, gridDim.x, blockIdx.x);
        EpiFinal E{(const bf16_t*)(ws + WS_C), (const bf16_t*)(ws + WS_A), ctl + CTL_SS2, ctl + CTL_SS3, (unsigned*)(ws + WS_PCNT), c.norm_f, c.out}; pg8::gemm_phase<EpiFinal, pg8::StaticOrder, false>(lds, g, S, E, nullptr); }
#undef IN
#undef SEAM
}

#ifndef N_LAUNCH_MODE
#define N_LAUNCH_MODE 1
#endif
extern "C" void kernel_launch(void* const* d_in, const int* in_sizes, int n_in, void* d_out, int out_size, void* d_ws, size_t ws_size, hipStream_t stream) {
    static int grid = 0;
    if (grid == 0) {
        int dev = 0, cus = 0, per_cu = 0;
        if (ws_size < WS_END) { fprintf(stderr, "kernel_launch: workspace too small: %zu < %zu\n", ws_size, (size_t)WS_END); grid = -1; return; }
        hipGetDevice(&dev); hipDeviceGetAttribute(&cus, hipDeviceAttributeMultiprocessorCount, dev);
        if (hipFuncSetAttribute((const void*)mega, hipFuncAttributeMaxDynamicSharedMemorySize, LDS_BYTES) != hipSuccess) { fprintf(stderr, "kernel_launch: hipFuncSetAttribute failed\n"); grid = -1; return; }
        if (hipOccupancyMaxActiveBlocksPerMultiprocessor(&per_cu, (const void*)mega, NTHREADS, LDS_BYTES) != hipSuccess || per_cu < 1) { fprintf(stderr, "kernel_launch: occupancy query says %d\n", per_cu); per_cu = 1; }
        (void)hipGetLastError();
        grid = cus * 1;
    }
    if (grid < 0) return;
    (void)hipMemsetAsync((unsigned char*)d_ws + WS_BAR, 0, 32768, stream);
    Ctx a{};
    const float** ap = (const float**)&a;
    for (int i = 0; i < 22; ++i) ap[i] = (const float*)d_in[i];
    a.out = (float*)d_out; a.ws = (unsigned char*)d_ws;
#if N_LAUNCH_MODE == 1
    a.ph_lo = 0; a.ph_hi = 8;
    void* args[] = {&a};
    hipError_t e = hipLaunchCooperativeKernel((const void*)mega, dim3(grid), dim3(NTHREADS), args, LDS_BYTES, stream);
    if (e != hipSuccess) fprintf(stderr, "cooperative launch failed: %s (grid %d)\n", hipGetErrorString(e), grid);
#else
    for (int ph = 0; ph < 8; ++ph) { a.ph_lo = ph; a.ph_hi = ph + 1; hipLaunchKernelGGL(mega, dim3(grid), dim3(NTHREADS), LDS_BYTES, stream, a); }
#endif
}
```

```cpp
#include <hip/hip_runtime.h>
#include <hip/hip_cooperative_groups.h>
#include <cstdio>
namespace cg = cooperative_groups;

constexpr int L_WTAB = 149008;
static __device__ __forceinline__ unsigned mk_lane() { return __builtin_amdgcn_mbcnt_hi(~0u, __builtin_amdgcn_mbcnt_lo(~0u, 0u)); }
static __device__ __forceinline__ unsigned mk_slot() { return (unsigned)__builtin_amdgcn_s_getreg(0x2804) & 63u; }
static __device__ __forceinline__ unsigned mk_tid() {
    extern __shared__ __attribute__((aligned(16))) unsigned char mk_shm[];
    const unsigned w = ((__attribute__((address_space(3))) unsigned*)((__attribute__((address_space(3))) unsigned char*)mk_shm + L_WTAB))[mk_slot()];
    return (unsigned)__builtin_amdgcn_readfirstlane((int)w) * 64u + mk_lane();
}
namespace pg8 {
#define PG8_LAS __attribute__((address_space(3)))
typedef unsigned short bf16_t;
typedef short bf16x8 __attribute__((ext_vector_type(8)));
typedef float f32x4 __attribute__((ext_vector_type(4)));
typedef unsigned u32x4 __attribute__((ext_vector_type(4)));
constexpr int BM = 256, BK = 64, HALF = 128, HTB = HALF * BK * 2  , STAGE_BYTES = 8 * HTB, NXCD = 8, WGM = 8;

__host__ __device__ __forceinline__ int lds_byte(int r, int c) { const int st = (r >> 4) * 2 + (c >> 5), rr = r & 15, cc = c & 31, ob = rr * 64 + cc * 2; return st * 1024 + (ob ^ (((ob >> 9) & 1) << 5)); }
__host__ __device__ __forceinline__ void stage_rc(int b, int& R, int& C) { const int st = b / 1024, sb = b % 1024, swz = sb ^ (((sb >> 9) & 1) << 5); R = (st >> 1) * 16 + swz / 64; C = (st & 1) * 32 + (swz % 64) / 2; }
__host__ __device__ __forceinline__ int perm32(int rho) { const int n = rho >> 4, i = rho & 15; return 8 * (i >> 2) + 4 * n + (i & 3); }

struct Unit { int pm, pn; };
struct Gemm { const bf16_t* A; const bf16_t* Bt; int M, N, K; int ld; };

struct StaticOrder {
    int nM, nN, nwg, G, c;
    __host__ __device__ void init(int M, int N, int G_, int c_) { nM = M / BM; nN = N / BM; nwg = nM * nN; G = G_; c = c_; }
    __host__ __device__ bool next(int i, Unit& u) const {
        const long L = (long)i * G + c; if (L >= nwg) return false;
        int wgid = (int)L; { const int q = nwg / NXCD, r = nwg % NXCD, xcd = wgid % NXCD, off = wgid / NXCD; wgid = (xcd < r ? xcd * (q + 1) : r * (q + 1) + (xcd - r) * q) + off; }
        const int nig = WGM * nN, gid = wgid / nig, fm = gid * WGM, gsz = (nM - fm) < WGM ? (nM - fm) : WGM;
        u.pm = fm + ((wgid % nig) % gsz); u.pn = (wgid % nig) / gsz; return true;
    }
    __device__ __forceinline__ void a_ready(const Unit&) const {}
    __device__ __forceinline__ void done(const Unit&) const {}
};
template <class Epi, class Sched, bool STAMP = false>
__device__ __forceinline__ void gemm_phase(PG8_LAS unsigned char* lds, const Gemm g, const Sched& S, const Epi& E, unsigned long long* stamps) {
    int tid = mk_tid(); asm volatile("" : "+v"(tid));
    const int wid = __builtin_amdgcn_readfirstlane(tid >> 6), lane = tid & 63, wr = wid >> 2, wc = wid & 3, fr = lane & 15, fq = lane >> 4;
    const int K = g.K, nt = K / BK, LD = g.ld ? g.ld : g.K;
    int ts_lo = 0, ts_hi = 0, nts = 0; const unsigned long long rt_entry = STAMP ? (unsigned long long)wall_clock64() : 0ull;
#define PG8_STAMP() do { if (STAMP && wid == 0 && nts < 64) { const unsigned long long _c = (unsigned long long)clock64(); \
        ts_lo = (lane == nts) ? (int)(unsigned)_c : ts_lo; ts_hi = (lane == nts) ? (int)(unsigned)(_c >> 32) : ts_hi; ++nts; } } while (0)
    PG8_STAMP();
    unsigned voffA[2], voffB[2];
#pragma unroll
    for (int i = 0; i < 2; ++i) { int R, C; stage_rc(tid * 16 + i * 8192, R, C); const int Rb = Epi::PERM ? ((R & ~31) + perm32(R & 31)) : R;
        voffA[i] = (unsigned)(R * LD + C) * 2u; voffB[i] = (unsigned)(Rb * LD + C) * 2u; }
    const size_t kstep = (size_t)(BK * 2);
    const size_t hstep = (size_t)HALF * LD * 2;
    const size_t tstep = 2 * hstep;
    const unsigned ldsw = (unsigned)wid * 1024u;
    const int aoff = lds_byte(wr * 64 + fr, fq * 8), boff = lds_byte(wc * 32 + fr, fq * 8);
#define PG8_SA(b, h) (((b) * 2 + (h)) * HTB)
#define PG8_SB(b, h) ((4 + (b) * 2 + (h)) * HTB)
#define PG8_STAGE(bufoff, gbase, voff) do { _Pragma("unroll") for (int _i = 0; _i < 2; ++_i) \
        __builtin_amdgcn_global_load_lds((const unsigned*)((const char*)(gbase) + (voff)[_i]), (PG8_LAS unsigned*)(lds + (bufoff) + ldsw + _i * 8192), 16, 0, 0); } while (0)
#define PG8_LDA(dst, b, h) do { _Pragma("unroll") for (int m = 0; m < 4; ++m) _Pragma("unroll") for (int k = 0; k < 2; ++k) dst[m][k] = *(const PG8_LAS bf16x8*)(lds + PG8_SA(b, h) + aoff + m * 2048 + k * 1024); } while (0)
#define PG8_LDB(dst, b, h) do { _Pragma("unroll") for (int n = 0; n < 2; ++n) _Pragma("unroll") for (int k = 0; k < 2; ++k) dst[n][k] = *(const PG8_LAS bf16x8*)(lds + PG8_SB(b, h) + boff + n * 2048 + k * 1024); } while (0)
#define PG8_MMA(ai, bj, At, Bt) do { __builtin_amdgcn_s_setprio(1); _Pragma("unroll") for (int m = 0; m < 4; ++m) _Pragma("unroll") for (int n = 0; n < 2; ++n) _Pragma("unroll") for (int k = 0; k < 2; ++k) \
        acc[ai][bj][m][n] = __builtin_amdgcn_mfma_f32_16x16x32_bf16(Bt[n][k], At[m][k], acc[ai][bj][m][n], 0, 0, 0); __builtin_amdgcn_s_setprio(0); } while (0)
#define PG8_WAIT_V(n) asm volatile("s_waitcnt vmcnt(" #n ")" ::: "memory")
#define PG8_WAIT_L(n) asm volatile("s_waitcnt lgkmcnt(" #n ")" ::: "memory")
#define PG8_BAR __builtin_amdgcn_s_barrier()
#define PG8_SCHED __builtin_amdgcn_sched_barrier(0)
    Unit cur, nxt; int ui = 0;
    if (!S.next(0, cur)) return;
    f32x4 acc[2][2][4][2];
#pragma unroll
    for (int a = 0; a < 2; ++a)
#pragma unroll
        for (int b = 0; b < 2; ++b)
#pragma unroll
            for (int m = 0; m < 4; ++m)
#pragma unroll
                for (int n = 0; n < 2; ++n) acc[a][b][m][n] = (f32x4){0.f, 0.f, 0.f, 0.f};
    bf16x8 At[4][2], B0[2][2], B1[2][2];
    const char* cA = (const char*)g.A + (size_t)cur.pm * tstep; const char* cB = (const char*)g.Bt + (size_t)cur.pn * tstep;
    S.a_ready(cur);
    PG8_STAGE(PG8_SB(0, 0), cB, voffB); PG8_STAGE(PG8_SA(0, 0), cA, voffA); PG8_STAGE(PG8_SB(0, 1), cB + hstep, voffB); PG8_STAGE(PG8_SA(0, 1), cA + hstep, voffA);
    if (wr == 1) PG8_BAR;
    PG8_WAIT_V(4); PG8_BAR;
    PG8_STAGE(PG8_SB(1, 0), cB + kstep, voffB); PG8_STAGE(PG8_SA(1, 0), cA + kstep, voffA); PG8_STAGE(PG8_SB(1, 1), cB + hstep + kstep, voffB);
    PG8_WAIT_V(6); PG8_BAR;
    PG8_STAMP();
    for (;;) {
        const bool has_next = S.next(ui + 1, nxt);
        const char* nA = has_next ? (const char*)g.A + (size_t)nxt.pm * tstep : cA; const char* nB = has_next ? (const char*)g.Bt + (size_t)nxt.pn * tstep : cB;
        for (int t = 0; t < nt; t += 2) {
            const bool last = (t == nt - 2);
            const char* a1 = cA + (size_t)(t + 1) * kstep;
            const char* a2 = last ? nA : cA + (size_t)(t + 2) * kstep; const char* b2 = last ? nB : cB + (size_t)(t + 2) * kstep;
            const char* a3 = a2 + kstep; const char* b3 = b2 + kstep;
            if (last && has_next) S.a_ready(nxt);
            PG8_LDB(B0, 0, 0); PG8_SCHED; PG8_LDA(At, 0, 0); PG8_STAGE(PG8_SA(1, 1), a1 + hstep, voffA);
            PG8_WAIT_L(8); PG8_BAR; PG8_WAIT_L(0); PG8_MMA(0, 0, At, B0); PG8_BAR; PG8_SCHED;
            PG8_LDB(B1, 0, 1); PG8_STAGE(PG8_SB(0, 0), b2, voffB);
            PG8_BAR; PG8_WAIT_L(0); PG8_MMA(0, 1, At, B1); PG8_BAR;
            PG8_LDA(At, 0, 1); PG8_STAGE(PG8_SA(0, 0), a2, voffA);
            PG8_BAR; PG8_WAIT_L(0); PG8_MMA(1, 0, At, B0); PG8_BAR; PG8_SCHED;
            PG8_STAGE(PG8_SB(0, 1), b2 + hstep, voffB);
            PG8_WAIT_V(6); PG8_BAR; PG8_MMA(1, 1, At, B1); PG8_BAR;
            PG8_LDB(B0, 1, 0); PG8_SCHED; PG8_LDA(At, 1, 0); PG8_STAGE(PG8_SA(0, 1), a2 + hstep, voffA);
            PG8_WAIT_L(8); PG8_BAR; PG8_WAIT_L(0); PG8_MMA(0, 0, At, B0); PG8_BAR; PG8_SCHED;
            PG8_LDB(B1, 1, 1); PG8_STAGE(PG8_SB(1, 0), b3, voffB);
            PG8_BAR; PG8_WAIT_L(0); PG8_MMA(0, 1, At, B1); PG8_BAR;
            PG8_LDA(At, 1, 1); PG8_STAGE(PG8_SA(1, 0), a3, voffA);
            PG8_BAR; PG8_WAIT_L(0); PG8_MMA(1, 0, At, B0); PG8_BAR; PG8_SCHED;
            PG8_STAGE(PG8_SB(1, 1), b3 + hstep, voffB);
            PG8_WAIT_V(6); PG8_BAR; PG8_MMA(1, 1, At, B1); PG8_BAR;
        }
        PG8_STAMP();
        if constexpr (!Epi::AFTER_DRAIN) { E(acc, cur, wr, wc, fr, fq); S.done(cur); }
        PG8_STAMP();
        if (!has_next) break;
#pragma unroll
        for (int a = 0; a < 2; ++a)
#pragma unroll
            for (int b = 0; b < 2; ++b)
#pragma unroll
                for (int m = 0; m < 4; ++m)
#pragma unroll
                    for (int n = 0; n < 2; ++n) acc[a][b][m][n] = (f32x4){0.f, 0.f, 0.f, 0.f};
        cur = nxt; cA = nA; cB = nB; ++ui;
    }
    PG8_WAIT_V(0);
    if (wr == 0) PG8_BAR;
    PG8_BAR;
    if constexpr (Epi::AFTER_DRAIN) { E.fused(acc, cur, wr, wc, fr, fq, lds, wid, lane); S.done(cur); }
    PG8_STAMP();
    if (STAMP && wid == 0) { stamps[lane] = lane < nts ? (((unsigned long long)(unsigned)ts_hi << 32) | (unsigned)ts_lo) : 0ull;
        if (lane == 62) stamps[62] = rt_entry; if (lane == 63) stamps[63] = (unsigned long long)wall_clock64(); }
#undef PG8_STAMP
#undef PG8_SA
#undef PG8_SB
#undef PG8_STAGE
#undef PG8_LDA
#undef PG8_LDB
#undef PG8_MMA
#undef PG8_WAIT_V
#undef PG8_WAIT_L
#undef PG8_BAR
#undef PG8_SCHED
}
}
#define LAS __attribute__((address_space(3)))
using pg8::bf16_t; using pg8::bf16x8; using pg8::f32x4; using pg8::u32x4;
typedef float f32x16 __attribute__((ext_vector_type(16)));
typedef float f32x2v __attribute__((ext_vector_type(2)));
typedef __bf16 bf16x2v __attribute__((ext_vector_type(2)));
typedef unsigned u32x2 __attribute__((ext_vector_type(2)));
#define DI __device__ __forceinline__
#define MFMA32(a, b, c) __builtin_amdgcn_mfma_f32_32x32x16_bf16((a), (b), (c), 0, 0, 0)

constexpr int D = 1024, NTP = 16384, NTS = 512, NT = NTP + NTS;
constexpr int NPROJ = 3584, INDIM = 3592, DFF = 4096, PLE = 256;
constexpr float EPS = 1e-6f;
constexpr int NTHREADS = 512;
constexpr int LDS_BYTES = 149008 + 256;
constexpr size_t WS_WIN = 0;
constexpr size_t WS_WOUT = WS_WIN + (size_t)NPROJ * D * 2;
constexpr size_t WS_WUP = WS_WOUT + (size_t)D * D * 2;
constexpr size_t WS_WDN = WS_WUP + (size_t)DFF * D * 2;
constexpr size_t WS_WG = WS_WDN + (size_t)D * DFF * 2;
constexpr size_t WS_WP = WS_WG + (size_t)D * D * 2;
constexpr size_t WS_CTL = WS_WP + (size_t)D * PLE * 2;
constexpr size_t CTL_RS0 = 0, CTL_SS1 = NT, CTL_SS2 = 2 * NT, CTL_SS3 = 3 * NT, CTL_LA = 4 * NT, CTL_BETA = 8 * NT, CTL_GL = 12 * NT, CTL_FLOATS = 12 * NT + 1024;
constexpr size_t WS_PB = WS_CTL + ((CTL_FLOATS * 4 + 4095) / 4096) * 4096;
constexpr size_t WS_A = WS_PB + (size_t)NT * PLE * 2;
constexpr size_t WS_B = WS_A + (size_t)NT * D * 2;
constexpr size_t WS_C = WS_B + (size_t)NT * DFF * 2;
constexpr size_t WS_BAR = WS_C + (size_t)NT * D * 2;
constexpr size_t WS_FLAGS = WS_BAR + 16384;
constexpr size_t WS_PCNT = WS_BAR + 20480;
constexpr size_t WS_PPS = WS_BAR + 32768;
constexpr size_t WS_END = WS_PPS + (size_t)NTS * D * 2;
constexpr size_t OFF_Y = 0, OFF_GCP = 17301504, OFF_GP = 17338368, OFF_SCP = 17862656, OFF_GCS = 17870848, OFF_GS = 18460672, OFF_SCS = 26849280;

struct Ctx {
    const float* x_prompt; const float* x_sample; const float* state_gdn_conv; const float* state_gdn; const float* state_sc_conv; const float* p_prompt; const float* p_sample;
    const float* norm_mix; const float* w_in; const float* w_conv_qkv; const float* a_log; const float* dt_bias; const float* w_gdn_norm; const float* w_conv_sc; const float* w_out;
    const float* norm_mlp; const float* w_up; const float* w_down; const float* norm_ple; const float* w_ple_gate; const float* w_ple_proj; const float* norm_f;
    float* out; unsigned char* ws; int ph_lo, ph_hi;
};

DI unsigned pk2(float lo, float hi) { f32x2v v = {lo, hi}; return __builtin_bit_cast(unsigned, __builtin_convertvector(v, bf16x2v)); }
DI bf16_t f2bf(float f) { return (bf16_t)(pk2(f, 0.f) & 0xffffu); }
DI float bf2f(bf16_t b) { return __uint_as_float((unsigned)b << 16); }
DI float bflo(unsigned u) { return __uint_as_float(u << 16); }
DI float bfhi(unsigned u) { return __uint_as_float(u & 0xffff0000u); }
DI void unpack8(const u32x4 v, float* f) { f[0] = bflo(v.x); f[1] = bfhi(v.x); f[2] = bflo(v.y); f[3] = bfhi(v.y); f[4] = bflo(v.z); f[5] = bfhi(v.z); f[6] = bflo(v.w); f[7] = bfhi(v.w); }
DI u32x4 pack8(const float* f) { u32x4 w; w.x = pk2(f[0], f[1]); w.y = pk2(f[2], f[3]); w.z = pk2(f[4], f[5]); w.w = pk2(f[6], f[7]); return w; }
DI void st16_wt(void* ptr, const u32x4 v) { asm volatile("global_store_dwordx4 %0, %1, off sc0 sc1\n\ts_nop 2" :: "v"(ptr), "v"(v) : "memory"); }
DI int crow(int reg, int h) { return (reg & 3) + 8 * (reg >> 2) + 4 * h; }
DI int swap23(int p) { return (p & ~12) | ((p & 4) << 1) | ((p & 8) >> 1); }
DI bf16x8 pack_step(const f32x16& x, int s) {
    u32x4 p; p.x = pk2(x[8 * s], x[8 * s + 1]); p.y = pk2(x[8 * s + 2], x[8 * s + 3]); p.z = pk2(x[8 * s + 4], x[8 * s + 5]); p.w = pk2(x[8 * s + 6], x[8 * s + 7]);
    return __builtin_bit_cast(bf16x8, p);
}
DI float sigmoidf_(float x) { return __builtin_amdgcn_rcpf(1.0f + __expf(-x)); }
DI float siluf_(float x) { return x * __builtin_amdgcn_rcpf(1.0f + __expf(-x)); }

struct EpiProj {
    static constexpr bool PERM = true, AFTER_DRAIN = false;
    bf16_t* O; int ldc; const float* rs; int wt = 0;
    DI void operator()(const f32x4 (&acc)[2][2][4][2], const pg8::Unit& u, int wr, int wc, int fr, int fq) const {
        const int row0 = u.pm * 256 + wr * 64 + fr, col0 = u.pn * 256 + wc * 32 + 8 * fq;
#pragma unroll
        for (int ai = 0; ai < 2; ++ai)
#pragma unroll
            for (int m = 0; m < 4; ++m) { const int row = row0 + ai * 128 + m * 16; const float r = rs ? rs[row] : 1.0f; bf16_t* rowp = O + (size_t)row * ldc + col0;
#pragma unroll
                for (int bj = 0; bj < 2; ++bj) { const f32x4 v0 = acc[ai][bj][m][0] * r, v1 = acc[ai][bj][m][1] * r;
                    u32x4 w; w.x = pk2(v0[0], v0[1]); w.y = pk2(v0[2], v0[3]); w.z = pk2(v1[0], v1[1]); w.w = pk2(v1[2], v1[3]);
                    if (wt) st16_wt(rowp + bj * 128, w); else *(u32x4*)(rowp + bj * 128) = w; } }
    }
};
struct EpiUp {
    static constexpr bool PERM = true, AFTER_DRAIN = false;
    bf16_t* O; const float* ss; int wt = 0;
    DI void operator()(const f32x4 (&acc)[2][2][4][2], const pg8::Unit& u, int wr, int wc, int fr, int fq) const {
        const int row0 = u.pm * 256 + wr * 64 + fr, col0 = u.pn * 256 + wc * 32 + 8 * fq;
#pragma unroll
        for (int ai = 0; ai < 2; ++ai)
#pragma unroll
            for (int m = 0; m < 4; ++m) { const int row = row0 + ai * 128 + m * 16; const float r = rsqrtf(ss[row] * (1.0f / 1024.0f) + EPS); bf16_t* rowp = O + (size_t)row * DFF + col0;
#pragma unroll
                for (int bj = 0; bj < 2; ++bj) { f32x4 v0 = acc[ai][bj][m][0] * r, v1 = acc[ai][bj][m][1] * r;
#pragma unroll
                    for (int j = 0; j < 4; ++j) { v0[j] = fmaxf(v0[j], 0.f); v0[j] *= v0[j]; v1[j] = fmaxf(v1[j], 0.f); v1[j] *= v1[j]; }
                    u32x4 w; w.x = pk2(v0[0], v0[1]); w.y = pk2(v0[2], v0[3]); w.z = pk2(v1[0], v1[1]); w.w = pk2(v1[2], v1[3]);
                    if (wt) st16_wt(rowp + bj * 128, w); else *(u32x4*)(rowp + bj * 128) = w; } }
    }
};
template <int MODE> struct EpiRes {
    static constexpr bool PERM = true, AFTER_DRAIN = false;
    const float* xp; const float* xs; bf16_t* XB; bf16_t* XO; float* ssn; const float* ssp; const bf16_t* PP; int wt = 0;
    DI void operator()(const f32x4 (&acc)[2][2][4][2], const pg8::Unit& u, int wr, int wc, int fr, int fq) const {
        const int row0 = u.pm * 256 + wr * 64 + fr, col0 = u.pn * 256 + wc * 32 + 8 * fq;
#pragma unroll
        for (int ai = 0; ai < 2; ++ai)
#pragma unroll
            for (int m = 0; m < 4; ++m) { const int row = row0 + ai * 128 + m * 16; const size_t off = (size_t)row * D + col0;
                float r = 1.f; if (MODE == 2) r = rsqrtf(ssp[row] * (1.0f / 1024.0f) + EPS);
                float sq = 0.f;
#pragma unroll
                for (int bj = 0; bj < 2; ++bj) { float v[8];
#pragma unroll
                    for (int j = 0; j < 4; ++j) { v[j] = acc[ai][bj][m][0][j]; v[4 + j] = acc[ai][bj][m][1][j]; }
                    if (MODE == 2) { float pf[8]; unpack8(*(const u32x4*)(PP + off + bj * 128), pf);
#pragma unroll
                        for (int j = 0; j < 8; ++j) v[j] = sigmoidf_(v[j] * r) * pf[j]; }
                    if (MODE == 0) { const float* bp = (row < NTP ? xp + off : xs + (off - (size_t)NTP * D)) + bj * 128; const f32x4 b0 = *(const f32x4*)bp, b1 = *(const f32x4*)(bp + 4);
#pragma unroll
                        for (int j = 0; j < 4; ++j) { v[j] += b0[j]; v[4 + j] += b1[j]; } }
                    else { float bf[8]; unpack8(*(const u32x4*)(XB + off + bj * 128), bf);
#pragma unroll
                        for (int j = 0; j < 8; ++j) v[j] += bf[j]; }
                    if (wt) st16_wt((MODE == 2 ? XO : XB) + off + bj * 128, pack8(v)); else *(u32x4*)((MODE == 2 ? XO : XB) + off + bj * 128) = pack8(v);
#pragma unroll
                    for (int j = 0; j < 8; ++j) sq += v[j] * v[j]; }
                sq += __shfl_xor(sq, 16); sq += __shfl_xor(sq, 32);
                if (fq == 0) atomicAdd(ssn + row, sq); }
    }
};
struct SubOrder {
    int pm0, nM, nN, G, c;
    DI bool next(int i, pg8::Unit& u) const { const int L = i * G + c; if (c < 0 || L >= nM * nN) return false; u.pm = pm0 + L % nM; u.pn = L / nM; return true; }
    DI void a_ready(const pg8::Unit&) const {}
    DI void done(const pg8::Unit&) const {}
};
constexpr size_t SLAB_OFF = 123000064;
constexpr size_t SLAB_FLOATS = (size_t)NTS * D;
struct EpiSplitK {
    static constexpr bool PERM = true, AFTER_DRAIN = true;
    float* SLAB; int kq; bf16_t* XB; float* ssn; unsigned* cnt;
    DI void fused(f32x4 (&acc)[2][2][4][2], const pg8::Unit& u, int wr, int wc, int fr, int fq, LAS unsigned char* lds, int wid, int lane) const {
        const int row0 = u.pm * 256 + wr * 64 + fr, col0 = u.pn * 256 + wc * 32 + 8 * fq;
        float* mine = SLAB + (size_t)kq * SLAB_FLOATS - (size_t)NTP * D;
#pragma unroll
        for (int ai = 0; ai < 2; ++ai)
#pragma unroll
            for (int m = 0; m < 4; ++m) { float* rowp = mine + (size_t)(row0 + ai * 128 + m * 16) * D + col0;
#pragma unroll
                for (int bj = 0; bj < 2; ++bj) { st16_wt(rowp + bj * 128, __builtin_bit_cast(u32x4, acc[ai][bj][m][0])); st16_wt(rowp + bj * 128 + 4, __builtin_bit_cast(u32x4, acc[ai][bj][m][1])); } }
        asm volatile("s_waitcnt vmcnt(0)" ::: "memory");
        __syncthreads();
        volatile LAS unsigned* flag = (volatile LAS unsigned*)lds;
        if (wid == 0 && lane == 0) { const unsigned t = __hip_atomic_fetch_add(cnt + ((u.pm - 64) * 4 + u.pn) * 32, 1u, __ATOMIC_RELAXED, __HIP_MEMORY_SCOPE_AGENT);
            __builtin_amdgcn_fence(__ATOMIC_ACQUIRE, "agent"); asm volatile("s_waitcnt vmcnt(0)" ::: "memory"); flag[0] = (t == 3u) ? 1u : 0u; }
        __syncthreads();
        if (flag[0] != 0u) {
#pragma unroll
            for (int ai = 0; ai < 2; ++ai)
#pragma unroll
                for (int m = 0; m < 4; ++m) { const int row = row0 + ai * 128 + m * 16; const size_t off = (size_t)row * D + col0; float sq = 0.f;
#pragma unroll
                    for (int bj = 0; bj < 2; ++bj) { float v[8]; unpack8(*(const u32x4*)(XB + off + bj * 128), v);
#pragma unroll
                        for (int q = 0; q < 4; ++q) { const float* sp = SLAB + (size_t)q * SLAB_FLOATS + (off - (size_t)NTP * D) + bj * 128; const f32x4 a0 = *(const f32x4*)sp, a1 = *(const f32x4*)(sp + 4);
#pragma unroll
                            for (int j = 0; j < 4; ++j) { v[j] += a0[j]; v[4 + j] += a1[j]; } }
                        st16_wt(XB + off + bj * 128, pack8(v));
#pragma unroll
                        for (int j = 0; j < 8; ++j) sq += v[j] * v[j]; }
                    sq += __shfl_xor(sq, 16); sq += __shfl_xor(sq, 32);
                    if (fq == 0) atomicAdd(ssn + row, sq); }
        }
    }
};
struct EpiFinal {
    static constexpr bool PERM = true, AFTER_DRAIN = true;
    const bf16_t* XB; const bf16_t* PP; const float* ssp; float* ssn; unsigned* cnt; const float* normf; float* Y;
    DI void fused(f32x4 (&acc)[2][2][4][2], const pg8::Unit& u, int wr, int wc, int fr, int fq, LAS unsigned char* lds, int wid, int lane) const {
        const int row0 = u.pm * 256 + wr * 64 + fr, col0 = u.pn * 256 + wc * 32 + 8 * fq;
#pragma unroll
        for (int ai = 0; ai < 2; ++ai)
#pragma unroll
            for (int m = 0; m < 4; ++m) { const int row = row0 + ai * 128 + m * 16; const size_t off = (size_t)row * D + col0;
                const float r = rsqrtf(ssp[row] * (1.0f / 1024.0f) + EPS); float sq = 0.f;
#pragma unroll
                for (int bj = 0; bj < 2; ++bj) { float pf[8], bf[8]; unpack8(*(const u32x4*)(PP + off + bj * 128), pf); unpack8(*(const u32x4*)(XB + off + bj * 128), bf);
#pragma unroll
                    for (int j = 0; j < 4; ++j) { const float a = sigmoidf_(acc[ai][bj][m][0][j] * r) * pf[j] + bf[j], b = sigmoidf_(acc[ai][bj][m][1][j] * r) * pf[4 + j] + bf[4 + j];
                        acc[ai][bj][m][0][j] = a; acc[ai][bj][m][1][j] = b; sq += a * a + b * b; } }
                sq += __shfl_xor(sq, 16); sq += __shfl_xor(sq, 32);
                if (fq == 0) atomicAdd(ssn + row, sq); }
        asm volatile("s_waitcnt vmcnt(0)" ::: "memory");
        __syncthreads();
        if (mk_tid() == 0) { unsigned* cw = cnt + u.pm * 32; (void)__hip_atomic_fetch_add(cw, 1u, __ATOMIC_RELAXED, __HIP_MEMORY_SCOPE_AGENT);
            unsigned sp = 0u; while (__hip_atomic_load(cw, __ATOMIC_RELAXED, __HIP_MEMORY_SCOPE_AGENT) < 4u) { __builtin_amdgcn_s_sleep(1); if (++sp > (1u << 22)) break; }
            __builtin_amdgcn_fence(__ATOMIC_ACQUIRE, "agent"); asm volatile("s_waitcnt vmcnt(0)" ::: "memory"); }
        __syncthreads();
#pragma unroll
        for (int ai = 0; ai < 2; ++ai)
#pragma unroll
            for (int m = 0; m < 4; ++m) { const int row = row0 + ai * 128 + m * 16; const size_t off = (size_t)row * D + col0;
                const float rs = rsqrtf(__hip_atomic_load(ssn + row, __ATOMIC_RELAXED, __HIP_MEMORY_SCOPE_AGENT) * (1.0f / 1024.0f) + EPS);
#pragma unroll
                for (int bj = 0; bj < 2; ++bj) { const f32x4 w0 = *(const f32x4*)(normf + col0 + bj * 128), w1 = *(const f32x4*)(normf + col0 + bj * 128 + 4);
                    *(f32x4*)(Y + off + bj * 128) = acc[ai][bj][m][0] * rs * w0; *(f32x4*)(Y + off + bj * 128 + 4) = acc[ai][bj][m][1] * rs * w1; } }
    }
};
#define XB_TMO      128
#define XB_XCNT(j)  (256  + 64 * (j))
#define XB_XSUB(j)  (1280 + 64 * (j))
#define XB_XGEN(j)  (2304 + 64 * (j))
#define XB_TOP      3328
#define XB_TOPGEN   3392
#define XCD_BAR_WORDS 3456
#define XB_SPIN_CAP (1u << 18)

__device__ __forceinline__ unsigned xb_ld(unsigned* p)              { return __hip_atomic_load(p, __ATOMIC_RELAXED, __HIP_MEMORY_SCOPE_AGENT); }
__device__ __forceinline__ unsigned xb_add(unsigned* p, unsigned v) { return __hip_atomic_fetch_add(p, v, __ATOMIC_RELAXED, __HIP_MEMORY_SCOPE_AGENT); }
__device__ __forceinline__ unsigned xb_xcc_id() { return (unsigned)__builtin_amdgcn_s_getreg((3 << 11) | 20) & 0xFu; }
#define XB_SPIN(cond, bar) do { unsigned _sp = 0; while (cond) { __builtin_amdgcn_s_sleep(1); \
    if ((++_sp & 255u) == 0u) { if (xb_ld(&(bar)[XB_TMO])) break; if (_sp > XB_SPIN_CAP) { atomicAdd(&(bar)[XB_TMO], 1u); break; } } } } while (0)

struct XcdBarrier {
    unsigned* bar; unsigned x;
    volatile LAS unsigned* st;
};

__device__ __forceinline__ XcdBarrier xcd_barrier_post(unsigned* bar, volatile LAS unsigned* st) {
    XcdBarrier b; b.bar = bar; b.x = xb_xcc_id(); b.st = st;
    if (mk_tid() == 0) (void)xb_add(&bar[XB_XCNT(b.x)], 1u);
    return b;
}
__device__ __forceinline__ void xcd_barrier_complete(unsigned* bar, unsigned x, unsigned& nloc, unsigned& nx) {
    const unsigned G = gridDim.x * gridDim.y * gridDim.z;
    unsigned sum, cnt, mine, sp = 0u;
    for (;;) {
        sum = 0u; cnt = 0u; mine = 0u;
#pragma unroll
        for (unsigned j = 0; j < 16; ++j) { const unsigned c = xb_ld(&bar[XB_XCNT(j)]); sum += c; cnt += (c > 0u) ? 1u : 0u; mine = (j == x) ? c : mine; }
        if (sum == G) break;
        __builtin_amdgcn_s_sleep(1);
        if ((++sp & 255u) == 0u) { if (xb_ld(&bar[XB_TMO])) break; if (sp > XB_SPIN_CAP) { atomicAdd(&bar[XB_TMO], 1u); break; } }
    }
    nloc = mine > 0u ? mine : 1u; nx = cnt > 0u ? cnt : 1u;
}

__device__ __forceinline__ void xcd_barrier(const XcdBarrier& b) {
    asm volatile("s_waitcnt vmcnt(0)" ::: "memory");
    __syncthreads();
    if (mk_tid() == 0) {
        unsigned* bar = b.bar;
        __builtin_amdgcn_s_waitcnt(0);
        unsigned nloc = b.st[0], nx = b.st[1];
        if (nloc == 0u) { xcd_barrier_complete(bar, b.x, nloc, nx); b.st[0] = nloc; b.st[1] = nx; }
        const unsigned old = xb_add(&bar[XB_XSUB(b.x)], 1u);
        const unsigned gen = old / nloc;
        if (old + 1u == (gen + 1u) * nloc) {
            __builtin_amdgcn_fence(__ATOMIC_RELEASE, "agent");
            asm volatile("s_waitcnt vmcnt(0)" ::: "memory");
            const unsigned og = xb_add(&bar[XB_TOP], 1u);
            const unsigned tg = og / nx;
            if (og + 1u == (tg + 1u) * nx) xb_add(&bar[XB_TOPGEN], 1u);
            else XB_SPIN(xb_ld(&bar[XB_TOPGEN]) == tg, bar);
            __builtin_amdgcn_fence(__ATOMIC_ACQUIRE, "agent");
            xb_add(&bar[XB_XGEN(b.x)], 1u);
            asm volatile("s_waitcnt vmcnt(0)" ::: "memory");
        } else {
            XB_SPIN(xb_ld(&bar[XB_XGEN(b.x)]) == gen, bar);
            __builtin_amdgcn_fence(__ATOMIC_ACQUIRE, "agent");
            asm volatile("s_waitcnt vmcnt(0)" ::: "memory");
        }
    }
    __syncthreads();
}
struct TileDesc { const float* W; const float* nrm; bf16_t* Wt; int ldw, K, k0, n0src, n0dst; };
DI TileDesc p0_tile(const Ctx& c, unsigned char* ws, int t) {
    TileDesc d;
    if (t < 896) { const int kt = t / 56, nt = t % 56, n0 = nt * 64; d = TileDesc{c.w_in, c.norm_mix, (bf16_t*)(ws + WS_WIN), INDIM, D, kt * 64, n0 < 1536 ? n0 : n0 + 8, n0}; return d; }
    t -= 896;
    if (t < 256) { d = TileDesc{c.w_out, nullptr, (bf16_t*)(ws + WS_WOUT), D, D, (t / 16) * 64, (t % 16) * 64, (t % 16) * 64}; return d; }
    t -= 256;
    if (t < 1024) { d = TileDesc{c.w_up, c.norm_mlp, (bf16_t*)(ws + WS_WUP), DFF, D, (t / 64) * 64, (t % 64) * 64, (t % 64) * 64}; return d; }
    t -= 1024;
    if (t < 1024) { d = TileDesc{c.w_down, nullptr, (bf16_t*)(ws + WS_WDN), D, DFF, (t / 16) * 64, (t % 16) * 64, (t % 16) * 64}; return d; }
    t -= 1024;
    if (t < 256) { d = TileDesc{c.w_ple_gate, c.norm_ple, (bf16_t*)(ws + WS_WG), D, D, (t / 16) * 64, (t % 16) * 64, (t % 16) * 64}; return d; }
    t -= 256;
    d = TileDesc{c.w_ple_proj, nullptr, (bf16_t*)(ws + WS_WP), D, PLE, (t / 16) * 64, (t % 16) * 64, (t % 16) * 64}; return d;
}
DI void tile_load(const TileDesc& d, float (&v)[8]) {
    const int tid = mk_tid();
#pragma unroll
    for (int i = 0; i < 8; ++i) { const int kk = i * 8 + (tid >> 6), nn = tid & 63; float x = d.W[(size_t)(d.k0 + kk) * d.ldw + d.n0src + nn]; if (d.nrm) x *= d.nrm[d.k0 + kk]; v[i] = x; }
}
DI void tile_store(const TileDesc& d, const float (&v)[8], LAS float* tile) {
    const int tid = mk_tid();
#pragma unroll
    for (int i = 0; i < 8; ++i) { const int kk = i * 8 + (tid >> 6), nn = tid & 63; tile[kk * 65 + nn] = v[i]; }
    __syncthreads();
    { const int nn = tid >> 3, kq = tid & 7; float f[8];
#pragma unroll
      for (int e = 0; e < 8; ++e) f[e] = tile[(kq * 8 + e) * 65 + nn];
      *(u32x4*)(d.Wt + (size_t)(d.n0dst + nn) * d.K + d.k0 + kq * 8) = pack8(f); }
    __syncthreads();
}
DI void p0_phase(const Ctx& c, LAS unsigned char* lds) {
    const int tid = mk_tid(), lane = tid & 63, wid = tid >> 6;
    unsigned char* ws = c.ws;
    float* ctl = (float*)(ws + WS_CTL);
    bf16_t* XB = (bf16_t*)(ws + WS_A); bf16_t* PB = (bf16_t*)(ws + WS_PB);
    LAS float* wab = (LAS float*)lds;
    for (int i = tid; i < 1024 * 8; i += NTHREADS) { const int k = i >> 3, j = i & 7; wab[i] = c.w_in[(size_t)k * INDIM + 1536 + j] * c.norm_mix[k]; }
    __syncthreads();
    float xn[16];
    { const int row = blockIdx.x * 8 + wid; if (row < NT) { const float* xr = row < NTP ? c.x_prompt + (size_t)row * D : c.x_sample + (size_t)(row - NTP) * D;
#pragma unroll
        for (int i = 0; i < 16; ++i) xn[i] = xr[i * 64 + lane]; } }
    for (int row = blockIdx.x * 8 + wid; row < NT; row += gridDim.x * 8) {
        const float* xr = row < NTP ? c.x_prompt + (size_t)row * D : c.x_sample + (size_t)(row - NTP) * D;
        const float* pr = row < NTP ? c.p_prompt + (size_t)row * PLE : c.p_sample + (size_t)(row - NTP) * PLE;
        float xc[16];
#pragma unroll
        for (int i = 0; i < 16; ++i) xc[i] = xn[i];
        { const int rown = row + gridDim.x * 8; if (rown < NT) { const float* xq = rown < NTP ? c.x_prompt + (size_t)rown * D : c.x_sample + (size_t)(rown - NTP) * D;
#pragma unroll
            for (int i = 0; i < 16; ++i) xn[i] = xq[i * 64 + lane]; } }
        float ss = 0.f, dot[8];
#pragma unroll
        for (int j = 0; j < 8; ++j) dot[j] = 0.f;
#pragma unroll
        for (int i = 0; i < 16; ++i) { const int k = i * 64 + lane; const float xv = xc[i]; ss += xv * xv;
            const f32x4 w0 = *(const LAS f32x4*)(wab + k * 8), w1 = *(const LAS f32x4*)(wab + k * 8 + 4);
            dot[0] += xv * w0[0]; dot[1] += xv * w0[1]; dot[2] += xv * w0[2]; dot[3] += xv * w0[3]; dot[4] += xv * w1[0]; dot[5] += xv * w1[1]; dot[6] += xv * w1[2]; dot[7] += xv * w1[3]; }
#pragma unroll
        for (int o = 32; o >= 1; o >>= 1) { ss += __shfl_xor(ss, o);
#pragma unroll
            for (int j = 0; j < 8; ++j) dot[j] += __shfl_xor(dot[j], o); }
        const float rs = rsqrtf(ss * (1.0f / 1024.0f) + EPS);
#pragma unroll
        for (int i = 0; i < 4; ++i) { const int k0 = i * 256 + lane * 4; const f32x4 v = *(const f32x4*)(xr + k0); u32x2 w; w.x = pk2(v[0], v[1]); w.y = pk2(v[2], v[3]); *(u32x2*)(XB + (size_t)row * D + k0) = w; }
        { const f32x4 v = *(const f32x4*)(pr + lane * 4); u32x2 w; w.x = pk2(v[0], v[1]); w.y = pk2(v[2], v[3]); *(u32x2*)(PB + (size_t)row * PLE + lane * 4) = w; }
        if (lane == 0) { ctl[CTL_RS0 + row] = rs; ctl[CTL_SS1 + row] = 0.f; ctl[CTL_SS2 + row] = 0.f; ctl[CTL_SS3 + row] = 0.f; }
        if (lane < 4) { const float da = lane == 0 ? dot[0] : lane == 1 ? dot[1] : lane == 2 ? dot[2] : dot[3]; const float db = lane == 0 ? dot[4] : lane == 1 ? dot[5] : lane == 2 ? dot[6] : dot[7];
            const float xa = da * rs + c.dt_bias[lane]; const float sp = xa > 20.f ? xa : log1pf(__expf(xa));
            ctl[CTL_LA + (size_t)row * 4 + lane] = -__expf(c.a_log[lane]) * sp; ctl[CTL_BETA + (size_t)row * 4 + lane] = sigmoidf_(db * rs); }
    }
    __syncthreads();
    LAS float* tile = (LAS float*)lds;
    {
        int tl = blockIdx.x; float va[8], vb[8];
        if (tl < 3520) { TileDesc d = p0_tile(c, ws, tl); tile_load(d, va);
            for (;;) {
                const int tn = tl + gridDim.x; TileDesc dn = d;
                if (tn < 3520) { dn = p0_tile(c, ws, tn); tile_load(dn, vb); }
                tile_store(d, va, tile);
                if (tn >= 3520) break;
#pragma unroll
                for (int i = 0; i < 8; ++i) va[i] = vb[i];
                d = dn; tl = tn;
            } }
    }
}

constexpr int L_QH = 0, L_KH = 17408, L_RT = 34816, L_AM = 71680, L_TB = 89088, L_G = 98304, L_WC = 98816, L_SSP = 104960;
DI void prep_chunk(const Ctx& c, LAS unsigned char* lds, int ch) {
    int tid = mk_tid(); asm volatile("" : "+v"(tid));
    const int lane = tid & 63, wid = __builtin_amdgcn_readfirstlane(tid >> 6);
    const int h = ch & 3, n = (ch >> 2) & 31, b = ch >> 7;
    const int row0 = b * 2048 + n * 64;
    float* ctl = (float*)(c.ws + WS_CTL);
    const bf16_t* PROJ = (const bf16_t*)(c.ws + WS_B);
    bf16_t* QP = (bf16_t*)c.out + (size_t)ch * 8192; bf16_t* WP = (bf16_t*)c.out + (size_t)(1024 + ch) * 8192; bf16_t* KTP = (bf16_t*)c.out + (size_t)(2048 + ch) * 8192;
    bf16_t* UT = (bf16_t*)(c.ws + WS_C) + (size_t)ch * 8192; bf16_t* QKP = (bf16_t*)(c.ws + WS_C) + (size_t)1024 * 8192 + (size_t)ch * 4096;
    LAS float* G = (LAS float*)(lds + L_G); LAS float* BT = G + 64;
    LAS float* WC = (LAS float*)(lds + L_WC);
    LAS float* SSP = (LAS float*)(lds + L_SSP);
    for (int i = tid; i < 1536; i += NTHREADS) { const int ten = i >> 9, jj = (i >> 7) & 3, cc = i & 127; WC[i] = c.w_conv_qkv[jj * 1536 + ten * 512 + h * 128 + cc]; }
    if (wid == 0) {
        float la = ctl[CTL_LA + (size_t)(row0 + lane) * 4 + h];
#pragma unroll
        for (int o = 1; o < 64; o <<= 1) { const float t = __int_as_float(__builtin_amdgcn_ds_bpermute(((lane - o) & 63) * 4, __float_as_int(la))); if (lane >= o) la += t; }
        G[lane] = la; BT[lane] = ctl[CTL_BETA + (size_t)(row0 + lane) * 4 + h];
        if (lane == 63) __hip_atomic_store(ctl + CTL_GL + ch, la, __ATOMIC_RELAXED, __HIP_MEMORY_SCOPE_AGENT);
    }
    {
        const int tok = lane, cg8 = wid;
        const int t_abs = n * 64 + tok;
        u32x4 xr[3][4][2];
#pragma unroll
        for (int ten = 0; ten < 3; ++ten)
#pragma unroll
            for (int j = 0; j < 4; ++j) { const int tt = t_abs - 3 + j;
                if (tt >= 0) { const bf16_t* src = PROJ + (size_t)(b * 2048 + tt) * NPROJ + ten * 512 + h * 128 + cg8 * 16; xr[ten][j][0] = *(const u32x4*)src; xr[ten][j][1] = *(const u32x4*)(src + 8); }
                else { xr[ten][j][0] = (u32x4){0u, 0u, 0u, 0u}; xr[ten][j][1] = (u32x4){0u, 0u, 0u, 0u}; } }
        __syncthreads();
        const float g = G[tok], bt = BT[tok];
        const float eg = __expf(g);
        float a[3][16];
#pragma unroll
        for (int ten = 0; ten < 3; ++ten) {
#pragma unroll
            for (int e = 0; e < 16; ++e) a[ten][e] = 0.f;
#pragma unroll
            for (int j = 0; j < 4; ++j) { float x[16]; unpack8(xr[ten][j][0], x); unpack8(xr[ten][j][1], x + 8);
                const LAS float* wj = WC + (ten * 4 + j) * 128 + cg8 * 16;
#pragma unroll
                for (int q = 0; q < 4; ++q) { const f32x4 w = *(const LAS f32x4*)(wj + 4 * q); a[ten][4 * q] += x[4 * q] * w[0]; a[ten][4 * q + 1] += x[4 * q + 1] * w[1]; a[ten][4 * q + 2] += x[4 * q + 2] * w[2]; a[ten][4 * q + 3] += x[4 * q + 3] * w[3]; } }
#pragma unroll
            for (int e = 0; e < 16; ++e) a[ten][e] = siluf_(a[ten][e]);
        }
        { float sq = 0.f, sk = 0.f;
#pragma unroll
          for (int e = 0; e < 16; ++e) { sq += a[0][e] * a[0][e]; sk += a[1][e] * a[1][e]; }
          SSP[cg8 * 64 + tok] = sq; SSP[512 + cg8 * 64 + tok] = sk; }
        __syncthreads();
        { float sq = 0.f, sk = 0.f;
#pragma unroll
          for (int w = 0; w < 8; ++w) { sq += SSP[w * 64 + tok]; sk += SSP[512 + w * 64 + tok]; }
          const float scq = rsqrtf(sq + EPS) * 0.08838834764831845f, sck = rsqrtf(sk + EPS);
#pragma unroll
          for (int e = 0; e < 16; ++e) { a[0][e] *= scq; a[1][e] *= sck; } }
        {
            LAS unsigned char* q = lds + L_QH + tok * 272 + cg8 * 32;
            *(LAS u32x4*)q = pack8(a[0]); *(LAS u32x4*)(q + 16) = pack8(a[0] + 8);
            float p[16];
#pragma unroll
            for (int e = 0; e < 16; ++e) p[swap23(e)] = a[0][e] * eg;
            bf16_t* dst = QP + tok * 128 + cg8 * 16; st16_wt(dst, pack8(p)); st16_wt(dst + 8, pack8(p + 8));
        }
        {
            LAS unsigned char* q = lds + L_KH + tok * 272 + cg8 * 32;
            *(LAS u32x4*)q = pack8(a[1]); *(LAS u32x4*)(q + 16) = pack8(a[1] + 8);
            const float f = bt * eg;
#pragma unroll
            for (int e = 0; e < 16; ++e) *(LAS bf16_t*)(lds + L_RT + (128 + cg8 * 16 + e) * 144 + tok * 2) = f2bf(a[1][e] * f);
        }
#pragma unroll
        for (int e = 0; e < 16; ++e) *(LAS bf16_t*)(lds + L_RT + (cg8 * 16 + e) * 144 + tok * 2) = f2bf(a[2][e] * bt);
    }
    __syncthreads();
    {
        int r = lane & 31, hh = lane >> 5; asm volatile("" : "+v"(r), "+v"(hh));
        const int blk = wid & 3, I = (blk == 1 || blk == 2) ? 1 : 0, J = (blk == 2 || blk == 3) ? 1 : 0; const bool isq = wid >= 4;
        f32x16 x;
#pragma unroll
        for (int i = 0; i < 16; ++i) x[i] = 0.f;
        if (blk != 3) {
            LAS unsigned char* Ab = lds + (isq ? L_QH : L_KH) + (32 * I + r) * 272 + hh * 16; LAS unsigned char* Bb = lds + L_KH + (32 * J + r) * 272 + hh * 16;
#pragma unroll
            for (int s = 0; s < 8; ++s) { const bf16x8 av = *(LAS bf16x8*)(Ab + s * 32), bv = *(LAS bf16x8*)(Bb + s * 32); x = isq ? MFMA32(bv, av, x) : MFMA32(av, bv, x); }
        }
        if (!isq) {
            const int jj = 32 * J + r; const float gj = G[jj];
            if (blk != 3) {
#pragma unroll
                for (int i = 0; i < 16; ++i) { const int ii = 32 * I + crow(i, hh); const float d = __expf(fminf(G[ii] - gj, 0.f)); ((LAS float*)(lds + L_AM))[ii * 68 + jj] = (ii > jj) ? BT[ii] * x[i] * d : 0.f; } }
        } else {
            const int ii = 32 * I + r; const float gi = G[ii]; float f[16];
#pragma unroll
            for (int i = 0; i < 16; ++i) { const int jj = 32 * J + crow(i, hh); const float d = __expf(fminf(gi - G[jj], 0.f)); f[i] = (ii >= jj && blk != 3) ? x[i] * d : 0.f; }
            bf16_t* dst = QKP + ii * 64 + 32 * J; st16_wt(dst + 8 * hh, pack8(f)); st16_wt(dst + 16 + 8 * hh, pack8(f + 8));
        }
    }
    {
        const int dk = tid & 127, tq = tid >> 7; const float glast = G[63]; float f[16];
#pragma unroll
        for (int t = 0; t < 16; ++t) { const int tk = 16 * tq + t; f[swap23(t)] = bf2f(*(LAS bf16_t*)(lds + L_KH + tk * 272 + dk * 2)) * __expf(glast - G[tk]); }
        bf16_t* dst = KTP + dk * 64 + 16 * tq; st16_wt(dst, pack8(f)); st16_wt(dst + 8, pack8(f + 8));
    }
    __syncthreads();
#ifndef NOINV
    if (wid == 0) {
        f32x2v t2[32]; f32x4 ab[2][16]; float lanef = (float)lane; asm volatile("" : "+v"(lanef));
        int zoff; asm volatile("v_mov_b32 %0, 0" : "=v"(zoff));
        LAS float* AM = (LAS float*)(lds + L_AM) + zoff;
        t2[0].x = fmaxf(1.0f - fabsf(lanef), 0.f); t2[0].y = 0.f;
        ab[1][0] = *(LAS f32x4*)(AM + 68);
#pragma unroll
        for (int i = 1; i < 64; ++i) {
            if (i + 1 < 64) {
#pragma unroll
                for (int q = 0; q < (i + 4) / 4; ++q) ab[(i + 1) & 1][q] = *(LAS f32x4*)(AM + (i + 1) * 68 + 4 * q); }
            __builtin_amdgcn_sched_barrier(0);
            f32x2v acc2 = {fmaxf(1.0f - fabsf(lanef - (float)i), 0.f), 0.f};
#pragma unroll
            for (int q = 0; q < (i + 3) / 4; ++q) { const f32x4 av = ab[i & 1][q]; const int j = 4 * q;
                if (j + 1 < i) acc2 -= (f32x2v){av[0], av[1]} * t2[j / 2]; else acc2.x -= av[0] * t2[j / 2].x;
                if (j + 3 < i) acc2 -= (f32x2v){av[2], av[3]} * t2[j / 2 + 1]; else if (j + 2 < i) acc2.x -= av[2] * t2[j / 2 + 1].x; }
            const float ti = acc2.x + acc2.y;
            if (i & 1) t2[i / 2].y = ti; else { t2[i / 2].x = ti; t2[i / 2].y = 0.f; }
            __builtin_amdgcn_sched_barrier(0);
        }
#pragma unroll
        for (int i = 0; i < 32; ++i) { *(LAS bf16_t*)(lds + L_TB + (2 * i) * 144 + lane * 2) = f2bf(t2[i].x); *(LAS bf16_t*)(lds + L_TB + (2 * i + 1) * 144 + lane * 2) = f2bf(t2[i].y); }
    }
#endif
    __syncthreads();
    {
        int r = lane & 31, hh = lane >> 5; asm volatile("" : "+v"(r), "+v"(hh));
#pragma unroll
        for (int tb = 0; tb < 2; ++tb) {
            f32x16 x;
#pragma unroll
            for (int i = 0; i < 16; ++i) x[i] = 0.f;
#pragma unroll
            for (int s = 0; s < 4; ++s) if (s < 2 || tb == 1) {
                const bf16x8 tf = *(LAS bf16x8*)(lds + L_TB + (32 * tb + r) * 144 + (16 * s + 8 * hh) * 2), rf = *(LAS bf16x8*)(lds + L_RT + (32 * wid + r) * 144 + (16 * s + 8 * hh) * 2);
                x = (wid < 4) ? MFMA32(tf, rf, x) : MFMA32(rf, tf, x); }
            float f[16];
#pragma unroll
            for (int i = 0; i < 16; ++i) f[i] = x[i];
            bf16_t* dst = (wid < 4) ? UT + (32 * wid + r) * 64 + 32 * tb : WP + (32 * tb + r) * 128 + 32 * (wid - 4);
            st16_wt(dst + 8 * hh, pack8(f)); st16_wt(dst + 16 + 8 * hh, pack8(f + 8));
        }
    }
    asm volatile("s_waitcnt vmcnt(0)" ::: "memory");
    __syncthreads();
    if (tid == 0) __hip_atomic_store((unsigned*)(c.ws + WS_FLAGS) + ch, 1u, __ATOMIC_RELAXED, __HIP_MEMORY_SCOPE_AGENT);
}

DI void sample_gdn2(const Ctx& c, LAS unsigned char* lds, int pair) {
    const int tid = mk_tid(), lane = tid & 63, half = tid >> 8, ht = tid & 255, hw = (tid >> 6) & 3;
    const int item = pair * 2 + half, b = item >> 2, h = item & 3;
    float* ctl = (float*)(c.ws + WS_CTL);
    const bf16_t* PROJ = (const bf16_t*)(c.ws + WS_B); bf16_t* OY = (bf16_t*)(c.ws + WS_A);
    LAS float* vals = (LAS float*)lds + half * 3072;
    LAS float* red = vals + 1536;
    LAS float* red2 = red + 256;
    LAS float* os = red2 + 256;
    const int row0 = NTP + b * 4;
    for (int i = ht; i < 1536; i += 256) { const int ten = i >> 9, tok = (i >> 7) & 3, ch = i & 127; const int col = ten * 512 + h * 128 + ch; float a = 0.f;
#pragma unroll
        for (int j = 0; j < 4; ++j) { const int idx = tok + j; const float xv = idx < 3 ? c.state_gdn_conv[((size_t)b * 3 + idx) * 1536 + col] : bf2f(PROJ[(size_t)(row0 + idx - 3) * NPROJ + col]); a += xv * c.w_conv_qkv[j * 1536 + col]; }
        vals[i] = siluf_(a); }
    __syncthreads();
#pragma unroll
    for (int rep = 0; rep < 2; ++rep) { const int pr = hw * 2 + rep, ten = pr >> 2, tok = pr & 3; LAS float* v = vals + ten * 512 + tok * 128; const float a0 = v[lane], a1 = v[lane + 64]; float ss = a0 * a0 + a1 * a1;
#pragma unroll
        for (int o = 32; o >= 1; o >>= 1) ss += __shfl_xor(ss, o);
        const float sc = rsqrtf(ss + EPS) * (ten == 0 ? 0.08838834764831845f : 1.0f); v[lane] = a0 * sc; v[lane + 64] = a1 * sc; }
    __syncthreads();
    const int e = ht & 127, part = ht >> 7;
    float s[64];
    const float* S0 = c.state_gdn + ((size_t)item * 128 + part * 64) * 128 + e;
#pragma unroll
    for (int i = 0; i < 64; ++i) s[i] = S0[(size_t)i * 128];
#pragma unroll 1
    for (int t = 0; t < 4; ++t) {
        const float a = __expf(ctl[CTL_LA + (size_t)(row0 + t) * 4 + h]), bt = ctl[CTL_BETA + (size_t)(row0 + t) * 4 + h];
        LAS float* qv = vals + t * 128 + part * 64; LAS float* kv = vals + 512 + t * 128 + part * 64;
        float p = 0.f;
#pragma unroll
        for (int i = 0; i < 64; ++i) { s[i] *= a; p += s[i] * kv[i]; }
        red[part * 128 + e] = p;
        __syncthreads();
        const float rr = bt * (vals[1024 + t * 128 + e] - (red[e] + red[128 + e]));
        float po = 0.f;
#pragma unroll
        for (int i = 0; i < 64; ++i) { s[i] += kv[i] * rr; po += s[i] * qv[i]; }
        red2[part * 128 + e] = po;
        __syncthreads();
        if (part == 0) os[t * 128 + e] = red2[e] + red2[128 + e];
    }
    float* Sout = c.out + OFF_GS + ((size_t)item * 128 + part * 64) * 128 + e;
#pragma unroll
    for (int i = 0; i < 64; ++i) Sout[(size_t)i * 128] = s[i];
    __syncthreads();
#pragma unroll
    for (int rep = 0; rep < 2; ++rep) { const int tok = part * 2 + rep; float ss = 0.f;
        for (int i = 0; i < 128; ++i) { const float v = os[tok * 128 + i]; ss += v * v; }
        const float rs = rsqrtf(ss * (1.0f / 128.0f) + EPS); const int row = row0 + tok;
        const float z = bf2f(PROJ[(size_t)row * NPROJ + 1536 + h * 128 + e]);
        OY[(size_t)row * D + h * 128 + e] = f2bf(os[tok * 128 + e] * rs * c.w_gdn_norm[e] * siluf_(z)); }
    __syncthreads();
}

DI void shortconv_items(const Ctx& c, int item_lo, int item_hi, int bfirst, int bcount) {
    const int tid = mk_tid();
    const bf16_t* PROJ = (const bf16_t*)(c.ws + WS_B); bf16_t* OY = (bf16_t*)(c.ws + WS_A);
    for (int item = item_lo + bfirst * NTHREADS + tid; item < item_hi; item += bcount * NTHREADS) {
        const int row = item >> 6, c8 = (item & 63) * 8;
        const bool prm = row < NTP; const int sb = prm ? (row >> 11) : ((row - NTP) >> 2); const int t = prm ? (row & 2047) : ((row - NTP) & 3); const int T = prm ? 2048 : 4;
        float bv[8]; unpack8(*(const u32x4*)(PROJ + (size_t)row * NPROJ + 2048 + c8), bv);
        float acc[8], cur[8];
#pragma unroll
        for (int e = 0; e < 8; ++e) { acc[e] = 0.f; cur[e] = 0.f; }
#pragma unroll
        for (int d = 0; d < 3; ++d) { const int tt = t - 2 + d; float sc[8];
            if (tt >= 0) { float cv[8], hv[8]; const bf16_t* src = PROJ + (size_t)(row - (2 - d)) * NPROJ + c8; unpack8(*(const u32x4*)(src + 2560), cv); unpack8(*(const u32x4*)(src + 3072), hv);
#pragma unroll
                for (int e = 0; e < 8; ++e) sc[e] = cv[e] * hv[e]; }
            else if (!prm) { const float* sp = c.state_sc_conv + ((size_t)sb * 2 + (2 + tt)) * 512 + c8; const f32x4 s0 = *(const f32x4*)sp, s1 = *(const f32x4*)(sp + 4);
#pragma unroll
                for (int e = 0; e < 4; ++e) { sc[e] = s0[e]; sc[4 + e] = s1[e]; } }
            else {
#pragma unroll
                for (int e = 0; e < 8; ++e) sc[e] = 0.f; }
            const float* wp = c.w_conv_sc + d * 512 + c8; const f32x4 w0 = *(const f32x4*)wp, w1 = *(const f32x4*)(wp + 4);
#pragma unroll
            for (int e = 0; e < 4; ++e) { acc[e] += sc[e] * w0[e]; acc[4 + e] += sc[4 + e] * w1[e]; }
            if (d == 2) {
#pragma unroll
                for (int e = 0; e < 8; ++e) cur[e] = sc[e]; } }
#pragma unroll
        for (int e = 0; e < 8; ++e) acc[e] *= bv[e];
        *(u32x4*)(OY + (size_t)row * D + 512 + c8) = pack8(acc);
        if (t >= T - 2) { float* dst = (prm ? c.out + OFF_SCP : c.out + OFF_SCS) + ((size_t)sb * 2 + (t - (T - 2))) * 512 + c8;
            *(f32x4*)dst = (f32x4){cur[0], cur[1], cur[2], cur[3]}; *(f32x4*)(dst + 4) = (f32x4){cur[4], cur[5], cur[6], cur[7]}; }
    }
}
DI void conv_state_copies(const Ctx& c, int bfirst, int bcount) {
    const int tid = mk_tid();
    const bf16_t* PROJ = (const bf16_t*)(c.ws + WS_B);
    for (int idx = bfirst * NTHREADS + tid; idx < 136 * 4608; idx += bcount * NTHREADS) {
        const int seq = idx / 4608, rem = idx % 4608, j = rem / 1536, col = rem % 1536;
        if (seq < 8) c.out[OFF_GCP + idx] = bf2f(PROJ[(size_t)(seq * 2048 + 2045 + j) * NPROJ + col]);
        else c.out[OFF_GCS + (idx - 8 * 4608)] = bf2f(PROJ[(size_t)(NTP + (seq - 8) * 4 + 1 + j) * NPROJ + col]);
    }
}

constexpr int P3_BUF = 57344, P3_OB = 114688, L_XST = 148480, P3_WN = 148496;
DI void scan_seq(const Ctx& c, LAS unsigned char* lds, int bh) {
    const int tid = mk_tid(), lane = tid & 63, wid = tid >> 6, r = lane & 31, hh = lane >> 5;
    const int b = bh >> 2, h = bh & 3;
    const bool loader = wid >= 4; const int lt = tid & 255;
    const float* ctl = (const float*)(c.ws + WS_CTL);
    const bf16_t* PROJ = (const bf16_t*)(c.ws + WS_B); bf16_t* OY = (bf16_t*)(c.ws + WS_A);
    LAS float* OB = (LAS float*)(lds + P3_OB);
    const int ch0 = b * 128 + h;
    const u32x4* gQ = (const u32x4*)((const bf16_t*)c.out) ; const u32x4* gW = gQ + (size_t)1024 * 1024; const u32x4* gKT = gQ + (size_t)2048 * 1024;
    const u32x4* gQK = (const u32x4*)((const bf16_t*)(c.ws + WS_C) + (size_t)1024 * 8192);
    const bf16_t* gUT = (const bf16_t*)(c.ws + WS_C);
    f32x16 S[4];
#pragma unroll
    for (int kt = 0; kt < 4; ++kt)
#pragma unroll
        for (int i = 0; i < 16; ++i) S[kt][i] = 0.f;
    const int e0 = 32 * (wid & 3);
    u32x4 zr[4]; u32x4 un[4]; float decn = 1.f;
#define P3_DMA(gp, ldsp) __builtin_amdgcn_global_load_lds((const unsigned*)(gp), (LAS unsigned*)(ldsp), 16, 0, 0)
    const int lw = (wid & 3) * 1024;
    int srcA[4], srcB[4];
#pragma unroll
    for (int i = 0; i < 4; ++i) { const int q = lt + 256 * i; const int rowA = q >> 4, rowB = q >> 3; srcA[i] = rowA * 16 + ((q & 15) ^ (rowA & 15)); srcB[i] = rowB * 8 + ((q & 7) ^ ((rowB >> 1) & 7)); }
    const int gtok = lt >> 2, gpart = lt & 3;
    if (tid < 128) ((LAS float*)(lds + P3_WN))[tid] = c.w_gdn_norm[tid];
    unsigned* const flags = (unsigned*)(c.ws + WS_FLAGS);
#define P3_WAIT(chx) do { unsigned sp_ = 0u; while (__hip_atomic_load(flags + (chx), __ATOMIC_RELAXED, __HIP_MEMORY_SCOPE_AGENT) == 0u) { __builtin_amdgcn_s_sleep(2); if (++sp_ > (1u << 22)) break; } __builtin_amdgcn_fence(__ATOMIC_ACQUIRE, "agent"); } while (0)
    P3_WAIT(ch0);
    if (loader) {
        const size_t t0 = (size_t)ch0 * 1024;
#pragma unroll
        for (int i = 0; i < 4; ++i) { P3_DMA(gW + t0 + srcA[i], lds + lw + 4096 * i); P3_DMA(gQ + t0 + srcA[i], lds + 16384 + lw + 4096 * i); P3_DMA(gKT + t0 + srcB[i], lds + 32768 + lw + 4096 * i); }
#pragma unroll
        for (int i = 0; i < 2; ++i) P3_DMA(gQK + (size_t)ch0 * 512 + srcB[i], lds + 49152 + lw + 4096 * i);
        asm volatile("s_waitcnt vmcnt(0)" ::: "memory");
    } else {
        const bf16_t* up = gUT + (size_t)ch0 * 8192 + (e0 + r) * 64 + 8 * hh;
        un[0] = *(const u32x4*)up; un[1] = *(const u32x4*)(up + 16); un[2] = *(const u32x4*)(up + 32); un[3] = *(const u32x4*)(up + 48);
        decn = __expf(__hip_atomic_load(ctl + CTL_GL + ch0, __ATOMIC_RELAXED, __HIP_MEMORY_SCOPE_AGENT));
    }
    const int rw = r & 15, rk = (r >> 1) & 7;
    if (loader) {
#pragma unroll 1
        for (int n = 0; n <= 32; ++n) {
            __syncthreads();
            if (n < 31) { P3_WAIT(ch0 + 4 * (n + 1)); const size_t t1 = (size_t)(ch0 + 4 * (n + 1)) * 1024; LAS unsigned char* Bn = lds + ((n + 1) & 1) * P3_BUF;
#pragma unroll
                for (int i = 0; i < 4; ++i) { P3_DMA(gW + t1 + srcA[i], Bn + lw + 4096 * i); P3_DMA(gQ + t1 + srcA[i], Bn + 16384 + lw + 4096 * i); P3_DMA(gKT + t1 + srcB[i], Bn + 32768 + lw + 4096 * i); }
#pragma unroll
                for (int i = 0; i < 2; ++i) P3_DMA(gQK + (size_t)(ch0 + 4 * (n + 1)) * 512 + srcB[i], Bn + 49152 + lw + 4096 * i); }
            if (n >= 1) {
                const int row = b * 2048 + (n - 1) * 64 + gtok; LAS float* op = OB + gtok * 132 + gpart * 32;
                float o[32]; float ss = 0.f;
#pragma unroll
                for (int q = 0; q < 8; ++q) { const f32x4 v = *(LAS f32x4*)(op + 4 * q); o[4 * q] = v[0]; o[4 * q + 1] = v[1]; o[4 * q + 2] = v[2]; o[4 * q + 3] = v[3]; ss += (v[0] * v[0] + v[1] * v[1]) + (v[2] * v[2] + v[3] * v[3]); }
                ss += __shfl_xor(ss, 1); ss += __shfl_xor(ss, 2);
                const float rs = rsqrtf(ss * (1.0f / 128.0f) + EPS);
                float z[32]; unpack8(zr[0], z); unpack8(zr[1], z + 8); unpack8(zr[2], z + 16); unpack8(zr[3], z + 24);
#pragma unroll
                for (int e = 0; e < 32; ++e) o[e] = o[e] * rs * ((LAS float*)(lds + P3_WN))[gpart * 32 + e] * siluf_(z[e]);
                bf16_t* dst = OY + (size_t)row * D + h * 128 + gpart * 32;
                *(u32x4*)dst = pack8(o); *(u32x4*)(dst + 8) = pack8(o + 8); *(u32x4*)(dst + 16) = pack8(o + 16); *(u32x4*)(dst + 24) = pack8(o + 24);
            }
            __syncthreads();
            asm volatile("s_waitcnt vmcnt(0)" ::: "memory");
            if (n < 32) { const bf16_t* zp = PROJ + (size_t)(b * 2048 + n * 64 + gtok) * NPROJ + 1536 + h * 128 + gpart * 32;
                zr[0] = *(const u32x4*)zp; zr[1] = *(const u32x4*)(zp + 8); zr[2] = *(const u32x4*)(zp + 16); zr[3] = *(const u32x4*)(zp + 24); }
        }
    } else {
#pragma unroll 1
        for (int n = 0; n <= 32; ++n) {
            __syncthreads();
            LAS unsigned char* B = lds + (n & 1) * P3_BUF;
            f32x16 O[2];
            if (n < 32) {
                const f32x16 zero16 = {0.f, 0.f, 0.f, 0.f, 0.f, 0.f, 0.f, 0.f, 0.f, 0.f, 0.f, 0.f, 0.f, 0.f, 0.f, 0.f};
                f32x16 P[2]; P[0] = zero16; P[1] = zero16; O[0] = zero16; O[1] = zero16;
#pragma unroll
                for (int kt = 0; kt < 4; ++kt)
#pragma unroll
                    for (int s = 0; s < 2; ++s) { const bf16x8 sb = pack_step(S[kt], s);
#pragma unroll
                        for (int mi = 0; mi < 2; ++mi) { const int off = ((32 * mi + r) * 16 + ((4 * kt + 2 * s + hh) ^ rw)) * 16;
                            P[mi] = MFMA32(*(LAS bf16x8*)(B + off), sb, P[mi]); O[mi] = MFMA32(*(LAS bf16x8*)(B + 16384 + off), sb, O[mi]); } }
                bf16x8 vb[2][2];
#pragma unroll
                for (int tb = 0; tb < 2; ++tb) { float u[16]; unpack8(un[2 * tb], u); unpack8(un[2 * tb + 1], u + 8);
                    f32x16 vn;
#pragma unroll
                    for (int i = 0; i < 16; ++i) vn[i] = u[i] - P[tb][i];
                    vb[tb][0] = pack_step(vn, 0); vb[tb][1] = pack_step(vn, 1); }
                const float dec = decn;
                if (n < 31) { P3_WAIT(ch0 + 4 * (n + 1)); const bf16_t* up = gUT + (size_t)(ch0 + 4 * (n + 1)) * 8192 + (e0 + r) * 64 + 8 * hh;
                    un[0] = *(const u32x4*)up; un[1] = *(const u32x4*)(up + 16); un[2] = *(const u32x4*)(up + 32); un[3] = *(const u32x4*)(up + 48);
                    decn = __expf(__hip_atomic_load(ctl + CTL_GL + ch0 + 4 * (n + 1), __ATOMIC_RELAXED, __HIP_MEMORY_SCOPE_AGENT)); }
#pragma unroll
                for (int mi = 0; mi < 2; ++mi)
#pragma unroll
                    for (int tb = 0; tb <= mi; ++tb)
#pragma unroll
                        for (int s = 0; s < 2; ++s) O[mi] = MFMA32(*(LAS bf16x8*)(B + 49152 + ((32 * mi + r) * 8 + ((4 * tb + 2 * s + hh) ^ rk)) * 16), vb[tb][s], O[mi]);
#pragma unroll
                for (int kt = 0; kt < 4; ++kt) { S[kt] *= dec;
#pragma unroll
                    for (int tb = 0; tb < 2; ++tb)
#pragma unroll
                        for (int s = 0; s < 2; ++s) S[kt] = MFMA32(*(LAS bf16x8*)(B + 32768 + ((32 * kt + r) * 8 + ((4 * tb + 2 * s + hh) ^ rk)) * 16), vb[tb][s], S[kt]); }
            }
            __syncthreads();
            if (n < 32) {
#pragma unroll
                for (int mi = 0; mi < 2; ++mi)
#pragma unroll
                    for (int i = 0; i < 16; ++i) OB[(32 * mi + crow(i, hh)) * 132 + e0 + r] = O[mi][i];
            }
        }
    }
    if (!loader) { float* So = c.out + OFF_GP + (size_t)bh * 16384;
#pragma unroll
        for (int kt = 0; kt < 4; ++kt)
#pragma unroll
            for (int i = 0; i < 16; ++i) So[(32 * kt + crow(i, hh)) * 128 + e0 + r] = S[kt][i]; }
    __syncthreads();
}

DI void sub_barrier(unsigned* cnt, unsigned target, bool release = true) {
    asm volatile("s_waitcnt vmcnt(0)" ::: "memory");
    __syncthreads();
    if (mk_tid() == 0) {
        if (release) { __builtin_amdgcn_fence(__ATOMIC_RELEASE, "agent"); asm volatile("s_waitcnt vmcnt(0)" ::: "memory"); }
        (void)xb_add(cnt, 1u);
        unsigned sp = 0u; while (xb_ld(cnt) < target) { __builtin_amdgcn_s_sleep(1); if (++sp > (1u << 22)) break; }
        __builtin_amdgcn_fence(__ATOMIC_ACQUIRE, "agent");
        asm volatile("s_waitcnt vmcnt(0)" ::: "memory");
    }
    __syncthreads();
}

__global__ void __launch_bounds__(NTHREADS, 2) mega(Ctx c) {
    extern __shared__ __attribute__((aligned(16))) unsigned char shm[];
    LAS unsigned char* lds = (LAS unsigned char*)shm;
    { const unsigned t0 = threadIdx.x; if ((t0 & 63u) == 0u) ((LAS unsigned*)(lds + L_WTAB))[mk_slot()] = t0 >> 6; }
    __syncthreads();
    unsigned char* ws = c.ws; float* ctl = (float*)(ws + WS_CTL);
    const int lo = c.ph_lo, hi = c.ph_hi;
    if (hi > 1000) cg::this_grid().sync();
    volatile LAS unsigned* xst = (volatile LAS unsigned*)(lds + L_XST);
    if (mk_tid() < 4) xst[mk_tid()] = 0u;
    __syncthreads();
    XcdBarrier bar = xcd_barrier_post((unsigned*)(ws + WS_BAR), xst);
#ifdef ONLY
#define IN(k) ((k) == ONLY)
#else
#define IN(k) (lo <= (k) && (k) < hi)
#endif
#define SEAM(k) do { if (IN(k) && IN((k) + 1)) xcd_barrier(bar); } while (0)
    if (IN(0)) p0_phase(c, lds);
    SEAM(0);
    if (IN(1)) { pg8::Gemm g{(const bf16_t*)(ws + WS_A), (const bf16_t*)(ws + WS_WIN), NT, NPROJ, D, 0}; pg8::StaticOrder S; S.init(NT, NPROJ, gridDim.x, blockIdx.x);
        EpiProj E{(bf16_t*)(ws + WS_B), NPROJ, ctl + CTL_RS0}; pg8::gemm_phase<EpiProj, pg8::StaticOrder, false>(lds, g, S, E, nullptr); }
    SEAM(1);
    if (IN(3)) {
        unsigned* const chw = (unsigned*)(ws + WS_BAR) + 96;
        if (blockIdx.x < 32 || blockIdx.x >= 64) {
            const int q = blockIdx.x < 32 ? (int)blockIdx.x : (int)blockIdx.x - 32, nq = (int)gridDim.x - 32;
            for (int it = q; it < 256; it += nq) sample_gdn2(c, lds, it);
            shortconv_items(c, NTP * 64, NT * 64, q, nq);
            asm volatile("s_waitcnt vmcnt(0)" ::: "memory");
            __syncthreads();
            if (mk_tid() == 0) { __builtin_amdgcn_fence(__ATOMIC_RELEASE, "agent"); asm volatile("s_waitcnt vmcnt(0)" ::: "memory"); (void)xb_add(chw, 1u); }
        }
        if (blockIdx.x < 32) { scan_seq(c, lds, blockIdx.x); const int nq = (int)gridDim.x - 32, q = nq - 32 + (int)blockIdx.x; shortconv_items(c, 0, NTP * 64, q, nq); conv_state_copies(c, q, nq); }
        else if (blockIdx.x < 64) {
            if (mk_tid() == 0) { unsigned sp = 0u; while (xb_ld(chw) < gridDim.x - 32u) { __builtin_amdgcn_s_sleep(2); if (++sp > (1u << 22)) break; } __builtin_amdgcn_fence(__ATOMIC_ACQUIRE, "agent"); asm volatile("s_waitcnt vmcnt(0)" ::: "memory"); }
            __syncthreads();
            const int j = blockIdx.x - 32; unsigned* sc = (unsigned*)(ws + WS_BAR) + 64;
            { pg8::Gemm g{(const bf16_t*)(ws + WS_A), (const bf16_t*)(ws + WS_WOUT), NT, D, D, 0}; SubOrder S{64, 2, 4, 8, j < 8 ? j : -1};
              EpiRes<0> E{c.x_prompt, c.x_sample, (bf16_t*)(ws + WS_C), nullptr, ctl + CTL_SS1, nullptr, nullptr, 1}; pg8::gemm_phase<EpiRes<0>, SubOrder, false>(lds, g, S, E, nullptr); }
            { pg8::Gemm g{(const bf16_t*)(ws + WS_PB), (const bf16_t*)(ws + WS_WP), NT, D, PLE, 0}; SubOrder S{64, 2, 4, 8, (j >= 8 && j < 16) ? j - 8 : -1};
              EpiProj E{(bf16_t*)(ws + WS_PPS) - (size_t)NTP * D, D, nullptr, 1}; pg8::gemm_phase<EpiProj, SubOrder, false>(lds, g, S, E, nullptr); }
            sub_barrier(sc, 32u, false);
            { pg8::Gemm g{(const bf16_t*)(ws + WS_C), (const bf16_t*)(ws + WS_WUP), NT, DFF, D, 0}; SubOrder S{64, 2, 16, 32, j};
              EpiUp E{(bf16_t*)(ws + WS_B), ctl + CTL_SS1, 1}; pg8::gemm_phase<EpiUp, SubOrder, false>(lds, g, S, E, nullptr); }
            sub_barrier(sc, 64u, false);
            { const int kq = j >> 3; pg8::Gemm g{(const bf16_t*)(ws + WS_B) + kq * 1024, (const bf16_t*)(ws + WS_WDN) + kq * 1024, NT, D, 1024, DFF}; SubOrder S{64, 2, 4, 8, j & 7};
              EpiSplitK E{(float*)(ws + WS_B + SLAB_OFF), kq, (bf16_t*)(ws + WS_C), ctl + CTL_SS2, (unsigned*)(ws + WS_PCNT) + 66 * 32}; pg8::gemm_phase<EpiSplitK, SubOrder, false>(lds, g, S, E, nullptr); }
            sub_barrier(sc, 96u, false);
            { pg8::Gemm g{(const bf16_t*)(ws + WS_C), (const bf16_t*)(ws + WS_WG), NT, D, D, 0}; SubOrder S{64, 2, 4, 8, j < 8 ? j : -1};
              EpiFinal E{(const bf16_t*)(ws + WS_C), (const bf16_t*)(ws + WS_PPS) - (size_t)NTP * D, ctl + CTL_SS2, ctl + CTL_SS3, (unsigned*)(ws + WS_PCNT), c.norm_f, c.out}; pg8::gemm_phase<EpiFinal, SubOrder, false>(lds, g, S, E, nullptr); }
        }
        else { const int q = (int)blockIdx.x - 64, nq = (int)gridDim.x - 64;
            for (int i = q; i < 1024; i += nq) { const int n = i >> 5, bh = i & 31; prep_chunk(c, lds, ((bh >> 2) * 32 + n) * 4 + (bh & 3)); }
            shortconv_items(c, 0, NTP * 64, q, nq + 32);
            conv_state_copies(c, q, nq + 32); }
    }
    SEAM(3);
    if (IN(4)) { pg8::Gemm g{(const bf16_t*)(ws + WS_A), (const bf16_t*)(ws + WS_WOUT), NT, D, D, 0}; pg8::StaticOrder S; S.init(NTP, D, gridDim.x, blockIdx.x);
        EpiRes<0> E{c.x_prompt, c.x_sample, (bf16_t*)(ws + WS_C), nullptr, ctl + CTL_SS1, nullptr, nullptr}; pg8::gemm_phase<EpiRes<0>, pg8::StaticOrder, false>(lds, g, S, E, nullptr); }
    SEAM(4);
    if (IN(5)) { pg8::Gemm g{(const bf16_t*)(ws + WS_C), (const bf16_t*)(ws + WS_WUP), NT, DFF, D, 0}; pg8::StaticOrder S; S.init(NTP, DFF, gridDim.x, blockIdx.x);
        EpiUp E{(bf16_t*)(ws + WS_B), ctl + CTL_SS1}; pg8::gemm_phase<EpiUp, pg8::StaticOrder, false>(lds, g, S, E, nullptr); }
    SEAM(5);
    if (IN(6)) {
        { pg8::Gemm g{(const bf16_t*)(ws + WS_B), (const bf16_t*)(ws + WS_WDN), NT, D, DFF, 0}; pg8::StaticOrder S; S.init(NTP, D, gridDim.x, blockIdx.x);
          EpiRes<1> E{nullptr, nullptr, (bf16_t*)(ws + WS_C), nullptr, ctl + CTL_SS2, nullptr, nullptr}; pg8::gemm_phase<EpiRes<1>, pg8::StaticOrder, false>(lds, g, S, E, nullptr); }
        { pg8::Gemm g{(const bf16_t*)(ws + WS_PB), (const bf16_t*)(ws + WS_WP), NT, D, PLE, 0}; pg8::StaticOrder S; S.init(NTP, D, gridDim.x, blockIdx.x);
          EpiProj E{(bf16_t*)(ws + WS_A), D, nullptr}; pg8::gemm_phase<EpiProj, pg8::StaticOrder, false>(lds, g, S, E, nullptr); }
    }
    SEAM(6);
    if (IN(7)) { pg8::Gemm g{(const bf16_t*)(ws + WS_C), (const bf16_t*)(ws + WS_WG), NT, D, D, 0}; pg8::StaticOrder S; S.init(NTP, D, gridDim.x, blockIdx.x);
        EpiFinal E{(const bf16_t*)(ws + WS_C), (const bf16_t*)(ws + WS_A), ctl + CTL_SS2, ctl + CTL_SS3, (unsigned*)(ws + WS_PCNT), c.norm_f, c.out}; pg8::gemm_phase<EpiFinal, pg8::StaticOrder, false>(lds, g, S, E, nullptr); }
#undef IN
#undef SEAM
}

#ifndef N_LAUNCH_MODE
#define N_LAUNCH_MODE 1
#endif
extern "C" void kernel_launch(void* const* d_in, const int* in_sizes, int n_in, void* d_out, int out_size, void* d_ws, size_t ws_size, hipStream_t stream) {
    static int grid = 0;
    if (grid == 0) {
        int dev = 0, cus = 0, per_cu = 0;
        if (ws_size < WS_END) { fprintf(stderr, "kernel_launch: workspace too small: %zu < %zu\n", ws_size, (size_t)WS_END); grid = -1; return; }
        hipGetDevice(&dev); hipDeviceGetAttribute(&cus, hipDeviceAttributeMultiprocessorCount, dev);
        if (hipFuncSetAttribute((const void*)mega, hipFuncAttributeMaxDynamicSharedMemorySize, LDS_BYTES) != hipSuccess) { fprintf(stderr, "kernel_launch: hipFuncSetAttribute failed\n"); grid = -1; return; }
        if (hipOccupancyMaxActiveBlocksPerMultiprocessor(&per_cu, (const void*)mega, NTHREADS, LDS_BYTES) != hipSuccess || per_cu < 1) { fprintf(stderr, "kernel_launch: occupancy query says %d\n", per_cu); per_cu = 1; }
        (void)hipGetLastError();
        grid = cus * 1;
    }
    if (grid < 0) return;
    (void)hipMemsetAsync((unsigned char*)d_ws + WS_BAR, 0, 32768, stream);
    Ctx a{};
    const float** ap = (const float**)&a;
    for (int i = 0; i < 22; ++i) ap[i] = (const float*)d_in[i];
    a.out = (float*)d_out; a.ws = (unsigned char*)d_ws;
#if N_LAUNCH_MODE == 1
    a.ph_lo = 0; a.ph_hi = 8;
    void* args[] = {&a};
    hipError_t e = hipLaunchCooperativeKernel((const void*)mega, dim3(grid), dim3(NTHREADS), args, LDS_BYTES, stream);
    if (e != hipSuccess) fprintf(stderr, "cooperative launch failed: %s (grid %d)\n", hipGetErrorString(e), grid);
#else
    for (int ph = 0; ph < 8; ++ph) { a.ph_lo = ph; a.ph_hi = ph + 1; hipLaunchKernelGGL(mega, dim3(grid), dim3(NTHREADS), LDS_BYTES, stream, a); }
#endif
}
```

```cpp
#include <hip/hip_runtime.h>
#include <hip/hip_cooperative_groups.h>
#include <cstdio>
namespace cg = cooperative_groups;

constexpr int L_WTAB = 149008;
static __device__ __forceinline__ unsigned mk_lane() { return __builtin_amdgcn_mbcnt_hi(~0u, __builtin_amdgcn_mbcnt_lo(~0u, 0u)); }
static __device__ __forceinline__ unsigned mk_slot() { return (unsigned)__builtin_amdgcn_s_getreg(0x2804) & 63u; }
static __device__ __forceinline__ unsigned mk_tid() {
    extern __shared__ __attribute__((aligned(16))) unsigned char mk_shm[];
    const unsigned w = ((__attribute__((address_space(3))) unsigned*)((__attribute__((address_space(3))) unsigned char*)mk_shm + L_WTAB))[mk_slot()];
    return (unsigned)__builtin_amdgcn_readfirstlane((int)w) * 64u + mk_lane();
}
namespace pg8 {
#define PG8_LAS __attribute__((address_space(3)))
typedef unsigned short bf16_t;
typedef short bf16x8 __attribute__((ext_vector_type(8)));
typedef float f32x4 __attribute__((ext_vector_type(4)));
typedef unsigned u32x4 __attribute__((ext_vector_type(4)));
constexpr int BM = 256, BK = 64, HALF = 128, HTB = HALF * BK * 2  , STAGE_BYTES = 8 * HTB, NXCD = 8, WGM = 8;

__host__ __device__ __forceinline__ int lds_byte(int r, int c) { const int st = (r >> 4) * 2 + (c >> 5), rr = r & 15, cc = c & 31, ob = rr * 64 + cc * 2; return st * 1024 + (ob ^ (((ob >> 9) & 1) << 5)); }
__host__ __device__ __forceinline__ void stage_rc(int b, int& R, int& C) { const int st = b / 1024, sb = b % 1024, swz = sb ^ (((sb >> 9) & 1) << 5); R = (st >> 1) * 16 + swz / 64; C = (st & 1) * 32 + (swz % 64) / 2; }
__host__ __device__ __forceinline__ int perm32(int rho) { const int n = rho >> 4, i = rho & 15; return 8 * (i >> 2) + 4 * n + (i & 3); }

struct Unit { int pm, pn; };
struct Gemm { const bf16_t* A; const bf16_t* Bt; int M, N, K; int ld; };

struct StaticOrder {
    int nM, nN, nwg, G, c;
    __host__ __device__ void init(int M, int N, int G_, int c_) { nM = M / BM; nN = N / BM; nwg = nM * nN; G = G_; c = c_; }
    __host__ __device__ bool next(int i, Unit& u) const {
        const long L = (long)i * G + c; if (L >= nwg) return false;
        int wgid = (int)L; { const int q = nwg / NXCD, r = nwg % NXCD, xcd = wgid % NXCD, off = wgid / NXCD; wgid = (xcd < r ? xcd * (q + 1) : r * (q + 1) + (xcd - r) * q) + off; }
        const int nig = WGM * nN, gid = wgid / nig, fm = gid * WGM, gsz = (nM - fm) < WGM ? (nM - fm) : WGM;
        u.pm = fm + ((wgid % nig) % gsz); u.pn = (wgid % nig) / gsz; return true;
    }
    __device__ __forceinline__ void a_ready(const Unit&) const {}
    __device__ __forceinline__ void done(const Unit&) const {}
};
template <class Epi, class Sched, bool STAMP = false>
__device__ __forceinline__ void gemm_phase(PG8_LAS unsigned char* lds, const Gemm g, const Sched& S, const Epi& E, unsigned long long* stamps) {
    int tid = mk_tid(); asm volatile("" : "+v"(tid));
    const int wid = __builtin_amdgcn_readfirstlane(tid >> 6), lane = tid & 63, wr = wid >> 2, wc = wid & 3, fr = lane & 15, fq = lane >> 4;
    const int K = g.K, nt = K / BK, LD = g.ld ? g.ld : g.K;
    int ts_lo = 0, ts_hi = 0, nts = 0; const unsigned long long rt_entry = STAMP ? (unsigned long long)wall_clock64() : 0ull;
#define PG8_STAMP() do { if (STAMP && wid == 0 && nts < 64) { const unsigned long long _c = (unsigned long long)clock64(); \
        ts_lo = (lane == nts) ? (int)(unsigned)_c : ts_lo; ts_hi = (lane == nts) ? (int)(unsigned)(_c >> 32) : ts_hi; ++nts; } } while (0)
    PG8_STAMP();
    unsigned voffA[2], voffB[2];
#pragma unroll
    for (int i = 0; i < 2; ++i) { int R, C; stage_rc(tid * 16 + i * 8192, R, C); const int Rb = Epi::PERM ? ((R & ~31) + perm32(R & 31)) : R;
        voffA[i] = (unsigned)(R * LD + C) * 2u; voffB[i] = (unsigned)(Rb * LD + C) * 2u; }
    const size_t kstep = (size_t)(BK * 2);
    const size_t hstep = (size_t)HALF * LD * 2;
    const size_t tstep = 2 * hstep;
    const unsigned ldsw = (unsigned)wid * 1024u;
    const int aoff = lds_byte(wr * 64 + fr, fq * 8), boff = lds_byte(wc * 32 + fr, fq * 8);
#define PG8_SA(b, h) (((b) * 2 + (h)) * HTB)
#define PG8_SB(b, h) ((4 + (b) * 2 + (h)) * HTB)
#define PG8_STAGE(bufoff, gbase, voff) do { _Pragma("unroll") for (int _i = 0; _i < 2; ++_i) \
        __builtin_amdgcn_global_load_lds((const unsigned*)((const char*)(gbase) + (voff)[_i]), (PG8_LAS unsigned*)(lds + (bufoff) + ldsw + _i * 8192), 16, 0, 0); } while (0)
#define PG8_LDA(dst, b, h) do { _Pragma("unroll") for (int m = 0; m < 4; ++m) _Pragma("unroll") for (int k = 0; k < 2; ++k) dst[m][k] = *(const PG8_LAS bf16x8*)(lds + PG8_SA(b, h) + aoff + m * 2048 + k * 1024); } while (0)
#define PG8_LDB(dst, b, h) do { _Pragma("unroll") for (int n = 0; n < 2; ++n) _Pragma("unroll") for (int k = 0; k < 2; ++k) dst[n][k] = *(const PG8_LAS bf16x8*)(lds + PG8_SB(b, h) + boff + n * 2048 + k * 1024); } while (0)
#define PG8_MMA(ai, bj, At, Bt) do { __builtin_amdgcn_s_setprio(1); _Pragma("unroll") for (int m = 0; m < 4; ++m) _Pragma("unroll") for (int n = 0; n < 2; ++n) _Pragma("unroll") for (int k = 0; k < 2; ++k) \
        acc[ai][bj][m][n] = __builtin_amdgcn_mfma_f32_16x16x32_bf16(Bt[n][k], At[m][k], acc[ai][bj][m][n], 0, 0, 0); __builtin_amdgcn_s_setprio(0); } while (0)
#define PG8_WAIT_V(n) asm volatile("s_waitcnt vmcnt(" #n ")" ::: "memory")
#define PG8_WAIT_L(n) asm volatile("s_waitcnt lgkmcnt(" #n ")" ::: "memory")
#define PG8_BAR __builtin_amdgcn_s_barrier()
#define PG8_SCHED __builtin_amdgcn_sched_barrier(0)
    Unit cur, nxt; int ui = 0;
    if (!S.next(0, cur)) return;
    f32x4 acc[2][2][4][2];
#pragma unroll
    for (int a = 0; a < 2; ++a)
#pragma unroll
        for (int b = 0; b < 2; ++b)
#pragma unroll
            for (int m = 0; m < 4; ++m)
#pragma unroll
                for (int n = 0; n < 2; ++n) acc[a][b][m][n] = (f32x4){0.f, 0.f, 0.f, 0.f};
    bf16x8 At[4][2], B0[2][2], B1[2][2];
    const char* cA = (const char*)g.A + (size_t)cur.pm * tstep; const char* cB = (const char*)g.Bt + (size_t)cur.pn * tstep;
    S.a_ready(cur);
    PG8_STAGE(PG8_SB(0, 0), cB, voffB); PG8_STAGE(PG8_SA(0, 0), cA, voffA); PG8_STAGE(PG8_SB(0, 1), cB + hstep, voffB); PG8_STAGE(PG8_SA(0, 1), cA + hstep, voffA);
    if (wr == 1) PG8_BAR;
    PG8_WAIT_V(4); PG8_BAR;
    PG8_STAGE(PG8_SB(1, 0), cB + kstep, voffB); PG8_STAGE(PG8_SA(1, 0), cA + kstep, voffA); PG8_STAGE(PG8_SB(1, 1), cB + hstep + kstep, voffB);
    PG8_WAIT_V(6); PG8_BAR;
    PG8_STAMP();
    for (;;) {
        const bool has_next = S.next(ui + 1, nxt);
        const char* nA = has_next ? (const char*)g.A + (size_t)nxt.pm * tstep : cA; const char* nB = has_next ? (const char*)g.Bt + (size_t)nxt.pn * tstep : cB;
        for (int t = 0; t < nt; t += 2) {
            const bool last = (t == nt - 2);
            const char* a1 = cA + (size_t)(t + 1) * kstep;
            const char* a2 = last ? nA : cA + (size_t)(t + 2) * kstep; const char* b2 = last ? nB : cB + (size_t)(t + 2) * kstep;
            const char* a3 = a2 + kstep; const char* b3 = b2 + kstep;
            if (last && has_next) S.a_ready(nxt);
            PG8_LDB(B0, 0, 0); PG8_SCHED; PG8_LDA(At, 0, 0); PG8_STAGE(PG8_SA(1, 1), a1 + hstep, voffA);
            PG8_WAIT_L(8); PG8_BAR; PG8_WAIT_L(0); PG8_MMA(0, 0, At, B0); PG8_BAR; PG8_SCHED;
            PG8_LDB(B1, 0, 1); PG8_STAGE(PG8_SB(0, 0), b2, voffB);
            PG8_BAR; PG8_WAIT_L(0); PG8_MMA(0, 1, At, B1); PG8_BAR;
            PG8_LDA(At, 0, 1); PG8_STAGE(PG8_SA(0, 0), a2, voffA);
            PG8_BAR; PG8_WAIT_L(0); PG8_MMA(1, 0, At, B0); PG8_BAR; PG8_SCHED;
            PG8_STAGE(PG8_SB(0, 1), b2 + hstep, voffB);
            PG8_WAIT_V(6); PG8_BAR; PG8_MMA(1, 1, At, B1); PG8_BAR;
            PG8_LDB(B0, 1, 0); PG8_SCHED; PG8_LDA(At, 1, 0); PG8_STAGE(PG8_SA(0, 1), a2 + hstep, voffA);
            PG8_WAIT_L(8); PG8_BAR; PG8_WAIT_L(0); PG8_MMA(0, 0, At, B0); PG8_BAR; PG8_SCHED;
            PG8_LDB(B1, 1, 1); PG8_STAGE(PG8_SB(1, 0), b3, voffB);
            PG8_BAR; PG8_WAIT_L(0); PG8_MMA(0, 1, At, B1); PG8_BAR;
            PG8_LDA(At, 1, 1); PG8_STAGE(PG8_SA(1, 0), a3, voffA);
            PG8_BAR; PG8_WAIT_L(0); PG8_MMA(1, 0, At, B0); PG8_BAR; PG8_SCHED;
            PG8_STAGE(PG8_SB(1, 1), b3 + hstep, voffB);
            PG8_WAIT_V(6); PG8_BAR; PG8_MMA(1, 1, At, B1); PG8_BAR;
        }
        PG8_STAMP();
        if constexpr (!Epi::AFTER_DRAIN) { E(acc, cur, wr, wc, fr, fq); S.done(cur); }
        PG8_STAMP();
        if (!has_next) break;
#pragma unroll
        for (int a = 0; a < 2; ++a)
#pragma unroll
            for (int b = 0; b < 2; ++b)
#pragma unroll
                for (int m = 0; m < 4; ++m)
#pragma unroll
                    for (int n = 0; n < 2; ++n) acc[a][b][m][n] = (f32x4){0.f, 0.f, 0.f, 0.f};
        cur = nxt; cA = nA; cB = nB; ++ui;
    }
    PG8_WAIT_V(0);
    if (wr == 0) PG8_BAR;
    PG8_BAR;
    if constexpr (Epi::AFTER_DRAIN) { E.fused(acc, cur, wr, wc, fr, fq, lds, wid, lane); S.done(cur); }
    PG8_STAMP();
    if (STAMP && wid == 0) { stamps[lane] = lane < nts ? (((unsigned long long)(unsigned)ts_hi << 32) | (unsigned)ts_lo) : 0ull;
        if (lane == 62) stamps[62] = rt_entry; if (lane == 63) stamps[63] = (unsigned long long)wall_clock64(); }
#undef PG8_STAMP
#undef PG8_SA
#undef PG8_SB
#undef PG8_STAGE
#undef PG8_LDA
#undef PG8_LDB
#undef PG8_MMA
#undef PG8_WAIT_V
#undef PG8_WAIT_L
#undef PG8_BAR
#undef PG8_SCHED
}
}
#define LAS __attribute__((address_space(3)))
using pg8::bf16_t; using pg8::bf16x8; using pg8::f32x4; using pg8::u32x4;
typedef float f32x16 __attribute__((ext_vector_type(16)));
typedef float f32x2v __attribute__((ext_vector_type(2)));
typedef __bf16 bf16x2v __attribute__((ext_vector_type(2)));
typedef unsigned u32x2 __attribute__((ext_vector_type(2)));
#define DI __device__ __forceinline__
#define MFMA32(a, b, c) __builtin_amdgcn_mfma_f32_32x32x16_bf16((a), (b), (c), 0, 0, 0)

constexpr int D = 1024, NTP = 16384, NTS = 512, NT = NTP + NTS;
constexpr int NPROJ = 3584, INDIM = 3592, DFF = 4096, PLE = 256;
constexpr float EPS = 1e-6f;
constexpr int NTHREADS = 512;
constexpr int LDS_BYTES = 149008 + 256;
constexpr size_t WS_WIN = 0;
constexpr size_t WS_WOUT = WS_WIN + (size_t)NPROJ * D * 2;
constexpr size_t WS_WUP = WS_WOUT + (size_t)D * D * 2;
constexpr size_t WS_WDN = WS_WUP + (size_t)DFF * D * 2;
constexpr size_t WS_WG = WS_WDN + (size_t)D * DFF * 2;
constexpr size_t WS_WP = WS_WG + (size_t)D * D * 2;
constexpr size_t WS_CTL = WS_WP + (size_t)D * PLE * 2;
constexpr size_t CTL_RS0 = 0, CTL_SS1 = NT, CTL_SS2 = 2 * NT, CTL_SS3 = 3 * NT, CTL_LA = 4 * NT, CTL_BETA = 8 * NT, CTL_GL = 12 * NT, CTL_FLOATS = 12 * NT + 1024;
constexpr size_t WS_PB = WS_CTL + ((CTL_FLOATS * 4 + 4095) / 4096) * 4096;
constexpr size_t WS_A = WS_PB + (size_t)NT * PLE * 2;
constexpr size_t WS_B = WS_A + (size_t)NT * D * 2;
constexpr size_t WS_C = WS_B + (size_t)NT * DFF * 2;
constexpr size_t WS_BAR = WS_C + (size_t)NT * D * 2;
constexpr size_t WS_FLAGS = WS_BAR + 16384;
constexpr size_t WS_PCNT = WS_BAR + 20480;
constexpr size_t WS_PPS = WS_BAR + 32768;
constexpr size_t WS_END = WS_PPS + (size_t)NTS * D * 2;
constexpr size_t OFF_Y = 0, OFF_GCP = 17301504, OFF_GP = 17338368, OFF_SCP = 17862656, OFF_GCS = 17870848, OFF_GS = 18460672, OFF_SCS = 26849280;

struct Ctx {
    const float* x_prompt; const float* x_sample; const float* state_gdn_conv; const float* state_gdn; const float* state_sc_conv; const float* p_prompt; const float* p_sample;
    const float* norm_mix; const float* w_in; const float* w_conv_qkv; const float* a_log; const float* dt_bias; const float* w_gdn_norm; const float* w_conv_sc; const float* w_out;
    const float* norm_mlp; const float* w_up; const float* w_down; const float* norm_ple; const float* w_ple_gate; const float* w_ple_proj; const float* norm_f;
    float* out; unsigned char* ws; int ph_lo, ph_hi;
};

DI unsigned pk2(float lo, float hi) { f32x2v v = {lo, hi}; return __builtin_bit_cast(unsigned, __builtin_convertvector(v, bf16x2v)); }
DI bf16_t f2bf(float f) { return (bf16_t)(pk2(f, 0.f) & 0xffffu); }
DI float bf2f(bf16_t b) { return __uint_as_float((unsigned)b << 16); }
DI float bflo(unsigned u) { return __uint_as_float(u << 16); }
DI float bfhi(unsigned u) { return __uint_as_float(u & 0xffff0000u); }
DI void unpack8(const u32x4 v, float* f) { f[0] = bflo(v.x); f[1] = bfhi(v.x); f[2] = bflo(v.y); f[3] = bfhi(v.y); f[4] = bflo(v.z); f[5] = bfhi(v.z); f[6] = bflo(v.w); f[7] = bfhi(v.w); }
DI u32x4 pack8(const float* f) { u32x4 w; w.x = pk2(f[0], f[1]); w.y = pk2(f[2], f[3]); w.z = pk2(f[4], f[5]); w.w = pk2(f[6], f[7]); return w; }
DI void st16_wt(void* ptr, const u32x4 v) { asm volatile("global_store_dwordx4 %0, %1, off sc0 sc1\n\ts_nop 2" :: "v"(ptr), "v"(v) : "memory"); }
DI int crow(int reg, int h) { return (reg & 3) + 8 * (reg >> 2) + 4 * h; }
DI int swap23(int p) { return (p & ~12) | ((p & 4) << 1) | ((p & 8) >> 1); }
DI bf16x8 pack_step(const f32x16& x, int s) {
    u32x4 p; p.x = pk2(x[8 * s], x[8 * s + 1]); p.y = pk2(x[8 * s + 2], x[8 * s + 3]); p.z = pk2(x[8 * s + 4], x[8 * s + 5]); p.w = pk2(x[8 * s + 6], x[8 * s + 7]);
    return __builtin_bit_cast(bf16x8, p);
}
DI float sigmoidf_(float x) { return __builtin_amdgcn_rcpf(1.0f + __expf(-x)); }
DI float siluf_(float x) { return x * __builtin_amdgcn_rcpf(1.0f + __expf(-x)); }

struct EpiProj {
    static constexpr bool PERM = true, AFTER_DRAIN = false;
    bf16_t* O; int ldc; const float* rs; int wt = 0;
    DI void operator()(const f32x4 (&acc)[2][2][4][2], const pg8::Unit& u, int wr, int wc, int fr, int fq) const {
        const int row0 = u.pm * 256 + wr * 64 + fr, col0 = u.pn * 256 + wc * 32 + 8 * fq;
        float rq[8];
#pragma unroll
        for (int g = 0; g < 8; ++g) rq[g] = rs ? rs[row0 + (g >> 2) * 128 + (g & 3) * 16] : 1.0f;
#pragma unroll
        for (int ai = 0; ai < 2; ++ai)
#pragma unroll
            for (int m = 0; m < 4; ++m) { const int row = row0 + ai * 128 + m * 16; const float r = rq[ai * 4 + m]; bf16_t* rowp = O + (size_t)row * ldc + col0;
#pragma unroll
                for (int bj = 0; bj < 2; ++bj) { const f32x4 v0 = acc[ai][bj][m][0] * r, v1 = acc[ai][bj][m][1] * r;
                    u32x4 w; w.x = pk2(v0[0], v0[1]); w.y = pk2(v0[2], v0[3]); w.z = pk2(v1[0], v1[1]); w.w = pk2(v1[2], v1[3]);
                    if (wt) st16_wt(rowp + bj * 128, w); else *(u32x4*)(rowp + bj * 128) = w; } }
    }
};
struct EpiUp {
    static constexpr bool PERM = true, AFTER_DRAIN = false;
    bf16_t* O; const float* ss; int wt = 0;
    DI void operator()(const f32x4 (&acc)[2][2][4][2], const pg8::Unit& u, int wr, int wc, int fr, int fq) const {
        const int row0 = u.pm * 256 + wr * 64 + fr, col0 = u.pn * 256 + wc * 32 + 8 * fq;
        float rq[8];
#pragma unroll
        for (int g = 0; g < 8; ++g) rq[g] = ss[row0 + (g >> 2) * 128 + (g & 3) * 16];
#pragma unroll
        for (int ai = 0; ai < 2; ++ai)
#pragma unroll
            for (int m = 0; m < 4; ++m) { const int row = row0 + ai * 128 + m * 16; const float r = rsqrtf(rq[ai * 4 + m] * (1.0f / 1024.0f) + EPS); bf16_t* rowp = O + (size_t)row * DFF + col0;
#pragma unroll
                for (int bj = 0; bj < 2; ++bj) { f32x4 v0 = acc[ai][bj][m][0] * r, v1 = acc[ai][bj][m][1] * r;
#pragma unroll
                    for (int j = 0; j < 4; ++j) { v0[j] = fmaxf(v0[j], 0.f); v0[j] *= v0[j]; v1[j] = fmaxf(v1[j], 0.f); v1[j] *= v1[j]; }
                    u32x4 w; w.x = pk2(v0[0], v0[1]); w.y = pk2(v0[2], v0[3]); w.z = pk2(v1[0], v1[1]); w.w = pk2(v1[2], v1[3]);
                    if (wt) st16_wt(rowp + bj * 128, w); else *(u32x4*)(rowp + bj * 128) = w; } }
    }
};
template <int MODE> struct EpiRes {
    static constexpr bool PERM = true, AFTER_DRAIN = false;
    const float* xp; const float* xs; bf16_t* XB; bf16_t* XO; float* ssn; const float* ssp; const bf16_t* PP; int wt = 0;
    DI void loadbase(int row, int col0, u32x4 (&b)[4]) const {
        const size_t off = (size_t)row * D + col0;
        if (MODE == 0) { const float* bp = (row < NTP ? xp + off : xs + (off - (size_t)NTP * D));
            b[0] = *(const u32x4*)bp; b[1] = *(const u32x4*)(bp + 4); b[2] = *(const u32x4*)(bp + 128); b[3] = *(const u32x4*)(bp + 132); }
        else { b[0] = *(const u32x4*)(XB + off); b[2] = *(const u32x4*)(XB + off + 128);
            if (MODE == 2) { b[1] = *(const u32x4*)(PP + off); b[3] = *(const u32x4*)(PP + off + 128); } else { b[1] = b[0]; b[3] = b[2]; } }
    }
    DI void operator()(const f32x4 (&acc)[2][2][4][2], const pg8::Unit& u, int wr, int wc, int fr, int fq) const {
        const int row0 = u.pm * 256 + wr * 64 + fr, col0 = u.pn * 256 + wc * 32 + 8 * fq;
        float rq[8];
        if (MODE == 2) {
#pragma unroll
            for (int g = 0; g < 8; ++g) rq[g] = ssp[row0 + (g >> 2) * 128 + (g & 3) * 16]; }
        u32x4 nb[4]; loadbase(row0, col0, nb);
#pragma unroll
        for (int g = 0; g < 8; ++g) { const int ai = g >> 2, m = g & 3; const int row = row0 + ai * 128 + m * 16; const size_t off = (size_t)row * D + col0;
            u32x4 cb[4];
#pragma unroll
            for (int q = 0; q < 4; ++q) cb[q] = nb[q];
            if (g < 7) loadbase(row0 + ((g + 1) >> 2) * 128 + ((g + 1) & 3) * 16, col0, nb);
            float r = 1.f; if (MODE == 2) r = rsqrtf(rq[g] * (1.0f / 1024.0f) + EPS);
            float sq = 0.f;
#pragma unroll
            for (int bj = 0; bj < 2; ++bj) { float v[8];
#pragma unroll
                for (int j = 0; j < 4; ++j) { v[j] = acc[ai][bj][m][0][j]; v[4 + j] = acc[ai][bj][m][1][j]; }
                if (MODE == 2) { float pf[8]; unpack8(cb[2 * bj + 1], pf);
#pragma unroll
                    for (int j = 0; j < 8; ++j) v[j] = sigmoidf_(v[j] * r) * pf[j]; }
                if (MODE == 0) { const f32x4 b0 = __builtin_bit_cast(f32x4, cb[2 * bj]), b1 = __builtin_bit_cast(f32x4, cb[2 * bj + 1]);
#pragma unroll
                    for (int j = 0; j < 4; ++j) { v[j] += b0[j]; v[4 + j] += b1[j]; } }
                else { float bf[8]; unpack8(cb[2 * bj], bf);
#pragma unroll
                    for (int j = 0; j < 8; ++j) v[j] += bf[j]; }
                if (wt) st16_wt((MODE == 2 ? XO : XB) + off + bj * 128, pack8(v)); else *(u32x4*)((MODE == 2 ? XO : XB) + off + bj * 128) = pack8(v);
#pragma unroll
                for (int j = 0; j < 8; ++j) sq += v[j] * v[j]; }
            sq += __shfl_xor(sq, 16); sq += __shfl_xor(sq, 32);
            if (fq == 0) atomicAdd(ssn + row, sq); }
    }
};
struct SubOrder {
    int pm0, nM, nN, G, c;
    DI bool next(int i, pg8::Unit& u) const { const int L = i * G + c; if (c < 0 || L >= nM * nN) return false; u.pm = pm0 + L % nM; u.pn = L / nM; return true; }
    DI void a_ready(const pg8::Unit&) const {}
    DI void done(const pg8::Unit&) const {}
};
constexpr size_t SLAB_OFF = 123000064;
constexpr size_t SLAB_FLOATS = (size_t)NTS * D;
struct EpiSplitK {
    static constexpr bool PERM = true, AFTER_DRAIN = true;
    float* SLAB; int kq; bf16_t* XB; float* ssn; unsigned* cnt;
    DI void fused(f32x4 (&acc)[2][2][4][2], const pg8::Unit& u, int wr, int wc, int fr, int fq, LAS unsigned char* lds, int wid, int lane) const {
        const int row0 = u.pm * 256 + wr * 64 + fr, col0 = u.pn * 256 + wc * 32 + 8 * fq;
        float* mine = SLAB + (size_t)kq * SLAB_FLOATS - (size_t)NTP * D;
#pragma unroll
        for (int ai = 0; ai < 2; ++ai)
#pragma unroll
            for (int m = 0; m < 4; ++m) { float* rowp = mine + (size_t)(row0 + ai * 128 + m * 16) * D + col0;
#pragma unroll
                for (int bj = 0; bj < 2; ++bj) { st16_wt(rowp + bj * 128, __builtin_bit_cast(u32x4, acc[ai][bj][m][0])); st16_wt(rowp + bj * 128 + 4, __builtin_bit_cast(u32x4, acc[ai][bj][m][1])); } }
        asm volatile("s_waitcnt vmcnt(0)" ::: "memory");
        __syncthreads();
        volatile LAS unsigned* flag = (volatile LAS unsigned*)lds;
        if (wid == 0 && lane == 0) { const unsigned t = __hip_atomic_fetch_add(cnt + ((u.pm - 64) * 4 + u.pn) * 32, 1u, __ATOMIC_RELAXED, __HIP_MEMORY_SCOPE_AGENT);
            __builtin_amdgcn_fence(__ATOMIC_ACQUIRE, "agent"); asm volatile("s_waitcnt vmcnt(0)" ::: "memory"); flag[0] = (t == 3u) ? 1u : 0u; }
        __syncthreads();
        if (flag[0] != 0u) {
#pragma unroll
            for (int ai = 0; ai < 2; ++ai)
#pragma unroll
                for (int m = 0; m < 4; ++m) { const int row = row0 + ai * 128 + m * 16; const size_t off = (size_t)row * D + col0; float sq = 0.f;
#pragma unroll
                    for (int bj = 0; bj < 2; ++bj) { float v[8]; unpack8(*(const u32x4*)(XB + off + bj * 128), v);
#pragma unroll
                        for (int q = 0; q < 4; ++q) { const float* sp = SLAB + (size_t)q * SLAB_FLOATS + (off - (size_t)NTP * D) + bj * 128; const f32x4 a0 = *(const f32x4*)sp, a1 = *(const f32x4*)(sp + 4);
#pragma unroll
                            for (int j = 0; j < 4; ++j) { v[j] += a0[j]; v[4 + j] += a1[j]; } }
                        st16_wt(XB + off + bj * 128, pack8(v));
#pragma unroll
                        for (int j = 0; j < 8; ++j) sq += v[j] * v[j]; }
                    sq += __shfl_xor(sq, 16); sq += __shfl_xor(sq, 32);
                    if (fq == 0) atomicAdd(ssn + row, sq); }
        }
    }
};
struct EpiFinal {
    static constexpr bool PERM = true, AFTER_DRAIN = true;
    const bf16_t* XB; const bf16_t* PP; const float* ssp; float* ssn; unsigned* cnt; const float* normf; float* Y;
    DI void fused(f32x4 (&acc)[2][2][4][2], const pg8::Unit& u, int wr, int wc, int fr, int fq, LAS unsigned char* lds, int wid, int lane) const {
        const int row0 = u.pm * 256 + wr * 64 + fr, col0 = u.pn * 256 + wc * 32 + 8 * fq;
        float rq[8];
#pragma unroll
        for (int g = 0; g < 8; ++g) rq[g] = ssp[row0 + (g >> 2) * 128 + (g & 3) * 16];
        u32x4 nb[4];
        { const size_t off = (size_t)row0 * D + col0; nb[0] = *(const u32x4*)(PP + off); nb[1] = *(const u32x4*)(XB + off); nb[2] = *(const u32x4*)(PP + off + 128); nb[3] = *(const u32x4*)(XB + off + 128); }
#pragma unroll
        for (int g = 0; g < 8; ++g) { const int ai = g >> 2, m = g & 3; const int row = row0 + ai * 128 + m * 16;
            u32x4 cb[4];
#pragma unroll
            for (int q = 0; q < 4; ++q) cb[q] = nb[q];
            if (g < 7) { const size_t off = (size_t)(row0 + ((g + 1) >> 2) * 128 + ((g + 1) & 3) * 16) * D + col0;
                nb[0] = *(const u32x4*)(PP + off); nb[1] = *(const u32x4*)(XB + off); nb[2] = *(const u32x4*)(PP + off + 128); nb[3] = *(const u32x4*)(XB + off + 128); }
            const float r = rsqrtf(rq[g] * (1.0f / 1024.0f) + EPS); float sq = 0.f;
#pragma unroll
            for (int bj = 0; bj < 2; ++bj) { float pf[8], bf[8]; unpack8(cb[2 * bj], pf); unpack8(cb[2 * bj + 1], bf);
#pragma unroll
                for (int j = 0; j < 4; ++j) { const float a = sigmoidf_(acc[ai][bj][m][0][j] * r) * pf[j] + bf[j], b = sigmoidf_(acc[ai][bj][m][1][j] * r) * pf[4 + j] + bf[4 + j];
                    acc[ai][bj][m][0][j] = a; acc[ai][bj][m][1][j] = b; sq += a * a + b * b; } }
            sq += __shfl_xor(sq, 16); sq += __shfl_xor(sq, 32);
            if (fq == 0) atomicAdd(ssn + row, sq); }
        asm volatile("s_waitcnt vmcnt(0)" ::: "memory");
        __syncthreads();
        if (mk_tid() == 0) { unsigned* cw = cnt + u.pm * 32; (void)__hip_atomic_fetch_add(cw, 1u, __ATOMIC_RELAXED, __HIP_MEMORY_SCOPE_AGENT);
            unsigned sp = 0u; while (__hip_atomic_load(cw, __ATOMIC_RELAXED, __HIP_MEMORY_SCOPE_AGENT) < 4u) { __builtin_amdgcn_s_sleep(1); if (++sp > (1u << 22)) break; }
            __builtin_amdgcn_fence(__ATOMIC_ACQUIRE, "agent"); asm volatile("s_waitcnt vmcnt(0)" ::: "memory"); }
        __syncthreads();
#pragma unroll
        for (int ai = 0; ai < 2; ++ai)
#pragma unroll
            for (int m = 0; m < 4; ++m) { const int row = row0 + ai * 128 + m * 16; const size_t off = (size_t)row * D + col0;
                const float rs = rsqrtf(__hip_atomic_load(ssn + row, __ATOMIC_RELAXED, __HIP_MEMORY_SCOPE_AGENT) * (1.0f / 1024.0f) + EPS);
#pragma unroll
                for (int bj = 0; bj < 2; ++bj) { const f32x4 w0 = *(const f32x4*)(normf + col0 + bj * 128), w1 = *(const f32x4*)(normf + col0 + bj * 128 + 4);
                    *(f32x4*)(Y + off + bj * 128) = acc[ai][bj][m][0] * rs * w0; *(f32x4*)(Y + off + bj * 128 + 4) = acc[ai][bj][m][1] * rs * w1; } }
    }
};
#define XB_TMO      128
#define XB_XCNT(j)  (256  + 64 * (j))
#define XB_XSUB(j)  (1280 + 64 * (j))
#define XB_XGEN(j)  (2304 + 64 * (j))
#define XB_TOP      3328
#define XB_TOPGEN   3392
#define XCD_BAR_WORDS 3456
#define XB_SPIN_CAP (1u << 18)

__device__ __forceinline__ unsigned xb_ld(unsigned* p)              { return __hip_atomic_load(p, __ATOMIC_RELAXED, __HIP_MEMORY_SCOPE_AGENT); }
__device__ __forceinline__ unsigned xb_add(unsigned* p, unsigned v) { return __hip_atomic_fetch_add(p, v, __ATOMIC_RELAXED, __HIP_MEMORY_SCOPE_AGENT); }
__device__ __forceinline__ unsigned xb_xcc_id() { return (unsigned)__builtin_amdgcn_s_getreg((3 << 11) | 20) & 0xFu; }
#define XB_SPIN(cond, bar) do { unsigned _sp = 0; while (cond) { __builtin_amdgcn_s_sleep(1); \
    if ((++_sp & 255u) == 0u) { if (xb_ld(&(bar)[XB_TMO])) break; if (_sp > XB_SPIN_CAP) { atomicAdd(&(bar)[XB_TMO], 1u); break; } } } } while (0)

struct XcdBarrier {
    unsigned* bar; unsigned x;
    volatile LAS unsigned* st;
};

__device__ __forceinline__ XcdBarrier xcd_barrier_post(unsigned* bar, volatile LAS unsigned* st) {
    XcdBarrier b; b.bar = bar; b.x = xb_xcc_id(); b.st = st;
    if (mk_tid() == 0) (void)xb_add(&bar[XB_XCNT(b.x)], 1u);
    return b;
}
__device__ __forceinline__ void xcd_barrier_complete(unsigned* bar, unsigned x, unsigned& nloc, unsigned& nx) {
    const unsigned G = gridDim.x * gridDim.y * gridDim.z;
    unsigned sum, cnt, mine, sp = 0u;
    for (;;) {
        sum = 0u; cnt = 0u; mine = 0u;
#pragma unroll
        for (unsigned j = 0; j < 16; ++j) { const unsigned c = xb_ld(&bar[XB_XCNT(j)]); sum += c; cnt += (c > 0u) ? 1u : 0u; mine = (j == x) ? c : mine; }
        if (sum == G) break;
        __builtin_amdgcn_s_sleep(1);
        if ((++sp & 255u) == 0u) { if (xb_ld(&bar[XB_TMO])) break; if (sp > XB_SPIN_CAP) { atomicAdd(&bar[XB_TMO], 1u); break; } }
    }
    nloc = mine > 0u ? mine : 1u; nx = cnt > 0u ? cnt : 1u;
}

__device__ __forceinline__ void xcd_barrier(const XcdBarrier& b) {
    asm volatile("s_waitcnt vmcnt(0)" ::: "memory");
    __syncthreads();
    if (mk_tid() == 0) {
        unsigned* bar = b.bar;
        __builtin_amdgcn_s_waitcnt(0);
        unsigned nloc = b.st[0], nx = b.st[1];
        if (nloc == 0u) { xcd_barrier_complete(bar, b.x, nloc, nx); b.st[0] = nloc; b.st[1] = nx; }
        const unsigned old = xb_add(&bar[XB_XSUB(b.x)], 1u);
        const unsigned gen = old / nloc;
        if (old + 1u == (gen + 1u) * nloc) {
            __builtin_amdgcn_fence(__ATOMIC_RELEASE, "agent");
            asm volatile("s_waitcnt vmcnt(0)" ::: "memory");
            const unsigned og = xb_add(&bar[XB_TOP], 1u);
            const unsigned tg = og / nx;
            if (og + 1u == (tg + 1u) * nx) xb_add(&bar[XB_TOPGEN], 1u);
            else XB_SPIN(xb_ld(&bar[XB_TOPGEN]) == tg, bar);
            __builtin_amdgcn_fence(__ATOMIC_ACQUIRE, "agent");
            xb_add(&bar[XB_XGEN(b.x)], 1u);
            asm volatile("s_waitcnt vmcnt(0)" ::: "memory");
        } else {
            XB_SPIN(xb_ld(&bar[XB_XGEN(b.x)]) == gen, bar);
            __builtin_amdgcn_fence(__ATOMIC_ACQUIRE, "agent");
            asm volatile("s_waitcnt vmcnt(0)" ::: "memory");
        }
    }
    __syncthreads();
}
struct TileDesc { const float* W; const float* nrm; bf16_t* Wt; int ldw, K, k0, n0src, n0dst; };
DI TileDesc p0_tile(const Ctx& c, unsigned char* ws, int t) {
    TileDesc d;
    if (t < 896) { const int kt = t / 56, nt = t % 56, n0 = nt * 64; d = TileDesc{c.w_in, c.norm_mix, (bf16_t*)(ws + WS_WIN), INDIM, D, kt * 64, n0 < 1536 ? n0 : n0 + 8, n0}; return d; }
    t -= 896;
    if (t < 256) { d = TileDesc{c.w_out, nullptr, (bf16_t*)(ws + WS_WOUT), D, D, (t / 16) * 64, (t % 16) * 64, (t % 16) * 64}; return d; }
    t -= 256;
    if (t < 1024) { d = TileDesc{c.w_up, c.norm_mlp, (bf16_t*)(ws + WS_WUP), DFF, D, (t / 64) * 64, (t % 64) * 64, (t % 64) * 64}; return d; }
    t -= 1024;
    if (t < 1024) { d = TileDesc{c.w_down, nullptr, (bf16_t*)(ws + WS_WDN), D, DFF, (t / 16) * 64, (t % 16) * 64, (t % 16) * 64}; return d; }
    t -= 1024;
    if (t < 256) { d = TileDesc{c.w_ple_gate, c.norm_ple, (bf16_t*)(ws + WS_WG), D, D, (t / 16) * 64, (t % 16) * 64, (t % 16) * 64}; return d; }
    t -= 256;
    d = TileDesc{c.w_ple_proj, nullptr, (bf16_t*)(ws + WS_WP), D, PLE, (t / 16) * 64, (t % 16) * 64, (t % 16) * 64}; return d;
}
DI void tile_load(const TileDesc& d, float (&v)[8]) {
    const int tid = mk_tid();
#pragma unroll
    for (int i = 0; i < 8; ++i) { const int kk = i * 8 + (tid >> 6), nn = tid & 63; float x = d.W[(size_t)(d.k0 + kk) * d.ldw + d.n0src + nn]; if (d.nrm) x *= d.nrm[d.k0 + kk]; v[i] = x; }
}
DI void tile_store(const TileDesc& d, const float (&v)[8], LAS float* tile) {
    const int tid = mk_tid();
#pragma unroll
    for (int i = 0; i < 8; ++i) { const int kk = i * 8 + (tid >> 6), nn = tid & 63; tile[kk * 65 + nn] = v[i]; }
    __syncthreads();
    { const int nn = tid >> 3, kq = tid & 7; float f[8];
#pragma unroll
      for (int e = 0; e < 8; ++e) f[e] = tile[(kq * 8 + e) * 65 + nn];
      *(u32x4*)(d.Wt + (size_t)(d.n0dst + nn) * d.K + d.k0 + kq * 8) = pack8(f); }
    __syncthreads();
}
DI void p0_phase(const Ctx& c, LAS unsigned char* lds) {
    const int tid = mk_tid(), lane = tid & 63, wid = tid >> 6;
    unsigned char* ws = c.ws;
    float* ctl = (float*)(ws + WS_CTL);
    bf16_t* XB = (bf16_t*)(ws + WS_A); bf16_t* PB = (bf16_t*)(ws + WS_PB);
    LAS float* wab = (LAS float*)lds;
    for (int i = tid; i < 1024 * 8; i += NTHREADS) { const int k = i >> 3, j = i & 7; wab[i] = c.w_in[(size_t)k * INDIM + 1536 + j] * c.norm_mix[k]; }
    __syncthreads();
    float xn[16];
    { const int row = blockIdx.x * 8 + wid; if (row < NT) { const float* xr = row < NTP ? c.x_prompt + (size_t)row * D : c.x_sample + (size_t)(row - NTP) * D;
#pragma unroll
        for (int i = 0; i < 16; ++i) xn[i] = xr[i * 64 + lane]; } }
    for (int row = blockIdx.x * 8 + wid; row < NT; row += gridDim.x * 8) {
        const float* xr = row < NTP ? c.x_prompt + (size_t)row * D : c.x_sample + (size_t)(row - NTP) * D;
        const float* pr = row < NTP ? c.p_prompt + (size_t)row * PLE : c.p_sample + (size_t)(row - NTP) * PLE;
        float xc[16];
#pragma unroll
        for (int i = 0; i < 16; ++i) xc[i] = xn[i];
        { const int rown = row + gridDim.x * 8; if (rown < NT) { const float* xq = rown < NTP ? c.x_prompt + (size_t)rown * D : c.x_sample + (size_t)(rown - NTP) * D;
#pragma unroll
            for (int i = 0; i < 16; ++i) xn[i] = xq[i * 64 + lane]; } }
        float ss = 0.f, dot[8];
#pragma unroll
        for (int j = 0; j < 8; ++j) dot[j] = 0.f;
#pragma unroll
        for (int i = 0; i < 16; ++i) { const int k = i * 64 + lane; const float xv = xc[i]; ss += xv * xv;
            const f32x4 w0 = *(const LAS f32x4*)(wab + k * 8), w1 = *(const LAS f32x4*)(wab + k * 8 + 4);
            dot[0] += xv * w0[0]; dot[1] += xv * w0[1]; dot[2] += xv * w0[2]; dot[3] += xv * w0[3]; dot[4] += xv * w1[0]; dot[5] += xv * w1[1]; dot[6] += xv * w1[2]; dot[7] += xv * w1[3]; }
#pragma unroll
        for (int o = 32; o >= 1; o >>= 1) { ss += __shfl_xor(ss, o);
#pragma unroll
            for (int j = 0; j < 8; ++j) dot[j] += __shfl_xor(dot[j], o); }
        const float rs = rsqrtf(ss * (1.0f / 1024.0f) + EPS);
#pragma unroll
        for (int i = 0; i < 4; ++i) { const int k0 = i * 256 + lane * 4; const f32x4 v = *(const f32x4*)(xr + k0); u32x2 w; w.x = pk2(v[0], v[1]); w.y = pk2(v[2], v[3]); *(u32x2*)(XB + (size_t)row * D + k0) = w; }
        { const f32x4 v = *(const f32x4*)(pr + lane * 4); u32x2 w; w.x = pk2(v[0], v[1]); w.y = pk2(v[2], v[3]); *(u32x2*)(PB + (size_t)row * PLE + lane * 4) = w; }
        if (lane == 0) { ctl[CTL_RS0 + row] = rs; ctl[CTL_SS1 + row] = 0.f; ctl[CTL_SS2 + row] = 0.f; ctl[CTL_SS3 + row] = 0.f; }
        if (lane < 4) { const float da = lane == 0 ? dot[0] : lane == 1 ? dot[1] : lane == 2 ? dot[2] : dot[3]; const float db = lane == 0 ? dot[4] : lane == 1 ? dot[5] : lane == 2 ? dot[6] : dot[7];
            const float xa = da * rs + c.dt_bias[lane]; const float sp = xa > 20.f ? xa : log1pf(__expf(xa));
            ctl[CTL_LA + (size_t)row * 4 + lane] = -__expf(c.a_log[lane]) * sp; ctl[CTL_BETA + (size_t)row * 4 + lane] = sigmoidf_(db * rs); }
    }
    __syncthreads();
    LAS float* tile = (LAS float*)lds;
    {
        int tl = blockIdx.x; float va[8], vb[8];
        if (tl < 3520) { TileDesc d = p0_tile(c, ws, tl); tile_load(d, va);
            for (;;) {
                const int tn = tl + gridDim.x; TileDesc dn = d;
                if (tn < 3520) { dn = p0_tile(c, ws, tn); tile_load(dn, vb); }
                tile_store(d, va, tile);
                if (tn >= 3520) break;
#pragma unroll
                for (int i = 0; i < 8; ++i) va[i] = vb[i];
                d = dn; tl = tn;
            } }
    }
}

constexpr int L_QH = 0, L_KH = 17408, L_RT = 34816, L_AM = 71680, L_TB = 89088, L_G = 98304, L_WC = 98816, L_SSP = 104960;
DI void prep_chunk(const Ctx& c, LAS unsigned char* lds, int ch) {
    int tid = mk_tid(); asm volatile("" : "+v"(tid));
    const int lane = tid & 63, wid = __builtin_amdgcn_readfirstlane(tid >> 6);
    const int h = ch & 3, n = (ch >> 2) & 31, b = ch >> 7;
    const int row0 = b * 2048 + n * 64;
    float* ctl = (float*)(c.ws + WS_CTL);
    const bf16_t* PROJ = (const bf16_t*)(c.ws + WS_B);
    bf16_t* QP = (bf16_t*)c.out + (size_t)ch * 8192; bf16_t* WP = (bf16_t*)c.out + (size_t)(1024 + ch) * 8192; bf16_t* KTP = (bf16_t*)c.out + (size_t)(2048 + ch) * 8192;
    bf16_t* UT = (bf16_t*)(c.ws + WS_C) + (size_t)ch * 8192; bf16_t* QKP = (bf16_t*)(c.ws + WS_C) + (size_t)1024 * 8192 + (size_t)ch * 4096;
    LAS float* G = (LAS float*)(lds + L_G); LAS float* BT = G + 64;
    LAS float* WC = (LAS float*)(lds + L_WC);
    LAS float* SSP = (LAS float*)(lds + L_SSP);
    for (int i = tid; i < 1536; i += NTHREADS) { const int ten = i >> 9, jj = (i >> 7) & 3, cc = i & 127; WC[i] = c.w_conv_qkv[jj * 1536 + ten * 512 + h * 128 + cc]; }
    if (wid == 0) {
        float la = ctl[CTL_LA + (size_t)(row0 + lane) * 4 + h];
#pragma unroll
        for (int o = 1; o < 64; o <<= 1) { const float t = __int_as_float(__builtin_amdgcn_ds_bpermute(((lane - o) & 63) * 4, __float_as_int(la))); if (lane >= o) la += t; }
        G[lane] = la; BT[lane] = ctl[CTL_BETA + (size_t)(row0 + lane) * 4 + h];
        if (lane == 63) __hip_atomic_store(ctl + CTL_GL + ch, la, __ATOMIC_RELAXED, __HIP_MEMORY_SCOPE_AGENT);
    }
    {
        const int tok = lane, cg8 = wid;
        const int t_abs = n * 64 + tok;
        u32x4 xr[3][4][2];
#pragma unroll
        for (int ten = 0; ten < 3; ++ten)
#pragma unroll
            for (int j = 0; j < 4; ++j) { const int tt = t_abs - 3 + j;
                if (tt >= 0) { const bf16_t* src = PROJ + (size_t)(b * 2048 + tt) * NPROJ + ten * 512 + h * 128 + cg8 * 16; xr[ten][j][0] = *(const u32x4*)src; xr[ten][j][1] = *(const u32x4*)(src + 8); }
                else { xr[ten][j][0] = (u32x4){0u, 0u, 0u, 0u}; xr[ten][j][1] = (u32x4){0u, 0u, 0u, 0u}; } }
        __syncthreads();
        const float g = G[tok], bt = BT[tok];
        const float eg = __expf(g);
        float a[3][16];
#pragma unroll
        for (int ten = 0; ten < 3; ++ten) {
#pragma unroll
            for (int e = 0; e < 16; ++e) a[ten][e] = 0.f;
#pragma unroll
            for (int j = 0; j < 4; ++j) { float x[16]; unpack8(xr[ten][j][0], x); unpack8(xr[ten][j][1], x + 8);
                const LAS float* wj = WC + (ten * 4 + j) * 128 + cg8 * 16;
#pragma unroll
                for (int q = 0; q < 4; ++q) { const f32x4 w = *(const LAS f32x4*)(wj + 4 * q); a[ten][4 * q] += x[4 * q] * w[0]; a[ten][4 * q + 1] += x[4 * q + 1] * w[1]; a[ten][4 * q + 2] += x[4 * q + 2] * w[2]; a[ten][4 * q + 3] += x[4 * q + 3] * w[3]; } }
#pragma unroll
            for (int e = 0; e < 16; ++e) a[ten][e] = siluf_(a[ten][e]);
        }
        { float sq = 0.f, sk = 0.f;
#pragma unroll
          for (int e = 0; e < 16; ++e) { sq += a[0][e] * a[0][e]; sk += a[1][e] * a[1][e]; }
          SSP[cg8 * 64 + tok] = sq; SSP[512 + cg8 * 64 + tok] = sk; }
        __syncthreads();
        { float sq = 0.f, sk = 0.f;
#pragma unroll
          for (int w = 0; w < 8; ++w) { sq += SSP[w * 64 + tok]; sk += SSP[512 + w * 64 + tok]; }
          const float scq = rsqrtf(sq + EPS) * 0.08838834764831845f, sck = rsqrtf(sk + EPS);
#pragma unroll
          for (int e = 0; e < 16; ++e) { a[0][e] *= scq; a[1][e] *= sck; } }
        {
            LAS unsigned char* q = lds + L_QH + tok * 272 + cg8 * 32;
            *(LAS u32x4*)q = pack8(a[0]); *(LAS u32x4*)(q + 16) = pack8(a[0] + 8);
            float p[16];
#pragma unroll
            for (int e = 0; e < 16; ++e) p[swap23(e)] = a[0][e] * eg;
            bf16_t* dst = QP + tok * 128 + cg8 * 16; st16_wt(dst, pack8(p)); st16_wt(dst + 8, pack8(p + 8));
        }
        {
            LAS unsigned char* q = lds + L_KH + tok * 272 + cg8 * 32;
            *(LAS u32x4*)q = pack8(a[1]); *(LAS u32x4*)(q + 16) = pack8(a[1] + 8);
            const float f = bt * eg;
#pragma unroll
            for (int e = 0; e < 16; ++e) *(LAS bf16_t*)(lds + L_RT + (128 + cg8 * 16 + e) * 144 + tok * 2) = f2bf(a[1][e] * f);
        }
#pragma unroll
        for (int e = 0; e < 16; ++e) *(LAS bf16_t*)(lds + L_RT + (cg8 * 16 + e) * 144 + tok * 2) = f2bf(a[2][e] * bt);
    }
    __syncthreads();
    {
        int r = lane & 31, hh = lane >> 5; asm volatile("" : "+v"(r), "+v"(hh));
        const int blk = wid & 3, I = (blk == 1 || blk == 2) ? 1 : 0, J = (blk == 2 || blk == 3) ? 1 : 0; const bool isq = wid >= 4;
        f32x16 x;
#pragma unroll
        for (int i = 0; i < 16; ++i) x[i] = 0.f;
        if (blk != 3) {
            LAS unsigned char* Ab = lds + (isq ? L_QH : L_KH) + (32 * I + r) * 272 + hh * 16; LAS unsigned char* Bb = lds + L_KH + (32 * J + r) * 272 + hh * 16;
#pragma unroll
            for (int s = 0; s < 8; ++s) { const bf16x8 av = *(LAS bf16x8*)(Ab + s * 32), bv = *(LAS bf16x8*)(Bb + s * 32); x = isq ? MFMA32(bv, av, x) : MFMA32(av, bv, x); }
        }
        if (!isq) {
            const int jj = 32 * J + r; const float gj = G[jj];
            if (blk != 3) {
#pragma unroll
                for (int i = 0; i < 16; ++i) { const int ii = 32 * I + crow(i, hh); const float d = __expf(fminf(G[ii] - gj, 0.f)); ((LAS float*)(lds + L_AM))[ii * 68 + jj] = (ii > jj) ? BT[ii] * x[i] * d : 0.f; } }
        } else {
            const int ii = 32 * I + r; const float gi = G[ii]; float f[16];
#pragma unroll
            for (int i = 0; i < 16; ++i) { const int jj = 32 * J + crow(i, hh); const float d = __expf(fminf(gi - G[jj], 0.f)); f[i] = (ii >= jj && blk != 3) ? x[i] * d : 0.f; }
            bf16_t* dst = QKP + ii * 64 + 32 * J; st16_wt(dst + 8 * hh, pack8(f)); st16_wt(dst + 16 + 8 * hh, pack8(f + 8));
        }
    }
    {
        const int dk = tid & 127, tq = tid >> 7; const float glast = G[63]; float f[16];
#pragma unroll
        for (int t = 0; t < 16; ++t) { const int tk = 16 * tq + t; f[swap23(t)] = bf2f(*(LAS bf16_t*)(lds + L_KH + tk * 272 + dk * 2)) * __expf(glast - G[tk]); }
        bf16_t* dst = KTP + dk * 64 + 16 * tq; st16_wt(dst, pack8(f)); st16_wt(dst + 8, pack8(f + 8));
    }
    __syncthreads();
#ifndef NOINV
    if (wid == 0) {
        f32x2v t2[32]; f32x4 ab[2][16]; float lanef = (float)lane; asm volatile("" : "+v"(lanef));
        int zoff; asm volatile("v_mov_b32 %0, 0" : "=v"(zoff));
        LAS float* AM = (LAS float*)(lds + L_AM) + zoff;
        t2[0].x = fmaxf(1.0f - fabsf(lanef), 0.f); t2[0].y = 0.f;
        ab[1][0] = *(LAS f32x4*)(AM + 68);
#pragma unroll
        for (int i = 1; i < 64; ++i) {
            if (i + 1 < 64) {
#pragma unroll
                for (int q = 0; q < (i + 4) / 4; ++q) ab[(i + 1) & 1][q] = *(LAS f32x4*)(AM + (i + 1) * 68 + 4 * q); }
            __builtin_amdgcn_sched_barrier(0);
            f32x2v acc2 = {fmaxf(1.0f - fabsf(lanef - (float)i), 0.f), 0.f};
#pragma unroll
            for (int q = 0; q < (i + 3) / 4; ++q) { const f32x4 av = ab[i & 1][q]; const int j = 4 * q;
                if (j + 1 < i) acc2 -= (f32x2v){av[0], av[1]} * t2[j / 2]; else acc2.x -= av[0] * t2[j / 2].x;
                if (j + 3 < i) acc2 -= (f32x2v){av[2], av[3]} * t2[j / 2 + 1]; else if (j + 2 < i) acc2.x -= av[2] * t2[j / 2 + 1].x; }
            const float ti = acc2.x + acc2.y;
            if (i & 1) t2[i / 2].y = ti; else { t2[i / 2].x = ti; t2[i / 2].y = 0.f; }
            __builtin_amdgcn_sched_barrier(0);
        }
#pragma unroll
        for (int i = 0; i < 32; ++i) { *(LAS bf16_t*)(lds + L_TB + (2 * i) * 144 + lane * 2) = f2bf(t2[i].x); *(LAS bf16_t*)(lds + L_TB + (2 * i + 1) * 144 + lane * 2) = f2bf(t2[i].y); }
    }
#endif
    __syncthreads();
    {
        int r = lane & 31, hh = lane >> 5; asm volatile("" : "+v"(r), "+v"(hh));
#pragma unroll
        for (int tb = 0; tb < 2; ++tb) {
            f32x16 x;
#pragma unroll
            for (int i = 0; i < 16; ++i) x[i] = 0.f;
#pragma unroll
            for (int s = 0; s < 4; ++s) if (s < 2 || tb == 1) {
                const bf16x8 tf = *(LAS bf16x8*)(lds + L_TB + (32 * tb + r) * 144 + (16 * s + 8 * hh) * 2), rf = *(LAS bf16x8*)(lds + L_RT + (32 * wid + r) * 144 + (16 * s + 8 * hh) * 2);
                x = (wid < 4) ? MFMA32(tf, rf, x) : MFMA32(rf, tf, x); }
            float f[16];
#pragma unroll
            for (int i = 0; i < 16; ++i) f[i] = x[i];
            bf16_t* dst = (wid < 4) ? UT + (32 * wid + r) * 64 + 32 * tb : WP + (32 * tb + r) * 128 + 32 * (wid - 4);
            st16_wt(dst + 8 * hh, pack8(f)); st16_wt(dst + 16 + 8 * hh, pack8(f + 8));
        }
    }
    asm volatile("s_waitcnt vmcnt(0)" ::: "memory");
    __syncthreads();
    if (tid == 0) __hip_atomic_store((unsigned*)(c.ws + WS_FLAGS) + ch, 1u, __ATOMIC_RELAXED, __HIP_MEMORY_SCOPE_AGENT);
}

DI void sample_gdn2(const Ctx& c, LAS unsigned char* lds, int pair) {
    const int tid = mk_tid(), lane = tid & 63, half = tid >> 8, ht = tid & 255, hw = (tid >> 6) & 3;
    const int item = pair * 2 + half, b = item >> 2, h = item & 3;
    float* ctl = (float*)(c.ws + WS_CTL);
    const bf16_t* PROJ = (const bf16_t*)(c.ws + WS_B); bf16_t* OY = (bf16_t*)(c.ws + WS_A);
    LAS float* vals = (LAS float*)lds + half * 3072;
    LAS float* red = vals + 1536;
    LAS float* red2 = red + 256;
    LAS float* os = red2 + 256;
    const int row0 = NTP + b * 4;
    for (int i = ht; i < 1536; i += 256) { const int ten = i >> 9, tok = (i >> 7) & 3, ch = i & 127; const int col = ten * 512 + h * 128 + ch; float a = 0.f;
#pragma unroll
        for (int j = 0; j < 4; ++j) { const int idx = tok + j; const float xv = idx < 3 ? c.state_gdn_conv[((size_t)b * 3 + idx) * 1536 + col] : bf2f(PROJ[(size_t)(row0 + idx - 3) * NPROJ + col]); a += xv * c.w_conv_qkv[j * 1536 + col]; }
        vals[i] = siluf_(a); }
    __syncthreads();
#pragma unroll
    for (int rep = 0; rep < 2; ++rep) { const int pr = hw * 2 + rep, ten = pr >> 2, tok = pr & 3; LAS float* v = vals + ten * 512 + tok * 128; const float a0 = v[lane], a1 = v[lane + 64]; float ss = a0 * a0 + a1 * a1;
#pragma unroll
        for (int o = 32; o >= 1; o >>= 1) ss += __shfl_xor(ss, o);
        const float sc = rsqrtf(ss + EPS) * (ten == 0 ? 0.08838834764831845f : 1.0f); v[lane] = a0 * sc; v[lane + 64] = a1 * sc; }
    __syncthreads();
    const int e = ht & 127, part = ht >> 7;
    float s[64];
    const float* S0 = c.state_gdn + ((size_t)item * 128 + part * 64) * 128 + e;
#pragma unroll
    for (int i = 0; i < 64; ++i) s[i] = S0[(size_t)i * 128];
#pragma unroll 1
    for (int t = 0; t < 4; ++t) {
        const float a = __expf(ctl[CTL_LA + (size_t)(row0 + t) * 4 + h]), bt = ctl[CTL_BETA + (size_t)(row0 + t) * 4 + h];
        LAS float* qv = vals + t * 128 + part * 64; LAS float* kv = vals + 512 + t * 128 + part * 64;
        float p = 0.f;
#pragma unroll
        for (int i = 0; i < 64; ++i) { s[i] *= a; p += s[i] * kv[i]; }
        red[part * 128 + e] = p;
        __syncthreads();
        const float rr = bt * (vals[1024 + t * 128 + e] - (red[e] + red[128 + e]));
        float po = 0.f;
#pragma unroll
        for (int i = 0; i < 64; ++i) { s[i] += kv[i] * rr; po += s[i] * qv[i]; }
        red2[part * 128 + e] = po;
        __syncthreads();
        if (part == 0) os[t * 128 + e] = red2[e] + red2[128 + e];
    }
    float* Sout = c.out + OFF_GS + ((size_t)item * 128 + part * 64) * 128 + e;
#pragma unroll
    for (int i = 0; i < 64; ++i) Sout[(size_t)i * 128] = s[i];
    __syncthreads();
#pragma unroll
    for (int rep = 0; rep < 2; ++rep) { const int tok = part * 2 + rep; float ss = 0.f;
        for (int i = 0; i < 128; ++i) { const float v = os[tok * 128 + i]; ss += v * v; }
        const float rs = rsqrtf(ss * (1.0f / 128.0f) + EPS); const int row = row0 + tok;
        const float z = bf2f(PROJ[(size_t)row * NPROJ + 1536 + h * 128 + e]);
        OY[(size_t)row * D + h * 128 + e] = f2bf(os[tok * 128 + e] * rs * c.w_gdn_norm[e] * siluf_(z)); }
    __syncthreads();
}

DI void shortconv_items(const Ctx& c, int item_lo, int item_hi, int bfirst, int bcount) {
    const int tid = mk_tid();
    const bf16_t* PROJ = (const bf16_t*)(c.ws + WS_B); bf16_t* OY = (bf16_t*)(c.ws + WS_A);
    for (int item = item_lo + bfirst * NTHREADS + tid; item < item_hi; item += bcount * NTHREADS) {
        const int row = item >> 6, c8 = (item & 63) * 8;
        const bool prm = row < NTP; const int sb = prm ? (row >> 11) : ((row - NTP) >> 2); const int t = prm ? (row & 2047) : ((row - NTP) & 3); const int T = prm ? 2048 : 4;
        float bv[8]; unpack8(*(const u32x4*)(PROJ + (size_t)row * NPROJ + 2048 + c8), bv);
        float acc[8], cur[8];
#pragma unroll
        for (int e = 0; e < 8; ++e) { acc[e] = 0.f; cur[e] = 0.f; }
#pragma unroll
        for (int d = 0; d < 3; ++d) { const int tt = t - 2 + d; float sc[8];
            if (tt >= 0) { float cv[8], hv[8]; const bf16_t* src = PROJ + (size_t)(row - (2 - d)) * NPROJ + c8; unpack8(*(const u32x4*)(src + 2560), cv); unpack8(*(const u32x4*)(src + 3072), hv);
#pragma unroll
                for (int e = 0; e < 8; ++e) sc[e] = cv[e] * hv[e]; }
            else if (!prm) { const float* sp = c.state_sc_conv + ((size_t)sb * 2 + (2 + tt)) * 512 + c8; const f32x4 s0 = *(const f32x4*)sp, s1 = *(const f32x4*)(sp + 4);
#pragma unroll
                for (int e = 0; e < 4; ++e) { sc[e] = s0[e]; sc[4 + e] = s1[e]; } }
            else {
#pragma unroll
                for (int e = 0; e < 8; ++e) sc[e] = 0.f; }
            const float* wp = c.w_conv_sc + d * 512 + c8; const f32x4 w0 = *(const f32x4*)wp, w1 = *(const f32x4*)(wp + 4);
#pragma unroll
            for (int e = 0; e < 4; ++e) { acc[e] += sc[e] * w0[e]; acc[4 + e] += sc[4 + e] * w1[e]; }
            if (d == 2) {
#pragma unroll
                for (int e = 0; e < 8; ++e) cur[e] = sc[e]; } }
#pragma unroll
        for (int e = 0; e < 8; ++e) acc[e] *= bv[e];
        *(u32x4*)(OY + (size_t)row * D + 512 + c8) = pack8(acc);
        if (t >= T - 2) { float* dst = (prm ? c.out + OFF_SCP : c.out + OFF_SCS) + ((size_t)sb * 2 + (t - (T - 2))) * 512 + c8;
            *(f32x4*)dst = (f32x4){cur[0], cur[1], cur[2], cur[3]}; *(f32x4*)(dst + 4) = (f32x4){cur[4], cur[5], cur[6], cur[7]}; }
    }
}
DI void conv_state_copies(const Ctx& c, int bfirst, int bcount) {
    const int tid = mk_tid();
    const bf16_t* PROJ = (const bf16_t*)(c.ws + WS_B);
    for (int idx = bfirst * NTHREADS + tid; idx < 136 * 4608; idx += bcount * NTHREADS) {
        const int seq = idx / 4608, rem = idx % 4608, j = rem / 1536, col = rem % 1536;
        if (seq < 8) c.out[OFF_GCP + idx] = bf2f(PROJ[(size_t)(seq * 2048 + 2045 + j) * NPROJ + col]);
        else c.out[OFF_GCS + (idx - 8 * 4608)] = bf2f(PROJ[(size_t)(NTP + (seq - 8) * 4 + 1 + j) * NPROJ + col]);
    }
}

constexpr int P3_BUF = 57344, P3_OB = 114688, L_XST = 148480, P3_WN = 148496;
DI void scan_seq(const Ctx& c, LAS unsigned char* lds, int bh) {
    const int tid = mk_tid(), lane = tid & 63, wid = tid >> 6, r = lane & 31, hh = lane >> 5;
    const int b = bh >> 2, h = bh & 3;
    const bool loader = wid >= 4; const int lt = tid & 255;
    const float* ctl = (const float*)(c.ws + WS_CTL);
    const bf16_t* PROJ = (const bf16_t*)(c.ws + WS_B); bf16_t* OY = (bf16_t*)(c.ws + WS_A);
    LAS float* OB = (LAS float*)(lds + P3_OB);
    const int ch0 = b * 128 + h;
    const u32x4* gQ = (const u32x4*)((const bf16_t*)c.out) ; const u32x4* gW = gQ + (size_t)1024 * 1024; const u32x4* gKT = gQ + (size_t)2048 * 1024;
    const u32x4* gQK = (const u32x4*)((const bf16_t*)(c.ws + WS_C) + (size_t)1024 * 8192);
    const bf16_t* gUT = (const bf16_t*)(c.ws + WS_C);
    f32x16 S[4];
#pragma unroll
    for (int kt = 0; kt < 4; ++kt)
#pragma unroll
        for (int i = 0; i < 16; ++i) S[kt][i] = 0.f;
    const int e0 = 32 * (wid & 3);
    u32x4 zr[4]; u32x4 un[4]; float decn = 1.f;
#define P3_DMA(gp, ldsp) __builtin_amdgcn_global_load_lds((const unsigned*)(gp), (LAS unsigned*)(ldsp), 16, 0, 0)
    const int lw = (wid & 3) * 1024;
    int srcA[4], srcB[4];
#pragma unroll
    for (int i = 0; i < 4; ++i) { const int q = lt + 256 * i; const int rowA = q >> 4, rowB = q >> 3; srcA[i] = rowA * 16 + ((q & 15) ^ (rowA & 15)); srcB[i] = rowB * 8 + ((q & 7) ^ ((rowB >> 1) & 7)); }
    const int gtok = lt >> 2, gpart = lt & 3;
    if (tid < 128) ((LAS float*)(lds + P3_WN))[tid] = c.w_gdn_norm[tid];
    unsigned* const flags = (unsigned*)(c.ws + WS_FLAGS);
#define P3_WAIT(chx) do { unsigned sp_ = 0u; while (__hip_atomic_load(flags + (chx), __ATOMIC_RELAXED, __HIP_MEMORY_SCOPE_AGENT) == 0u) { __builtin_amdgcn_s_sleep(2); if (++sp_ > (1u << 22)) break; } __builtin_amdgcn_fence(__ATOMIC_ACQUIRE, "agent"); } while (0)
    P3_WAIT(ch0);
    if (loader) {
        const size_t t0 = (size_t)ch0 * 1024;
#pragma unroll
        for (int i = 0; i < 4; ++i) { P3_DMA(gW + t0 + srcA[i], lds + lw + 4096 * i); P3_DMA(gQ + t0 + srcA[i], lds + 16384 + lw + 4096 * i); P3_DMA(gKT + t0 + srcB[i], lds + 32768 + lw + 4096 * i); }
#pragma unroll
        for (int i = 0; i < 2; ++i) P3_DMA(gQK + (size_t)ch0 * 512 + srcB[i], lds + 49152 + lw + 4096 * i);
        asm volatile("s_waitcnt vmcnt(0)" ::: "memory");
    } else {
        const bf16_t* up = gUT + (size_t)ch0 * 8192 + (e0 + r) * 64 + 8 * hh;
        un[0] = *(const u32x4*)up; un[1] = *(const u32x4*)(up + 16); un[2] = *(const u32x4*)(up + 32); un[3] = *(const u32x4*)(up + 48);
        decn = __expf(__hip_atomic_load(ctl + CTL_GL + ch0, __ATOMIC_RELAXED, __HIP_MEMORY_SCOPE_AGENT));
    }
    const int rw = r & 15, rk = (r >> 1) & 7;
    if (loader) {
#pragma unroll 1
        for (int n = 0; n <= 32; ++n) {
            __syncthreads();
            if (n < 31) { P3_WAIT(ch0 + 4 * (n + 1)); const size_t t1 = (size_t)(ch0 + 4 * (n + 1)) * 1024; LAS unsigned char* Bn = lds + ((n + 1) & 1) * P3_BUF;
#pragma unroll
                for (int i = 0; i < 4; ++i) { P3_DMA(gW + t1 + srcA[i], Bn + lw + 4096 * i); P3_DMA(gQ + t1 + srcA[i], Bn + 16384 + lw + 4096 * i); P3_DMA(gKT + t1 + srcB[i], Bn + 32768 + lw + 4096 * i); }
#pragma unroll
                for (int i = 0; i < 2; ++i) P3_DMA(gQK + (size_t)(ch0 + 4 * (n + 1)) * 512 + srcB[i], Bn + 49152 + lw + 4096 * i); }
            if (n >= 1) {
                const int row = b * 2048 + (n - 1) * 64 + gtok; LAS float* op = OB + gtok * 132 + gpart * 32;
                float o[32]; float ss = 0.f;
#pragma unroll
                for (int q = 0; q < 8; ++q) { const f32x4 v = *(LAS f32x4*)(op + 4 * q); o[4 * q] = v[0]; o[4 * q + 1] = v[1]; o[4 * q + 2] = v[2]; o[4 * q + 3] = v[3]; ss += (v[0] * v[0] + v[1] * v[1]) + (v[2] * v[2] + v[3] * v[3]); }
                ss += __shfl_xor(ss, 1); ss += __shfl_xor(ss, 2);
                const float rs = rsqrtf(ss * (1.0f / 128.0f) + EPS);
                float z[32]; unpack8(zr[0], z); unpack8(zr[1], z + 8); unpack8(zr[2], z + 16); unpack8(zr[3], z + 24);
#pragma unroll
                for (int e = 0; e < 32; ++e) o[e] = o[e] * rs * ((LAS float*)(lds + P3_WN))[gpart * 32 + e] * siluf_(z[e]);
                bf16_t* dst = OY + (size_t)row * D + h * 128 + gpart * 32;
                *(u32x4*)dst = pack8(o); *(u32x4*)(dst + 8) = pack8(o + 8); *(u32x4*)(dst + 16) = pack8(o + 16); *(u32x4*)(dst + 24) = pack8(o + 24);
            }
            __syncthreads();
            asm volatile("s_waitcnt vmcnt(0)" ::: "memory");
            if (n < 32) { const bf16_t* zp = PROJ + (size_t)(b * 2048 + n * 64 + gtok) * NPROJ + 1536 + h * 128 + gpart * 32;
                zr[0] = *(const u32x4*)zp; zr[1] = *(const u32x4*)(zp + 8); zr[2] = *(const u32x4*)(zp + 16); zr[3] = *(const u32x4*)(zp + 24); }
        }
    } else {
#pragma unroll 1
        for (int n = 0; n <= 32; ++n) {
            __syncthreads();
            LAS unsigned char* B = lds + (n & 1) * P3_BUF;
            f32x16 O[2];
            if (n < 32) {
                const f32x16 zero16 = {0.f, 0.f, 0.f, 0.f, 0.f, 0.f, 0.f, 0.f, 0.f, 0.f, 0.f, 0.f, 0.f, 0.f, 0.f, 0.f};
                f32x16 P[2]; P[0] = zero16; P[1] = zero16; O[0] = zero16; O[1] = zero16;
#pragma unroll
                for (int kt = 0; kt < 4; ++kt)
#pragma unroll
                    for (int s = 0; s < 2; ++s) { const bf16x8 sb = pack_step(S[kt], s);
#pragma unroll
                        for (int mi = 0; mi < 2; ++mi) { const int off = ((32 * mi + r) * 16 + ((4 * kt + 2 * s + hh) ^ rw)) * 16;
                            P[mi] = MFMA32(*(LAS bf16x8*)(B + off), sb, P[mi]); O[mi] = MFMA32(*(LAS bf16x8*)(B + 16384 + off), sb, O[mi]); } }
                bf16x8 vb[2][2];
#pragma unroll
                for (int tb = 0; tb < 2; ++tb) { float u[16]; unpack8(un[2 * tb], u); unpack8(un[2 * tb + 1], u + 8);
                    f32x16 vn;
#pragma unroll
                    for (int i = 0; i < 16; ++i) vn[i] = u[i] - P[tb][i];
                    vb[tb][0] = pack_step(vn, 0); vb[tb][1] = pack_step(vn, 1); }
                const float dec = decn;
                if (n < 31) { P3_WAIT(ch0 + 4 * (n + 1)); const bf16_t* up = gUT + (size_t)(ch0 + 4 * (n + 1)) * 8192 + (e0 + r) * 64 + 8 * hh;
                    un[0] = *(const u32x4*)up; un[1] = *(const u32x4*)(up + 16); un[2] = *(const u32x4*)(up + 32); un[3] = *(const u32x4*)(up + 48);
                    decn = __expf(__hip_atomic_load(ctl + CTL_GL + ch0 + 4 * (n + 1), __ATOMIC_RELAXED, __HIP_MEMORY_SCOPE_AGENT)); }
#pragma unroll
                for (int mi = 0; mi < 2; ++mi)
#pragma unroll
                    for (int tb = 0; tb <= mi; ++tb)
#pragma unroll
                        for (int s = 0; s < 2; ++s) O[mi] = MFMA32(*(LAS bf16x8*)(B + 49152 + ((32 * mi + r) * 8 + ((4 * tb + 2 * s + hh) ^ rk)) * 16), vb[tb][s], O[mi]);
#pragma unroll
                for (int kt = 0; kt < 4; ++kt) { S[kt] *= dec;
#pragma unroll
                    for (int tb = 0; tb < 2; ++tb)
#pragma unroll
                        for (int s = 0; s < 2; ++s) S[kt] = MFMA32(*(LAS bf16x8*)(B + 32768 + ((32 * kt + r) * 8 + ((4 * tb + 2 * s + hh) ^ rk)) * 16), vb[tb][s], S[kt]); }
            }
            __syncthreads();
            if (n < 32) {
#pragma unroll
                for (int mi = 0; mi < 2; ++mi)
#pragma unroll
                    for (int i = 0; i < 16; ++i) OB[(32 * mi + crow(i, hh)) * 132 + e0 + r] = O[mi][i];
            }
        }
    }
    if (!loader) { float* So = c.out + OFF_GP + (size_t)bh * 16384;
#pragma unroll
        for (int kt = 0; kt < 4; ++kt)
#pragma unroll
            for (int i = 0; i < 16; ++i) So[(32 * kt + crow(i, hh)) * 128 + e0 + r] = S[kt][i]; }
    __syncthreads();
}

DI void sub_barrier(unsigned* cnt, unsigned target, bool release = true) {
    asm volatile("s_waitcnt vmcnt(0)" ::: "memory");
    __syncthreads();
    if (mk_tid() == 0) {
        if (release) { __builtin_amdgcn_fence(__ATOMIC_RELEASE, "agent"); asm volatile("s_waitcnt vmcnt(0)" ::: "memory"); }
        (void)xb_add(cnt, 1u);
        unsigned sp = 0u; while (xb_ld(cnt) < target) { __builtin_amdgcn_s_sleep(1); if (++sp > (1u << 22)) break; }
        __builtin_amdgcn_fence(__ATOMIC_ACQUIRE, "agent");
        asm volatile("s_waitcnt vmcnt(0)" ::: "memory");
    }
    __syncthreads();
}

__global__ void __launch_bounds__(NTHREADS, 2) mega(Ctx c) {
    extern __shared__ __attribute__((aligned(16))) unsigned char shm[];
    LAS unsigned char* lds = (LAS unsigned char*)shm;
    { const unsigned t0 = threadIdx.x; if ((t0 & 63u) == 0u) ((LAS unsigned*)(lds + L_WTAB))[mk_slot()] = t0 >> 6; }
    __syncthreads();
    unsigned char* ws = c.ws; float* ctl = (float*)(ws + WS_CTL);
    const int lo = c.ph_lo, hi = c.ph_hi;
    if (hi > 1000) cg::this_grid().sync();
    volatile LAS unsigned* xst = (volatile LAS unsigned*)(lds + L_XST);
    if (mk_tid() < 4) xst[mk_tid()] = 0u;
    __syncthreads();
    XcdBarrier bar = xcd_barrier_post((unsigned*)(ws + WS_BAR), xst);
#ifdef ONLY
#define IN(k) ((k) == ONLY)
#else
#define IN(k) (lo <= (k) && (k) < hi)
#endif
#define SEAM(k) do { if (IN(k) && IN((k) + 1)) xcd_barrier(bar); } while (0)
    if (IN(0)) p0_phase(c, lds);
    SEAM(0);
    if (IN(1)) { pg8::Gemm g{(const bf16_t*)(ws + WS_A), (const bf16_t*)(ws + WS_WIN), NT, NPROJ, D, 0}; pg8::StaticOrder S; S.init(NT, NPROJ, gridDim.x, blockIdx.x);
        EpiProj E{(bf16_t*)(ws + WS_B), NPROJ, ctl + CTL_RS0}; pg8::gemm_phase<EpiProj, pg8::StaticOrder, false>(lds, g, S, E, nullptr); }
    SEAM(1);
    if (IN(3)) {
        unsigned* const chw = (unsigned*)(ws + WS_BAR) + 96;
        if (blockIdx.x < 32 || blockIdx.x >= 64) {
            const int q = blockIdx.x < 32 ? (int)blockIdx.x : (int)blockIdx.x - 32, nq = (int)gridDim.x - 32;
            for (int it = q; it < 256; it += nq) sample_gdn2(c, lds, it);
            shortconv_items(c, NTP * 64, NT * 64, q, nq);
            asm volatile("s_waitcnt vmcnt(0)" ::: "memory");
            __syncthreads();
            if (mk_tid() == 0) { __builtin_amdgcn_fence(__ATOMIC_RELEASE, "agent"); asm volatile("s_waitcnt vmcnt(0)" ::: "memory"); (void)xb_add(chw, 1u); }
        }
        if (blockIdx.x < 32) { scan_seq(c, lds, blockIdx.x); const int nq = (int)gridDim.x - 32, q = nq - 32 + (int)blockIdx.x; shortconv_items(c, 0, NTP * 64, q, nq); conv_state_copies(c, q, nq); }
        else if (blockIdx.x < 64) {
            if (mk_tid() == 0) { unsigned sp = 0u; while (xb_ld(chw) < gridDim.x - 32u) { __builtin_amdgcn_s_sleep(2); if (++sp > (1u << 22)) break; } __builtin_amdgcn_fence(__ATOMIC_ACQUIRE, "agent"); asm volatile("s_waitcnt vmcnt(0)" ::: "memory"); }
            __syncthreads();
            const int j = blockIdx.x - 32; unsigned* sc = (unsigned*)(ws + WS_BAR) + 64;
            { pg8::Gemm g{(const bf16_t*)(ws + WS_A), (const bf16_t*)(ws + WS_WOUT), NT, D, D, 0}; SubOrder S{64, 2, 4, 8, j < 8 ? j : -1};
              EpiRes<0> E{c.x_prompt, c.x_sample, (bf16_t*)(ws + WS_C), nullptr, ctl + CTL_SS1, nullptr, nullptr, 1}; pg8::gemm_phase<EpiRes<0>, SubOrder, false>(lds, g, S, E, nullptr); }
            { pg8::Gemm g{(const bf16_t*)(ws + WS_PB), (const bf16_t*)(ws + WS_WP), NT, D, PLE, 0}; SubOrder S{64, 2, 4, 8, (j >= 8 && j < 16) ? j - 8 : -1};
              EpiProj E{(bf16_t*)(ws + WS_PPS) - (size_t)NTP * D, D, nullptr, 1}; pg8::gemm_phase<EpiProj, SubOrder, false>(lds, g, S, E, nullptr); }
            sub_barrier(sc, 32u, false);
            { pg8::Gemm g{(const bf16_t*)(ws + WS_C), (const bf16_t*)(ws + WS_WUP), NT, DFF, D, 0}; SubOrder S{64, 2, 16, 32, j};
              EpiUp E{(bf16_t*)(ws + WS_B), ctl + CTL_SS1, 1}; pg8::gemm_phase<EpiUp, SubOrder, false>(lds, g, S, E, nullptr); }
            sub_barrier(sc, 64u, false);
            { const int kq = j >> 3; pg8::Gemm g{(const bf16_t*)(ws + WS_B) + kq * 1024, (const bf16_t*)(ws + WS_WDN) + kq * 1024, NT, D, 1024, DFF}; SubOrder S{64, 2, 4, 8, j & 7};
              EpiSplitK E{(float*)(ws + WS_B + SLAB_OFF), kq, (bf16_t*)(ws + WS_C), ctl + CTL_SS2, (unsigned*)(ws + WS_PCNT) + 66 * 32}; pg8::gemm_phase<EpiSplitK, SubOrder, false>(lds, g, S, E, nullptr); }
            sub_barrier(sc, 96u, false);
            { pg8::Gemm g{(const bf16_t*)(ws + WS_C), (const bf16_t*)(ws + WS_WG), NT, D, D, 0}; SubOrder S{64, 2, 4, 8, j < 8 ? j : -1};
              EpiFinal E{(const bf16_t*)(ws + WS_C), (const bf16_t*)(ws + WS_PPS) - (size_t)NTP * D, ctl + CTL_SS2, ctl + CTL_SS3, (unsigned*)(ws + WS_PCNT), c.norm_f, c.out}; pg8::gemm_phase<EpiFinal, SubOrder, false>(lds, g, S, E, nullptr); }
        }
        else { const int q = (int)blockIdx.x - 64, nq = (int)gridDim.x - 64;
            for (int i = q; i < 1024; i += nq) { const int n = i >> 5, bh = i & 31; prep_chunk(c, lds, ((bh >> 2) * 32 + n) * 4 + (bh & 3)); }
            shortconv_items(c, 0, NTP * 64, q, nq + 32);
            conv_state_copies(c, q, nq + 32); }
    }
    SEAM(3);
    if (IN(4)) { pg8::Gemm g{(const bf16_t*)(ws + WS_A), (const bf16_t*)(ws + WS_WOUT), NT, D, D, 0}; pg8::StaticOrder S; S.init(NTP, D, gridDim.x, blockIdx.x);
        EpiRes<0> E{c.x_prompt, c.x_sample, (bf16_t*)(ws + WS_C), nullptr, ctl + CTL_SS1, nullptr, nullptr}; pg8::gemm_phase<EpiRes<0>, pg8::StaticOrder, false>(lds, g, S, E, nullptr); }
    SEAM(4);
    if (IN(5)) { pg8::Gemm g{(const bf16_t*)(ws + WS_C), (const bf16_t*)(ws + WS_WUP), NT, DFF, D, 0}; pg8::StaticOrder S; S.init(NTP, DFF, gridDim.x, blockIdx.x);
        EpiUp E{(bf16_t*)(ws + WS_B), ctl + CTL_SS1}; pg8::gemm_phase<EpiUp, pg8::StaticOrder, false>(lds, g, S, E, nullptr); }
    SEAM(5);
    if (IN(6)) {
        { pg8::Gemm g{(const bf16_t*)(ws + WS_B), (const bf16_t*)(ws + WS_WDN), NT, D, DFF, 0}; pg8::StaticOrder S; S.init(NTP, D, gridDim.x, blockIdx.x);
          EpiRes<1> E{nullptr, nullptr, (bf16_t*)(ws + WS_C), nullptr, ctl + CTL_SS2, nullptr, nullptr}; pg8::gemm_phase<EpiRes<1>, pg8::StaticOrder, false>(lds, g, S, E, nullptr); }
        { pg8::Gemm g{(const bf16_t*)(ws + WS_PB), (const bf16_t*)(ws + WS_WP), NT, D, PLE, 0}; pg8::StaticOrder S; S.init(NTP, D, gridDim.x, blockIdx.x);
          EpiProj E{(bf16_t*)(ws + WS_A), D, nullptr}; pg8::gemm_phase<EpiProj, pg8::StaticOrder, false>(lds, g, S, E, nullptr); }
    }
    SEAM(6);
    if (IN(7)) { pg8::Gemm g{(const bf16_t*)(ws + WS_C), (const bf16_t*)(ws + WS_WG), NT, D, D, 0}; pg8::StaticOrder S; S.init(NTP, D, gridDim.x, blockIdx.x);
        EpiFinal E{(const bf16_t*)(ws + WS_C), (const bf16_t*)(ws + WS_A), ctl + CTL_SS2, ctl + CTL_SS3, (unsigned*)(ws + WS_PCNT), c.norm_f, c.out}; pg8::gemm_phase<EpiFinal, pg8::StaticOrder, false>(lds, g, S, E, nullptr); }
#undef IN
#undef SEAM
}

#ifndef N_LAUNCH_MODE
#define N_LAUNCH_MODE 1
#endif
extern "C" void kernel_launch(void* const* d_in, const int* in_sizes, int n_in, void* d_out, int out_size, void* d_ws, size_t ws_size, hipStream_t stream) {
    static int grid = 0;
    if (grid == 0) {
        int dev = 0, cus = 0, per_cu = 0;
        if (ws_size < WS_END) { fprintf(stderr, "kernel_launch: workspace too small: %zu < %zu\n", ws_size, (size_t)WS_END); grid = -1; return; }
        hipGetDevice(&dev); hipDeviceGetAttribute(&cus, hipDeviceAttributeMultiprocessorCount, dev);
        if (hipFuncSetAttribute((const void*)mega, hipFuncAttributeMaxDynamicSharedMemorySize, LDS_BYTES) != hipSuccess) { fprintf(stderr, "kernel_launch: hipFuncSetAttribute failed\n"); grid = -1; return; }
        if (hipOccupancyMaxActiveBlocksPerMultiprocessor(&per_cu, (const void*)mega, NTHREADS, LDS_BYTES) != hipSuccess || per_cu < 1) { fprintf(stderr, "kernel_launch: occupancy query says %d\n", per_cu); per_cu = 1; }
        (void)hipGetLastError();
        grid = cus * 1;
    }
    if (grid < 0) return;
    (void)hipMemsetAsync((unsigned char*)d_ws + WS_BAR, 0, 32768, stream);
    Ctx a{};
    const float** ap = (const float**)&a;
    for (int i = 0; i < 22; ++i) ap[i] = (const float*)d_in[i];
    a.out = (float*)d_out; a.ws = (unsigned char*)d_ws;
#if N_LAUNCH_MODE == 1
    a.ph_lo = 0; a.ph_hi = 8;
    void* args[] = {&a};
    hipError_t e = hipLaunchCooperativeKernel((const void*)mega, dim3(grid), dim3(NTHREADS), args, LDS_BYTES, stream);
    if (e != hipSuccess) fprintf(stderr, "cooperative launch failed: %s (grid %d)\n", hipGetErrorString(e), grid);
#else
    for (int ph = 0; ph < 8; ++ph) { a.ph_lo = ph; a.ph_hi = ph + 1; hipLaunchKernelGGL(mega, dim3(grid), dim3(NTHREADS), LDS_BYTES, stream, a); }
#endif
}
```

```cpp
#include <hip/hip_runtime.h>
#include <hip/hip_cooperative_groups.h>
#include <cstdio>
namespace cg = cooperative_groups;

constexpr int L_WTAB = 149008;
static __device__ __forceinline__ unsigned mk_lane() { return __builtin_amdgcn_mbcnt_hi(~0u, __builtin_amdgcn_mbcnt_lo(~0u, 0u)); }
static __device__ __forceinline__ unsigned mk_slot() { return (unsigned)__builtin_amdgcn_s_getreg(0x2804) & 63u; }
static __device__ __forceinline__ unsigned mk_tid() {
    extern __shared__ __attribute__((aligned(16))) unsigned char mk_shm[];
    const unsigned w = ((__attribute__((address_space(3))) unsigned*)((__attribute__((address_space(3))) unsigned char*)mk_shm + L_WTAB))[mk_slot()];
    return (unsigned)__builtin_amdgcn_readfirstlane((int)w) * 64u + mk_lane();
}
namespace pg8 {
#define PG8_LAS __attribute__((address_space(3)))
typedef unsigned short bf16_t;
typedef short bf16x8 __attribute__((ext_vector_type(8)));
typedef float f32x4 __attribute__((ext_vector_type(4)));
typedef unsigned u32x4 __attribute__((ext_vector_type(4)));
constexpr int BM = 256, BK = 64, HALF = 128, HTB = HALF * BK * 2  , STAGE_BYTES = 8 * HTB, NXCD = 8, WGM = 8;

__host__ __device__ __forceinline__ int lds_byte(int r, int c) { const int st = (r >> 4) * 2 + (c >> 5), rr = r & 15, cc = c & 31, ob = rr * 64 + cc * 2; return st * 1024 + (ob ^ (((ob >> 9) & 1) << 5)); }
__host__ __device__ __forceinline__ void stage_rc(int b, int& R, int& C) { const int st = b / 1024, sb = b % 1024, swz = sb ^ (((sb >> 9) & 1) << 5); R = (st >> 1) * 16 + swz / 64; C = (st & 1) * 32 + (swz % 64) / 2; }
__host__ __device__ __forceinline__ int perm32(int rho) { const int n = rho >> 4, i = rho & 15; return 8 * (i >> 2) + 4 * n + (i & 3); }

struct Unit { int pm, pn; };
struct Gemm { const bf16_t* A; const bf16_t* Bt; int M, N, K; int ld; };

struct StaticOrder {
    int nM, nN, nwg, G, c;
    __host__ __device__ void init(int M, int N, int G_, int c_) { nM = M / BM; nN = N / BM; nwg = nM * nN; G = G_; c = c_; }
    __host__ __device__ bool next(int i, Unit& u) const {
        const long L = (long)i * G + c; if (L >= nwg) return false;
        int wgid = (int)L; { const int q = nwg / NXCD, r = nwg % NXCD, xcd = wgid % NXCD, off = wgid / NXCD; wgid = (xcd < r ? xcd * (q + 1) : r * (q + 1) + (xcd - r) * q) + off; }
        const int nig = WGM * nN, gid = wgid / nig, fm = gid * WGM, gsz = (nM - fm) < WGM ? (nM - fm) : WGM;
        u.pm = fm + ((wgid % nig) % gsz); u.pn = (wgid % nig) / gsz; return true;
    }
    __device__ __forceinline__ void a_ready(const Unit&) const {}
    __device__ __forceinline__ void done(const Unit&) const {}
};
template <class Epi, class Sched, bool STAMP = false>
__device__ __forceinline__ void gemm_phase(PG8_LAS unsigned char* lds, const Gemm g, const Sched& S, const Epi& E, unsigned long long* stamps) {
    int tid = mk_tid(); asm volatile("" : "+v"(tid));
    const int wid = __builtin_amdgcn_readfirstlane(tid >> 6), lane = tid & 63, wr = wid >> 2, wc = wid & 3, fr = lane & 15, fq = lane >> 4;
    const int K = g.K, nt = K / BK, LD = g.ld ? g.ld : g.K;
    int ts_lo = 0, ts_hi = 0, nts = 0; const unsigned long long rt_entry = STAMP ? (unsigned long long)wall_clock64() : 0ull;
#define PG8_STAMP() do { if (STAMP && wid == 0 && nts < 64) { const unsigned long long _c = (unsigned long long)clock64(); \
        ts_lo = (lane == nts) ? (int)(unsigned)_c : ts_lo; ts_hi = (lane == nts) ? (int)(unsigned)(_c >> 32) : ts_hi; ++nts; } } while (0)
    PG8_STAMP();
    unsigned voffA[2], voffB[2];
#pragma unroll
    for (int i = 0; i < 2; ++i) { int R, C; stage_rc(tid * 16 + i * 8192, R, C); const int Rb = Epi::PERM ? ((R & ~31) + perm32(R & 31)) : R;
        voffA[i] = (unsigned)(R * LD + C) * 2u; voffB[i] = (unsigned)(Rb * LD + C) * 2u; }
    const size_t kstep = (size_t)(BK * 2);
    const size_t hstep = (size_t)HALF * LD * 2;
    const size_t tstep = 2 * hstep;
    const unsigned ldsw = (unsigned)wid * 1024u;
    const int aoff = lds_byte(wr * 64 + fr, fq * 8), boff = lds_byte(wc * 32 + fr, fq * 8);
#define PG8_SA(b, h) (((b) * 2 + (h)) * HTB)
#define PG8_SB(b, h) ((4 + (b) * 2 + (h)) * HTB)
#define PG8_STAGE(bufoff, gbase, voff) do { _Pragma("unroll") for (int _i = 0; _i < 2; ++_i) \
        __builtin_amdgcn_global_load_lds((const unsigned*)((const char*)(gbase) + (voff)[_i]), (PG8_LAS unsigned*)(lds + (bufoff) + ldsw + _i * 8192), 16, 0, 0); } while (0)
#define PG8_LDA(dst, b, h) do { _Pragma("unroll") for (int m = 0; m < 4; ++m) _Pragma("unroll") for (int k = 0; k < 2; ++k) dst[m][k] = *(const PG8_LAS bf16x8*)(lds + PG8_SA(b, h) + aoff + m * 2048 + k * 1024); } while (0)
#define PG8_LDB(dst, b, h) do { _Pragma("unroll") for (int n = 0; n < 2; ++n) _Pragma("unroll") for (int k = 0; k < 2; ++k) dst[n][k] = *(const PG8_LAS bf16x8*)(lds + PG8_SB(b, h) + boff + n * 2048 + k * 1024); } while (0)
#define PG8_MMA(ai, bj, At, Bt) do { __builtin_amdgcn_s_setprio(1); _Pragma("unroll") for (int m = 0; m < 4; ++m) _Pragma("unroll") for (int n = 0; n < 2; ++n) _Pragma("unroll") for (int k = 0; k < 2; ++k) \
        acc[ai][bj][m][n] = __builtin_amdgcn_mfma_f32_16x16x32_bf16(Bt[n][k], At[m][k], acc[ai][bj][m][n], 0, 0, 0); __builtin_amdgcn_s_setprio(0); } while (0)
#define PG8_WAIT_V(n) asm volatile("s_waitcnt vmcnt(" #n ")" ::: "memory")
#define PG8_WAIT_L(n) asm volatile("s_waitcnt lgkmcnt(" #n ")" ::: "memory")
#define PG8_BAR __builtin_amdgcn_s_barrier()
#define PG8_SCHED __builtin_amdgcn_sched_barrier(0)
    Unit cur, nxt; int ui = 0;
    if (!S.next(0, cur)) return;
    f32x4 acc[2][2][4][2];
#pragma unroll
    for (int a = 0; a < 2; ++a)
#pragma unroll
        for (int b = 0; b < 2; ++b)
#pragma unroll
            for (int m = 0; m < 4; ++m)
#pragma unroll
                for (int n = 0; n < 2; ++n) acc[a][b][m][n] = (f32x4){0.f, 0.f, 0.f, 0.f};
    bf16x8 At[4][2], B0[2][2], B1[2][2];
    const char* cA = (const char*)g.A + (size_t)cur.pm * tstep; const char* cB = (const char*)g.Bt + (size_t)cur.pn * tstep;
    S.a_ready(cur);
    PG8_STAGE(PG8_SB(0, 0), cB, voffB); PG8_STAGE(PG8_SA(0, 0), cA, voffA); PG8_STAGE(PG8_SB(0, 1), cB + hstep, voffB); PG8_STAGE(PG8_SA(0, 1), cA + hstep, voffA);
    if (wr == 1) PG8_BAR;
    PG8_WAIT_V(4); PG8_BAR;
    PG8_STAGE(PG8_SB(1, 0), cB + kstep, voffB); PG8_STAGE(PG8_SA(1, 0), cA + kstep, voffA); PG8_STAGE(PG8_SB(1, 1), cB + hstep + kstep, voffB);
    PG8_WAIT_V(6); PG8_BAR;
    PG8_STAMP();
    for (;;) {
        const bool has_next = S.next(ui + 1, nxt);
        const char* nA = has_next ? (const char*)g.A + (size_t)nxt.pm * tstep : cA; const char* nB = has_next ? (const char*)g.Bt + (size_t)nxt.pn * tstep : cB;
        for (int t = 0; t < nt; t += 2) {
            const bool last = (t == nt - 2);
            const char* a1 = cA + (size_t)(t + 1) * kstep;
            const char* a2 = last ? nA : cA + (size_t)(t + 2) * kstep; const char* b2 = last ? nB : cB + (size_t)(t + 2) * kstep;
            const char* a3 = a2 + kstep; const char* b3 = b2 + kstep;
            if (last && has_next) S.a_ready(nxt);
            PG8_LDB(B0, 0, 0); PG8_SCHED; PG8_LDA(At, 0, 0); PG8_STAGE(PG8_SA(1, 1), a1 + hstep, voffA);
            PG8_WAIT_L(8); PG8_BAR; PG8_WAIT_L(0); PG8_MMA(0, 0, At, B0); PG8_BAR; PG8_SCHED;
            PG8_LDB(B1, 0, 1); PG8_STAGE(PG8_SB(0, 0), b2, voffB);
            PG8_BAR; PG8_WAIT_L(0); PG8_MMA(0, 1, At, B1); PG8_BAR;
            PG8_LDA(At, 0, 1); PG8_STAGE(PG8_SA(0, 0), a2, voffA);
            PG8_BAR; PG8_WAIT_L(0); PG8_MMA(1, 0, At, B0); PG8_BAR; PG8_SCHED;
            PG8_STAGE(PG8_SB(0, 1), b2 + hstep, voffB);
            PG8_WAIT_V(6); PG8_BAR; PG8_MMA(1, 1, At, B1); PG8_BAR;
            PG8_LDB(B0, 1, 0); PG8_SCHED; PG8_LDA(At, 1, 0); PG8_STAGE(PG8_SA(0, 1), a2 + hstep, voffA);
            PG8_WAIT_L(8); PG8_BAR; PG8_WAIT_L(0); PG8_MMA(0, 0, At, B0); PG8_BAR; PG8_SCHED;
            PG8_LDB(B1, 1, 1); PG8_STAGE(PG8_SB(1, 0), b3, voffB);
            PG8_BAR; PG8_WAIT_L(0); PG8_MMA(0, 1, At, B1); PG8_BAR;
            PG8_LDA(At, 1, 1); PG8_STAGE(PG8_SA(1, 0), a3, voffA);
            PG8_BAR; PG8_WAIT_L(0); PG8_MMA(1, 0, At, B0); PG8_BAR; PG8_SCHED;
            PG8_STAGE(PG8_SB(1, 1), b3 + hstep, voffB);
            PG8_WAIT_V(6); PG8_BAR; PG8_MMA(1, 1, At, B1); PG8_BAR;
        }
        PG8_STAMP();
        if constexpr (!Epi::AFTER_DRAIN) { E(acc, cur, wr, wc, fr, fq); S.done(cur); }
        PG8_STAMP();
        if (!has_next) break;
#pragma unroll
        for (int a = 0; a < 2; ++a)
#pragma unroll
            for (int b = 0; b < 2; ++b)
#pragma unroll
                for (int m = 0; m < 4; ++m)
#pragma unroll
                    for (int n = 0; n < 2; ++n) acc[a][b][m][n] = (f32x4){0.f, 0.f, 0.f, 0.f};
        cur = nxt; cA = nA; cB = nB; ++ui;
    }
    PG8_WAIT_V(0);
    if (wr == 0) PG8_BAR;
    PG8_BAR;
    if constexpr (Epi::AFTER_DRAIN) { E.fused(acc, cur, wr, wc, fr, fq, lds, wid, lane); S.done(cur); }
    PG8_STAMP();
    if (STAMP && wid == 0) { stamps[lane] = lane < nts ? (((unsigned long long)(unsigned)ts_hi << 32) | (unsigned)ts_lo) : 0ull;
        if (lane == 62) stamps[62] = rt_entry; if (lane == 63) stamps[63] = (unsigned long long)wall_clock64(); }
#undef PG8_STAMP
#undef PG8_SA
#undef PG8_SB
#undef PG8_STAGE
#undef PG8_LDA
#undef PG8_LDB
#undef PG8_MMA
#undef PG8_WAIT_V
#undef PG8_WAIT_L
#undef PG8_BAR
#undef PG8_SCHED
}
}
#define LAS __attribute__((address_space(3)))
using pg8::bf16_t; using pg8::bf16x8; using pg8::f32x4; using pg8::u32x4;
typedef float f32x16 __attribute__((ext_vector_type(16)));
typedef float f32x2v __attribute__((ext_vector_type(2)));
typedef __bf16 bf16x2v __attribute__((ext_vector_type(2)));
typedef unsigned u32x2 __attribute__((ext_vector_type(2)));
#define DI __device__ __forceinline__
#define MFMA32(a, b, c) __builtin_amdgcn_mfma_f32_32x32x16_bf16((a), (b), (c), 0, 0, 0)

constexpr int D = 1024, NTP = 16384, NTS = 512, NT = NTP + NTS;
constexpr int NPROJ = 3584, INDIM = 3592, DFF = 4096, PLE = 256;
constexpr float EPS = 1e-6f;
constexpr int NTHREADS = 512;
constexpr int LDS_BYTES = 149008 + 256;
constexpr size_t WS_WIN = 0;
constexpr size_t WS_WOUT = WS_WIN + (size_t)NPROJ * D * 2;
constexpr size_t WS_WUP = WS_WOUT + (size_t)D * D * 2;
constexpr size_t WS_WDN = WS_WUP + (size_t)DFF * D * 2;
constexpr size_t WS_WG = WS_WDN + (size_t)D * DFF * 2;
constexpr size_t WS_WP = WS_WG + (size_t)D * D * 2;
constexpr size_t WS_CTL = WS_WP + (size_t)D * PLE * 2;
constexpr size_t CTL_RS0 = 0, CTL_SS1 = NT, CTL_SS2 = 2 * NT, CTL_SS3 = 3 * NT, CTL_LA = 4 * NT, CTL_BETA = 8 * NT, CTL_GL = 12 * NT, CTL_FLOATS = 12 * NT + 1024;
constexpr size_t WS_PB = WS_CTL + ((CTL_FLOATS * 4 + 4095) / 4096) * 4096;
constexpr size_t WS_A = WS_PB + (size_t)NT * PLE * 2;
constexpr size_t WS_B = WS_A + (size_t)NT * D * 2;
constexpr size_t WS_C = WS_B + (size_t)NT * DFF * 2;
constexpr size_t WS_BAR = WS_C + (size_t)NT * D * 2;
constexpr size_t WS_FLAGS = WS_BAR + 16384;
constexpr size_t WS_PCNT = WS_BAR + 20480;
constexpr size_t WS_PPS = WS_BAR + 32768;
constexpr size_t WS_END = WS_PPS + (size_t)NTS * D * 2;
constexpr size_t OFF_Y = 0, OFF_GCP = 17301504, OFF_GP = 17338368, OFF_SCP = 17862656, OFF_GCS = 17870848, OFF_GS = 18460672, OFF_SCS = 26849280;

struct Ctx {
    const float* x_prompt; const float* x_sample; const float* state_gdn_conv; const float* state_gdn; const float* state_sc_conv; const float* p_prompt; const float* p_sample;
    const float* norm_mix; const float* w_in; const float* w_conv_qkv; const float* a_log; const float* dt_bias; const float* w_gdn_norm; const float* w_conv_sc; const float* w_out;
    const float* norm_mlp; const float* w_up; const float* w_down; const float* norm_ple; const float* w_ple_gate; const float* w_ple_proj; const float* norm_f;
    float* out; unsigned char* ws; int ph_lo, ph_hi;
};

DI unsigned pk2(float lo, float hi) { f32x2v v = {lo, hi}; return __builtin_bit_cast(unsigned, __builtin_convertvector(v, bf16x2v)); }
DI bf16_t f2bf(float f) { return (bf16_t)(pk2(f, 0.f) & 0xffffu); }
DI float bf2f(bf16_t b) { return __uint_as_float((unsigned)b << 16); }
DI float bflo(unsigned u) { return __uint_as_float(u << 16); }
DI float bfhi(unsigned u) { return __uint_as_float(u & 0xffff0000u); }
DI void unpack8(const u32x4 v, float* f) { f[0] = bflo(v.x); f[1] = bfhi(v.x); f[2] = bflo(v.y); f[3] = bfhi(v.y); f[4] = bflo(v.z); f[5] = bfhi(v.z); f[6] = bflo(v.w); f[7] = bfhi(v.w); }
DI u32x4 pack8(const float* f) { u32x4 w; w.x = pk2(f[0], f[1]); w.y = pk2(f[2], f[3]); w.z = pk2(f[4], f[5]); w.w = pk2(f[6], f[7]); return w; }
DI void st16_wt(void* ptr, const u32x4 v) { asm volatile("global_store_dwordx4 %0, %1, off sc0 sc1\n\ts_nop 2" :: "v"(ptr), "v"(v) : "memory"); }
DI int crow(int reg, int h) { return (reg & 3) + 8 * (reg >> 2) + 4 * h; }
DI int swap23(int p) { return (p & ~12) | ((p & 4) << 1) | ((p & 8) >> 1); }
DI bf16x8 pack_step(const f32x16& x, int s) {
    u32x4 p; p.x = pk2(x[8 * s], x[8 * s + 1]); p.y = pk2(x[8 * s + 2], x[8 * s + 3]); p.z = pk2(x[8 * s + 4], x[8 * s + 5]); p.w = pk2(x[8 * s + 6], x[8 * s + 7]);
    return __builtin_bit_cast(bf16x8, p);
}
DI float sigmoidf_(float x) { return __builtin_amdgcn_rcpf(1.0f + __expf(-x)); }
DI float siluf_(float x) { return x * __builtin_amdgcn_rcpf(1.0f + __expf(-x)); }

struct EpiProj {
    static constexpr bool PERM = true, AFTER_DRAIN = false;
    bf16_t* O; int ldc; const float* rs; int wt = 0;
    DI void operator()(const f32x4 (&acc)[2][2][4][2], const pg8::Unit& u, int wr, int wc, int fr, int fq) const {
        const int row0 = u.pm * 256 + wr * 64 + fr, col0 = u.pn * 256 + wc * 32 + 8 * fq;
        float rq[8];
#pragma unroll
        for (int g = 0; g < 8; ++g) rq[g] = rs ? rs[row0 + (g >> 2) * 128 + (g & 3) * 16] : 1.0f;
#pragma unroll
        for (int ai = 0; ai < 2; ++ai)
#pragma unroll
            for (int m = 0; m < 4; ++m) { const int row = row0 + ai * 128 + m * 16; const float r = rq[ai * 4 + m]; bf16_t* rowp = O + (size_t)row * ldc + col0;
#pragma unroll
                for (int bj = 0; bj < 2; ++bj) { const f32x4 v0 = acc[ai][bj][m][0] * r, v1 = acc[ai][bj][m][1] * r;
                    u32x4 w; w.x = pk2(v0[0], v0[1]); w.y = pk2(v0[2], v0[3]); w.z = pk2(v1[0], v1[1]); w.w = pk2(v1[2], v1[3]);
                    if (wt) st16_wt(rowp + bj * 128, w); else *(u32x4*)(rowp + bj * 128) = w; } }
    }
};
struct EpiUp {
    static constexpr bool PERM = true, AFTER_DRAIN = false;
    bf16_t* O; const float* ss; int wt = 0;
    DI void operator()(const f32x4 (&acc)[2][2][4][2], const pg8::Unit& u, int wr, int wc, int fr, int fq) const {
        const int row0 = u.pm * 256 + wr * 64 + fr, col0 = u.pn * 256 + wc * 32 + 8 * fq;
        float rq[8];
#pragma unroll
        for (int g = 0; g < 8; ++g) rq[g] = ss[row0 + (g >> 2) * 128 + (g & 3) * 16];
#pragma unroll
        for (int ai = 0; ai < 2; ++ai)
#pragma unroll
            for (int m = 0; m < 4; ++m) { const int row = row0 + ai * 128 + m * 16; const float r = rsqrtf(rq[ai * 4 + m] * (1.0f / 1024.0f) + EPS); bf16_t* rowp = O + (size_t)row * DFF + col0;
#pragma unroll
                for (int bj = 0; bj < 2; ++bj) { f32x4 v0 = acc[ai][bj][m][0] * r, v1 = acc[ai][bj][m][1] * r;
#pragma unroll
                    for (int j = 0; j < 4; ++j) { v0[j] = fmaxf(v0[j], 0.f); v0[j] *= v0[j]; v1[j] = fmaxf(v1[j], 0.f); v1[j] *= v1[j]; }
                    u32x4 w; w.x = pk2(v0[0], v0[1]); w.y = pk2(v0[2], v0[3]); w.z = pk2(v1[0], v1[1]); w.w = pk2(v1[2], v1[3]);
                    if (wt) st16_wt(rowp + bj * 128, w); else *(u32x4*)(rowp + bj * 128) = w; } }
    }
};
template <int MODE> struct EpiRes {
    static constexpr bool PERM = true, AFTER_DRAIN = false;
    const float* xp; const float* xs; bf16_t* XB; bf16_t* XO; float* ssn; const float* ssp; const bf16_t* PP; int wt = 0;
    DI void loadbase(int row, int col0, u32x4 (&b)[4]) const {
        const size_t off = (size_t)row * D + col0;
        if (MODE == 0) { const float* bp = (row < NTP ? xp + off : xs + (off - (size_t)NTP * D));
            b[0] = *(const u32x4*)bp; b[1] = *(const u32x4*)(bp + 4); b[2] = *(const u32x4*)(bp + 128); b[3] = *(const u32x4*)(bp + 132); }
        else { b[0] = *(const u32x4*)(XB + off); b[2] = *(const u32x4*)(XB + off + 128);
            if (MODE == 2) { b[1] = *(const u32x4*)(PP + off); b[3] = *(const u32x4*)(PP + off + 128); } else { b[1] = b[0]; b[3] = b[2]; } }
    }
    DI void operator()(const f32x4 (&acc)[2][2][4][2], const pg8::Unit& u, int wr, int wc, int fr, int fq) const {
        const int row0 = u.pm * 256 + wr * 64 + fr, col0 = u.pn * 256 + wc * 32 + 8 * fq;
        float rq[8];
        if (MODE == 2) {
#pragma unroll
            for (int g = 0; g < 8; ++g) rq[g] = ssp[row0 + (g >> 2) * 128 + (g & 3) * 16]; }
        u32x4 nb[4]; loadbase(row0, col0, nb);
#pragma unroll
        for (int g = 0; g < 8; ++g) { const int ai = g >> 2, m = g & 3; const int row = row0 + ai * 128 + m * 16; const size_t off = (size_t)row * D + col0;
            u32x4 cb[4];
#pragma unroll
            for (int q = 0; q < 4; ++q) cb[q] = nb[q];
            if (g < 7) loadbase(row0 + ((g + 1) >> 2) * 128 + ((g + 1) & 3) * 16, col0, nb);
            float r = 1.f; if (MODE == 2) r = rsqrtf(rq[g] * (1.0f / 1024.0f) + EPS);
            float sq = 0.f;
#pragma unroll
            for (int bj = 0; bj < 2; ++bj) { float v[8];
#pragma unroll
                for (int j = 0; j < 4; ++j) { v[j] = acc[ai][bj][m][0][j]; v[4 + j] = acc[ai][bj][m][1][j]; }
                if (MODE == 2) { float pf[8]; unpack8(cb[2 * bj + 1], pf);
#pragma unroll
                    for (int j = 0; j < 8; ++j) v[j] = sigmoidf_(v[j] * r) * pf[j]; }
                if (MODE == 0) { const f32x4 b0 = __builtin_bit_cast(f32x4, cb[2 * bj]), b1 = __builtin_bit_cast(f32x4, cb[2 * bj + 1]);
#pragma unroll
                    for (int j = 0; j < 4; ++j) { v[j] += b0[j]; v[4 + j] += b1[j]; } }
                else { float bf[8]; unpack8(cb[2 * bj], bf);
#pragma unroll
                    for (int j = 0; j < 8; ++j) v[j] += bf[j]; }
                if (wt) st16_wt((MODE == 2 ? XO : XB) + off + bj * 128, pack8(v)); else *(u32x4*)((MODE == 2 ? XO : XB) + off + bj * 128) = pack8(v);
#pragma unroll
                for (int j = 0; j < 8; ++j) sq += v[j] * v[j]; }
            sq += __shfl_xor(sq, 16); sq += __shfl_xor(sq, 32);
            if (fq == 0) atomicAdd(ssn + row, sq); }
    }
};
struct SubOrder {
    int pm0, nM, nN, G, c;
    DI bool next(int i, pg8::Unit& u) const { const int L = i * G + c; if (c < 0 || L >= nM * nN) return false; u.pm = pm0 + L % nM; u.pn = L / nM; return true; }
    DI void a_ready(const pg8::Unit&) const {}
    DI void done(const pg8::Unit&) const {}
};
constexpr size_t SLAB_OFF = 123000064;
constexpr size_t SLAB_FLOATS = (size_t)NTS * D;
struct EpiSplitK {
    static constexpr bool PERM = true, AFTER_DRAIN = true;
    float* SLAB; int kq; bf16_t* XB; float* ssn; unsigned* cnt;
    DI void fused(f32x4 (&acc)[2][2][4][2], const pg8::Unit& u, int wr, int wc, int fr, int fq, LAS unsigned char* lds, int wid, int lane) const {
        const int row0 = u.pm * 256 + wr * 64 + fr, col0 = u.pn * 256 + wc * 32 + 8 * fq;
        float* mine = SLAB + (size_t)kq * SLAB_FLOATS - (size_t)NTP * D;
#pragma unroll
        for (int ai = 0; ai < 2; ++ai)
#pragma unroll
            for (int m = 0; m < 4; ++m) { float* rowp = mine + (size_t)(row0 + ai * 128 + m * 16) * D + col0;
#pragma unroll
                for (int bj = 0; bj < 2; ++bj) { st16_wt(rowp + bj * 128, __builtin_bit_cast(u32x4, acc[ai][bj][m][0])); st16_wt(rowp + bj * 128 + 4, __builtin_bit_cast(u32x4, acc[ai][bj][m][1])); } }
        asm volatile("s_waitcnt vmcnt(0)" ::: "memory");
        __syncthreads();
        volatile LAS unsigned* flag = (volatile LAS unsigned*)lds;
        if (wid == 0 && lane == 0) { const unsigned t = __hip_atomic_fetch_add(cnt + ((u.pm - 64) * 4 + u.pn) * 32, 1u, __ATOMIC_RELAXED, __HIP_MEMORY_SCOPE_AGENT);
            __builtin_amdgcn_fence(__ATOMIC_ACQUIRE, "agent"); asm volatile("s_waitcnt vmcnt(0)" ::: "memory"); flag[0] = (t == 3u) ? 1u : 0u; }
        __syncthreads();
        if (flag[0] != 0u) {
#pragma unroll
            for (int ai = 0; ai < 2; ++ai)
#pragma unroll
                for (int m = 0; m < 4; ++m) { const int row = row0 + ai * 128 + m * 16; const size_t off = (size_t)row * D + col0; float sq = 0.f;
#pragma unroll
                    for (int bj = 0; bj < 2; ++bj) { float v[8]; unpack8(*(const u32x4*)(XB + off + bj * 128), v);
#pragma unroll
                        for (int q = 0; q < 4; ++q) { const float* sp = SLAB + (size_t)q * SLAB_FLOATS + (off - (size_t)NTP * D) + bj * 128; const f32x4 a0 = *(const f32x4*)sp, a1 = *(const f32x4*)(sp + 4);
#pragma unroll
                            for (int j = 0; j < 4; ++j) { v[j] += a0[j]; v[4 + j] += a1[j]; } }
                        st16_wt(XB + off + bj * 128, pack8(v));
#pragma unroll
                        for (int j = 0; j < 8; ++j) sq += v[j] * v[j]; }
                    sq += __shfl_xor(sq, 16); sq += __shfl_xor(sq, 32);
                    if (fq == 0) atomicAdd(ssn + row, sq); }
        }
    }
};
struct EpiFinal {
    static constexpr bool PERM = true, AFTER_DRAIN = true;
    const bf16_t* XB; const bf16_t* PP; const float* ssp; float* ssn; unsigned* cnt; const float* normf; float* Y;
    DI void fused(f32x4 (&acc)[2][2][4][2], const pg8::Unit& u, int wr, int wc, int fr, int fq, LAS unsigned char* lds, int wid, int lane) const {
        const int row0 = u.pm * 256 + wr * 64 + fr, col0 = u.pn * 256 + wc * 32 + 8 * fq;
        float rq[8];
#pragma unroll
        for (int g = 0; g < 8; ++g) rq[g] = ssp[row0 + (g >> 2) * 128 + (g & 3) * 16];
        u32x4 nb[4];
        { const size_t off = (size_t)row0 * D + col0; nb[0] = *(const u32x4*)(PP + off); nb[1] = *(const u32x4*)(XB + off); nb[2] = *(const u32x4*)(PP + off + 128); nb[3] = *(const u32x4*)(XB + off + 128); }
#pragma unroll
        for (int g = 0; g < 8; ++g) { const int ai = g >> 2, m = g & 3; const int row = row0 + ai * 128 + m * 16;
            u32x4 cb[4];
#pragma unroll
            for (int q = 0; q < 4; ++q) cb[q] = nb[q];
            if (g < 7) { const size_t off = (size_t)(row0 + ((g + 1) >> 2) * 128 + ((g + 1) & 3) * 16) * D + col0;
                nb[0] = *(const u32x4*)(PP + off); nb[1] = *(const u32x4*)(XB + off); nb[2] = *(const u32x4*)(PP + off + 128); nb[3] = *(const u32x4*)(XB + off + 128); }
            const float r = rsqrtf(rq[g] * (1.0f / 1024.0f) + EPS); float sq = 0.f;
#pragma unroll
            for (int bj = 0; bj < 2; ++bj) { float pf[8], bf[8]; unpack8(cb[2 * bj], pf); unpack8(cb[2 * bj + 1], bf);
#pragma unroll
                for (int j = 0; j < 4; ++j) { const float a = sigmoidf_(acc[ai][bj][m][0][j] * r) * pf[j] + bf[j], b = sigmoidf_(acc[ai][bj][m][1][j] * r) * pf[4 + j] + bf[4 + j];
                    acc[ai][bj][m][0][j] = a; acc[ai][bj][m][1][j] = b; sq += a * a + b * b; } }
            sq += __shfl_xor(sq, 16); sq += __shfl_xor(sq, 32);
            if (fq == 0) atomicAdd(ssn + row, sq); }
        asm volatile("s_waitcnt vmcnt(0)" ::: "memory");
        __syncthreads();
        if (mk_tid() == 0) { unsigned* cw = cnt + u.pm * 32; (void)__hip_atomic_fetch_add(cw, 1u, __ATOMIC_RELAXED, __HIP_MEMORY_SCOPE_AGENT);
            unsigned sp = 0u; while (__hip_atomic_load(cw, __ATOMIC_RELAXED, __HIP_MEMORY_SCOPE_AGENT) < 4u) { __builtin_amdgcn_s_sleep(1); if (++sp > (1u << 22)) break; }
            __builtin_amdgcn_fence(__ATOMIC_ACQUIRE, "agent"); asm volatile("s_waitcnt vmcnt(0)" ::: "memory"); }
        __syncthreads();
        float sq8[8]; f32x4 wv[2][2];
#pragma unroll
        for (int g = 0; g < 8; ++g) sq8[g] = __hip_atomic_load(ssn + row0 + (g >> 2) * 128 + (g & 3) * 16, __ATOMIC_RELAXED, __HIP_MEMORY_SCOPE_AGENT);
#pragma unroll
        for (int bj = 0; bj < 2; ++bj) { wv[bj][0] = *(const f32x4*)(normf + col0 + bj * 128); wv[bj][1] = *(const f32x4*)(normf + col0 + bj * 128 + 4); }
#pragma unroll
        for (int ai = 0; ai < 2; ++ai)
#pragma unroll
            for (int m = 0; m < 4; ++m) { const int row = row0 + ai * 128 + m * 16; const size_t off = (size_t)row * D + col0;
                const float rs = rsqrtf(sq8[ai * 4 + m] * (1.0f / 1024.0f) + EPS);
#pragma unroll
                for (int bj = 0; bj < 2; ++bj) { *(f32x4*)(Y + off + bj * 128) = acc[ai][bj][m][0] * rs * wv[bj][0]; *(f32x4*)(Y + off + bj * 128 + 4) = acc[ai][bj][m][1] * rs * wv[bj][1]; } }
    }
};
#define XB_TMO      128
#define XB_XCNT(j)  (256  + 64 * (j))
#define XB_XSUB(j)  (1280 + 64 * (j))
#define XB_XGEN(j)  (2304 + 64 * (j))
#define XB_TOP      3328
#define XB_TOPGEN   3392
#define XCD_BAR_WORDS 3456
#define XB_SPIN_CAP (1u << 18)

__device__ __forceinline__ unsigned xb_ld(unsigned* p)              { return __hip_atomic_load(p, __ATOMIC_RELAXED, __HIP_MEMORY_SCOPE_AGENT); }
__device__ __forceinline__ unsigned xb_add(unsigned* p, unsigned v) { return __hip_atomic_fetch_add(p, v, __ATOMIC_RELAXED, __HIP_MEMORY_SCOPE_AGENT); }
__device__ __forceinline__ unsigned xb_xcc_id() { return (unsigned)__builtin_amdgcn_s_getreg((3 << 11) | 20) & 0xFu; }
#define XB_SPIN(cond, bar) do { unsigned _sp = 0; while (cond) { __builtin_amdgcn_s_sleep(1); \
    if ((++_sp & 255u) == 0u) { if (xb_ld(&(bar)[XB_TMO])) break; if (_sp > XB_SPIN_CAP) { atomicAdd(&(bar)[XB_TMO], 1u); break; } } } } while (0)

struct XcdBarrier {
    unsigned* bar; unsigned x;
    volatile LAS unsigned* st;
};

__device__ __forceinline__ XcdBarrier xcd_barrier_post(unsigned* bar, volatile LAS unsigned* st) {
    XcdBarrier b; b.bar = bar; b.x = xb_xcc_id(); b.st = st;
    if (mk_tid() == 0) (void)xb_add(&bar[XB_XCNT(b.x)], 1u);
    return b;
}
__device__ __forceinline__ void xcd_barrier_complete(unsigned* bar, unsigned x, unsigned& nloc, unsigned& nx) {
    const unsigned G = gridDim.x * gridDim.y * gridDim.z;
    unsigned sum, cnt, mine, sp = 0u;
    for (;;) {
        sum = 0u; cnt = 0u; mine = 0u;
#pragma unroll
        for (unsigned j = 0; j < 16; ++j) { const unsigned c = xb_ld(&bar[XB_XCNT(j)]); sum += c; cnt += (c > 0u) ? 1u : 0u; mine = (j == x) ? c : mine; }
        if (sum == G) break;
        __builtin_amdgcn_s_sleep(1);
        if ((++sp & 255u) == 0u) { if (xb_ld(&bar[XB_TMO])) break; if (sp > XB_SPIN_CAP) { atomicAdd(&bar[XB_TMO], 1u); break; } }
    }
    nloc = mine > 0u ? mine : 1u; nx = cnt > 0u ? cnt : 1u;
}

__device__ __forceinline__ void xcd_barrier(const XcdBarrier& b) {
    asm volatile("s_waitcnt vmcnt(0)" ::: "memory");
    __syncthreads();
    if (mk_tid() == 0) {
        unsigned* bar = b.bar;
        __builtin_amdgcn_s_waitcnt(0);
        unsigned nloc = b.st[0], nx = b.st[1];
        if (nloc == 0u) { xcd_barrier_complete(bar, b.x, nloc, nx); b.st[0] = nloc; b.st[1] = nx; }
        const unsigned old = xb_add(&bar[XB_XSUB(b.x)], 1u);
        const unsigned gen = old / nloc;
        if (old + 1u == (gen + 1u) * nloc) {
            __builtin_amdgcn_fence(__ATOMIC_RELEASE, "agent");
            asm volatile("s_waitcnt vmcnt(0)" ::: "memory");
            const unsigned og = xb_add(&bar[XB_TOP], 1u);
            const unsigned tg = og / nx;
            if (og + 1u == (tg + 1u) * nx) xb_add(&bar[XB_TOPGEN], 1u);
            else XB_SPIN(xb_ld(&bar[XB_TOPGEN]) == tg, bar);
            __builtin_amdgcn_fence(__ATOMIC_ACQUIRE, "agent");
            xb_add(&bar[XB_XGEN(b.x)], 1u);
            asm volatile("s_waitcnt vmcnt(0)" ::: "memory");
        } else {
            XB_SPIN(xb_ld(&bar[XB_XGEN(b.x)]) == gen, bar);
            __builtin_amdgcn_fence(__ATOMIC_ACQUIRE, "agent");
            asm volatile("s_waitcnt vmcnt(0)" ::: "memory");
        }
    }
    __syncthreads();
}
struct TileDesc { const float* W; const float* nrm; bf16_t* Wt; int ldw, K, k0, n0src, n0dst; };
DI TileDesc p0_tile(const Ctx& c, unsigned char* ws, int t) {
    TileDesc d;
    if (t < 896) { const int kt = t / 56, nt = t % 56, n0 = nt * 64; d = TileDesc{c.w_in, c.norm_mix, (bf16_t*)(ws + WS_WIN), INDIM, D, kt * 64, n0 < 1536 ? n0 : n0 + 8, n0}; return d; }
    t -= 896;
    if (t < 256) { d = TileDesc{c.w_out, nullptr, (bf16_t*)(ws + WS_WOUT), D, D, (t / 16) * 64, (t % 16) * 64, (t % 16) * 64}; return d; }
    t -= 256;
    if (t < 1024) { d = TileDesc{c.w_up, c.norm_mlp, (bf16_t*)(ws + WS_WUP), DFF, D, (t / 64) * 64, (t % 64) * 64, (t % 64) * 64}; return d; }
    t -= 1024;
    if (t < 1024) { d = TileDesc{c.w_down, nullptr, (bf16_t*)(ws + WS_WDN), D, DFF, (t / 16) * 64, (t % 16) * 64, (t % 16) * 64}; return d; }
    t -= 1024;
    if (t < 256) { d = TileDesc{c.w_ple_gate, c.norm_ple, (bf16_t*)(ws + WS_WG), D, D, (t / 16) * 64, (t % 16) * 64, (t % 16) * 64}; return d; }
    t -= 256;
    d = TileDesc{c.w_ple_proj, nullptr, (bf16_t*)(ws + WS_WP), D, PLE, (t / 16) * 64, (t % 16) * 64, (t % 16) * 64}; return d;
}
DI void tile_load(const TileDesc& d, float (&v)[8]) {
    const int tid = mk_tid();
#pragma unroll
    for (int i = 0; i < 8; ++i) { const int kk = i * 8 + (tid >> 6), nn = tid & 63; float x = d.W[(size_t)(d.k0 + kk) * d.ldw + d.n0src + nn]; if (d.nrm) x *= d.nrm[d.k0 + kk]; v[i] = x; }
}
DI void tile_store(const TileDesc& d, const float (&v)[8], LAS float* tile) {
    const int tid = mk_tid();
#pragma unroll
    for (int i = 0; i < 8; ++i) { const int kk = i * 8 + (tid >> 6), nn = tid & 63; tile[kk * 65 + nn] = v[i]; }
    __syncthreads();
    { const int nn = tid >> 3, kq = tid & 7; float f[8];
#pragma unroll
      for (int e = 0; e < 8; ++e) f[e] = tile[(kq * 8 + e) * 65 + nn];
      *(u32x4*)(d.Wt + (size_t)(d.n0dst + nn) * d.K + d.k0 + kq * 8) = pack8(f); }
    __syncthreads();
}
DI void p0_phase(const Ctx& c, LAS unsigned char* lds) {
    const int tid = mk_tid(), lane = tid & 63, wid = tid >> 6;
    unsigned char* ws = c.ws;
    float* ctl = (float*)(ws + WS_CTL);
    bf16_t* XB = (bf16_t*)(ws + WS_A); bf16_t* PB = (bf16_t*)(ws + WS_PB);
    LAS float* wab = (LAS float*)lds;
    for (int i = tid; i < 1024 * 8; i += NTHREADS) { const int k = i >> 3, j = i & 7; wab[i] = c.w_in[(size_t)k * INDIM + 1536 + j] * c.norm_mix[k]; }
    __syncthreads();
    float xn[16]; f32x4 x4n[4], p4n;
#pragma unroll
    for (int i = 0; i < 4; ++i) x4n[i] = (f32x4){0.f, 0.f, 0.f, 0.f};
    p4n = (f32x4){0.f, 0.f, 0.f, 0.f};
    { const int row = blockIdx.x * 8 + wid; if (row < NT) { const float* xr = row < NTP ? c.x_prompt + (size_t)row * D : c.x_sample + (size_t)(row - NTP) * D;
        const float* pr0 = row < NTP ? c.p_prompt + (size_t)row * PLE : c.p_sample + (size_t)(row - NTP) * PLE;
#pragma unroll
        for (int i = 0; i < 16; ++i) xn[i] = xr[i * 64 + lane];
#pragma unroll
        for (int i = 0; i < 4; ++i) x4n[i] = *(const f32x4*)(xr + i * 256 + lane * 4);
        p4n = *(const f32x4*)(pr0 + lane * 4); } }
    for (int row = blockIdx.x * 8 + wid; row < NT; row += gridDim.x * 8) {
        const float* xr = row < NTP ? c.x_prompt + (size_t)row * D : c.x_sample + (size_t)(row - NTP) * D;
        const float* pr = row < NTP ? c.p_prompt + (size_t)row * PLE : c.p_sample + (size_t)(row - NTP) * PLE;
        float xc[16]; f32x4 x4c[4]; const f32x4 p4c = p4n;
#pragma unroll
        for (int i = 0; i < 16; ++i) xc[i] = xn[i];
#pragma unroll
        for (int i = 0; i < 4; ++i) x4c[i] = x4n[i];
        { const int rown = row + gridDim.x * 8; if (rown < NT) { const float* xq = rown < NTP ? c.x_prompt + (size_t)rown * D : c.x_sample + (size_t)(rown - NTP) * D;
            const float* pq = rown < NTP ? c.p_prompt + (size_t)rown * PLE : c.p_sample + (size_t)(rown - NTP) * PLE;
#pragma unroll
            for (int i = 0; i < 4; ++i) x4n[i] = *(const f32x4*)(xq + i * 256 + lane * 4);
            p4n = *(const f32x4*)(pq + lane * 4);
#pragma unroll
            for (int i = 0; i < 16; ++i) xn[i] = xq[i * 64 + lane]; } }
        float ss = 0.f, dot[8];
#pragma unroll
        for (int j = 0; j < 8; ++j) dot[j] = 0.f;
#pragma unroll
        for (int i = 0; i < 16; ++i) { const int k = i * 64 + lane; const float xv = xc[i]; ss += xv * xv;
            const f32x4 w0 = *(const LAS f32x4*)(wab + k * 8), w1 = *(const LAS f32x4*)(wab + k * 8 + 4);
            dot[0] += xv * w0[0]; dot[1] += xv * w0[1]; dot[2] += xv * w0[2]; dot[3] += xv * w0[3]; dot[4] += xv * w1[0]; dot[5] += xv * w1[1]; dot[6] += xv * w1[2]; dot[7] += xv * w1[3]; }
#pragma unroll
        for (int o = 32; o >= 1; o >>= 1) { ss += __shfl_xor(ss, o);
#pragma unroll
            for (int j = 0; j < 8; ++j) dot[j] += __shfl_xor(dot[j], o); }
        const float rs = rsqrtf(ss * (1.0f / 1024.0f) + EPS);
#pragma unroll
        for (int i = 0; i < 4; ++i) { const int k0 = i * 256 + lane * 4; const f32x4 v = x4c[i]; u32x2 w; w.x = pk2(v[0], v[1]); w.y = pk2(v[2], v[3]); *(u32x2*)(XB + (size_t)row * D + k0) = w; }
        { const f32x4 v = p4c; u32x2 w; w.x = pk2(v[0], v[1]); w.y = pk2(v[2], v[3]); *(u32x2*)(PB + (size_t)row * PLE + lane * 4) = w; }
        if (lane == 0) { ctl[CTL_RS0 + row] = rs; ctl[CTL_SS1 + row] = 0.f; ctl[CTL_SS2 + row] = 0.f; ctl[CTL_SS3 + row] = 0.f; }
        if (lane < 4) { const float da = lane == 0 ? dot[0] : lane == 1 ? dot[1] : lane == 2 ? dot[2] : dot[3]; const float db = lane == 0 ? dot[4] : lane == 1 ? dot[5] : lane == 2 ? dot[6] : dot[7];
            const float xa = da * rs + c.dt_bias[lane]; const float sp = xa > 20.f ? xa : log1pf(__expf(xa));
            ctl[CTL_LA + (size_t)row * 4 + lane] = -__expf(c.a_log[lane]) * sp; ctl[CTL_BETA + (size_t)row * 4 + lane] = sigmoidf_(db * rs); }
    }
    __syncthreads();
    LAS float* tile = (LAS float*)lds;
    {
        int tl = blockIdx.x; float va[8], vb[8];
        if (tl < 3520) { TileDesc d = p0_tile(c, ws, tl); tile_load(d, va);
            for (;;) {
                const int tn = tl + gridDim.x; TileDesc dn = d;
                if (tn < 3520) { dn = p0_tile(c, ws, tn); tile_load(dn, vb); }
                tile_store(d, va, tile);
                if (tn >= 3520) break;
#pragma unroll
                for (int i = 0; i < 8; ++i) va[i] = vb[i];
                d = dn; tl = tn;
            } }
    }
}

constexpr int L_QH = 0, L_KH = 17408, L_RT = 34816, L_AM = 71680, L_TB = 89088, L_G = 98304, L_WC = 98816, L_SSP = 104960;
DI void prep_chunk(const Ctx& c, LAS unsigned char* lds, int ch) {
    int tid = mk_tid(); asm volatile("" : "+v"(tid));
    const int lane = tid & 63, wid = __builtin_amdgcn_readfirstlane(tid >> 6);
    const int h = ch & 3, n = (ch >> 2) & 31, b = ch >> 7;
    const int row0 = b * 2048 + n * 64;
    float* ctl = (float*)(c.ws + WS_CTL);
    const bf16_t* PROJ = (const bf16_t*)(c.ws + WS_B);
    bf16_t* QP = (bf16_t*)c.out + (size_t)ch * 8192; bf16_t* WP = (bf16_t*)c.out + (size_t)(1024 + ch) * 8192; bf16_t* KTP = (bf16_t*)c.out + (size_t)(2048 + ch) * 8192;
    bf16_t* UT = (bf16_t*)(c.ws + WS_C) + (size_t)ch * 8192; bf16_t* QKP = (bf16_t*)(c.ws + WS_C) + (size_t)1024 * 8192 + (size_t)ch * 4096;
    LAS float* G = (LAS float*)(lds + L_G); LAS float* BT = G + 64;
    LAS float* WC = (LAS float*)(lds + L_WC);
    LAS float* SSP = (LAS float*)(lds + L_SSP);
    for (int i = tid; i < 1536; i += NTHREADS) { const int ten = i >> 9, jj = (i >> 7) & 3, cc = i & 127; WC[i] = c.w_conv_qkv[jj * 1536 + ten * 512 + h * 128 + cc]; }
    if (wid == 0) {
        float la = ctl[CTL_LA + (size_t)(row0 + lane) * 4 + h];
#pragma unroll
        for (int o = 1; o < 64; o <<= 1) { const float t = __int_as_float(__builtin_amdgcn_ds_bpermute(((lane - o) & 63) * 4, __float_as_int(la))); if (lane >= o) la += t; }
        G[lane] = la; BT[lane] = ctl[CTL_BETA + (size_t)(row0 + lane) * 4 + h];
        if (lane == 63) __hip_atomic_store(ctl + CTL_GL + ch, la, __ATOMIC_RELAXED, __HIP_MEMORY_SCOPE_AGENT);
    }
    {
        const int tok = lane, cg8 = wid;
        const int t_abs = n * 64 + tok;
        u32x4 xr[3][4][2];
#pragma unroll
        for (int ten = 0; ten < 3; ++ten)
#pragma unroll
            for (int j = 0; j < 4; ++j) { const int tt = t_abs - 3 + j;
                if (tt >= 0) { const bf16_t* src = PROJ + (size_t)(b * 2048 + tt) * NPROJ + ten * 512 + h * 128 + cg8 * 16; xr[ten][j][0] = *(const u32x4*)src; xr[ten][j][1] = *(const u32x4*)(src + 8); }
                else { xr[ten][j][0] = (u32x4){0u, 0u, 0u, 0u}; xr[ten][j][1] = (u32x4){0u, 0u, 0u, 0u}; } }
        __syncthreads();
        const float g = G[tok], bt = BT[tok];
        const float eg = __expf(g);
        float a[3][16];
#pragma unroll
        for (int ten = 0; ten < 3; ++ten) {
#pragma unroll
            for (int e = 0; e < 16; ++e) a[ten][e] = 0.f;
#pragma unroll
            for (int j = 0; j < 4; ++j) { float x[16]; unpack8(xr[ten][j][0], x); unpack8(xr[ten][j][1], x + 8);
                const LAS float* wj = WC + (ten * 4 + j) * 128 + cg8 * 16;
#pragma unroll
                for (int q = 0; q < 4; ++q) { const f32x4 w = *(const LAS f32x4*)(wj + 4 * q); a[ten][4 * q] += x[4 * q] * w[0]; a[ten][4 * q + 1] += x[4 * q + 1] * w[1]; a[ten][4 * q + 2] += x[4 * q + 2] * w[2]; a[ten][4 * q + 3] += x[4 * q + 3] * w[3]; } }
#pragma unroll
            for (int e = 0; e < 16; ++e) a[ten][e] = siluf_(a[ten][e]);
        }
        { float sq = 0.f, sk = 0.f;
#pragma unroll
          for (int e = 0; e < 16; ++e) { sq += a[0][e] * a[0][e]; sk += a[1][e] * a[1][e]; }
          SSP[cg8 * 64 + tok] = sq; SSP[512 + cg8 * 64 + tok] = sk; }
        __syncthreads();
        { float sq = 0.f, sk = 0.f;
#pragma unroll
          for (int w = 0; w < 8; ++w) { sq += SSP[w * 64 + tok]; sk += SSP[512 + w * 64 + tok]; }
          const float scq = rsqrtf(sq + EPS) * 0.08838834764831845f, sck = rsqrtf(sk + EPS);
#pragma unroll
          for (int e = 0; e < 16; ++e) { a[0][e] *= scq; a[1][e] *= sck; } }
        {
            LAS unsigned char* q = lds + L_QH + tok * 272 + cg8 * 32;
            *(LAS u32x4*)q = pack8(a[0]); *(LAS u32x4*)(q + 16) = pack8(a[0] + 8);
            float p[16];
#pragma unroll
            for (int e = 0; e < 16; ++e) p[swap23(e)] = a[0][e] * eg;
            bf16_t* dst = QP + tok * 128 + cg8 * 16; st16_wt(dst, pack8(p)); st16_wt(dst + 8, pack8(p + 8));
        }
        {
            LAS unsigned char* q = lds + L_KH + tok * 272 + cg8 * 32;
            *(LAS u32x4*)q = pack8(a[1]); *(LAS u32x4*)(q + 16) = pack8(a[1] + 8);
            const float f = bt * eg;
#pragma unroll
            for (int e = 0; e < 16; ++e) *(LAS bf16_t*)(lds + L_RT + (128 + cg8 * 16 + e) * 144 + tok * 2) = f2bf(a[1][e] * f);
        }
#pragma unroll
        for (int e = 0; e < 16; ++e) *(LAS bf16_t*)(lds + L_RT + (cg8 * 16 + e) * 144 + tok * 2) = f2bf(a[2][e] * bt);
    }
    __syncthreads();
    {
        int r = lane & 31, hh = lane >> 5; asm volatile("" : "+v"(r), "+v"(hh));
        const int blk = wid & 3, I = (blk == 1 || blk == 2) ? 1 : 0, J = (blk == 2 || blk == 3) ? 1 : 0; const bool isq = wid >= 4;
        f32x16 x;
#pragma unroll
        for (int i = 0; i < 16; ++i) x[i] = 0.f;
        if (blk != 3) {
            LAS unsigned char* Ab = lds + (isq ? L_QH : L_KH) + (32 * I + r) * 272 + hh * 16; LAS unsigned char* Bb = lds + L_KH + (32 * J + r) * 272 + hh * 16;
#pragma unroll
            for (int s = 0; s < 8; ++s) { const bf16x8 av = *(LAS bf16x8*)(Ab + s * 32), bv = *(LAS bf16x8*)(Bb + s * 32); x = isq ? MFMA32(bv, av, x) : MFMA32(av, bv, x); }
        }
        if (!isq) {
            const int jj = 32 * J + r; const float gj = G[jj];
            if (blk != 3) {
#pragma unroll
                for (int i = 0; i < 16; ++i) { const int ii = 32 * I + crow(i, hh); const float d = __expf(fminf(G[ii] - gj, 0.f)); ((LAS float*)(lds + L_AM))[ii * 68 + jj] = (ii > jj) ? BT[ii] * x[i] * d : 0.f; } }
        } else {
            const int ii = 32 * I + r; const float gi = G[ii]; float f[16];
#pragma unroll
            for (int i = 0; i < 16; ++i) { const int jj = 32 * J + crow(i, hh); const float d = __expf(fminf(gi - G[jj], 0.f)); f[i] = (ii >= jj && blk != 3) ? x[i] * d : 0.f; }
            bf16_t* dst = QKP + ii * 64 + 32 * J; st16_wt(dst + 8 * hh, pack8(f)); st16_wt(dst + 16 + 8 * hh, pack8(f + 8));
        }
    }
    {
        const int dk = tid & 127, tq = tid >> 7; const float glast = G[63]; float f[16];
#pragma unroll
        for (int t = 0; t < 16; ++t) { const int tk = 16 * tq + t; f[swap23(t)] = bf2f(*(LAS bf16_t*)(lds + L_KH + tk * 272 + dk * 2)) * __expf(glast - G[tk]); }
        bf16_t* dst = KTP + dk * 64 + 16 * tq; st16_wt(dst, pack8(f)); st16_wt(dst + 8, pack8(f + 8));
    }
    __syncthreads();
#ifndef NOINV
    if (wid == 0) {
        f32x2v t2[32]; f32x4 ab[2][16]; float lanef = (float)lane; asm volatile("" : "+v"(lanef));
        int zoff; asm volatile("v_mov_b32 %0, 0" : "=v"(zoff));
        LAS float* AM = (LAS float*)(lds + L_AM) + zoff;
        t2[0].x = fmaxf(1.0f - fabsf(lanef), 0.f); t2[0].y = 0.f;
        ab[1][0] = *(LAS f32x4*)(AM + 68);
#pragma unroll
        for (int i = 1; i < 64; ++i) {
            if (i + 1 < 64) {
#pragma unroll
                for (int q = 0; q < (i + 4) / 4; ++q) ab[(i + 1) & 1][q] = *(LAS f32x4*)(AM + (i + 1) * 68 + 4 * q); }
            __builtin_amdgcn_sched_barrier(0);
            f32x2v acc2 = {fmaxf(1.0f - fabsf(lanef - (float)i), 0.f), 0.f};
#pragma unroll
            for (int q = 0; q < (i + 3) / 4; ++q) { const f32x4 av = ab[i & 1][q]; const int j = 4 * q;
                if (j + 1 < i) acc2 -= (f32x2v){av[0], av[1]} * t2[j / 2]; else acc2.x -= av[0] * t2[j / 2].x;
                if (j + 3 < i) acc2 -= (f32x2v){av[2], av[3]} * t2[j / 2 + 1]; else if (j + 2 < i) acc2.x -= av[2] * t2[j / 2 + 1].x; }
            const float ti = acc2.x + acc2.y;
            if (i & 1) t2[i / 2].y = ti; else { t2[i / 2].x = ti; t2[i / 2].y = 0.f; }
            __builtin_amdgcn_sched_barrier(0);
        }
#pragma unroll
        for (int i = 0; i < 32; ++i) { *(LAS bf16_t*)(lds + L_TB + (2 * i) * 144 + lane * 2) = f2bf(t2[i].x); *(LAS bf16_t*)(lds + L_TB + (2 * i + 1) * 144 + lane * 2) = f2bf(t2[i].y); }
    }
#endif
    __syncthreads();
    {
        int r = lane & 31, hh = lane >> 5; asm volatile("" : "+v"(r), "+v"(hh));
#pragma unroll
        for (int tb = 0; tb < 2; ++tb) {
            f32x16 x;
#pragma unroll
            for (int i = 0; i < 16; ++i) x[i] = 0.f;
#pragma unroll
            for (int s = 0; s < 4; ++s) if (s < 2 || tb == 1) {
                const bf16x8 tf = *(LAS bf16x8*)(lds + L_TB + (32 * tb + r) * 144 + (16 * s + 8 * hh) * 2), rf = *(LAS bf16x8*)(lds + L_RT + (32 * wid + r) * 144 + (16 * s + 8 * hh) * 2);
                x = (wid < 4) ? MFMA32(tf, rf, x) : MFMA32(rf, tf, x); }
            float f[16];
#pragma unroll
            for (int i = 0; i < 16; ++i) f[i] = x[i];
            bf16_t* dst = (wid < 4) ? UT + (32 * wid + r) * 64 + 32 * tb : WP + (32 * tb + r) * 128 + 32 * (wid - 4);
            st16_wt(dst + 8 * hh, pack8(f)); st16_wt(dst + 16 + 8 * hh, pack8(f + 8));
        }
    }
    asm volatile("s_waitcnt vmcnt(0)" ::: "memory");
    __syncthreads();
    if (tid == 0) __hip_atomic_store((unsigned*)(c.ws + WS_FLAGS) + ch, 1u, __ATOMIC_RELAXED, __HIP_MEMORY_SCOPE_AGENT);
}

DI void sample_gdn2(const Ctx& c, LAS unsigned char* lds, int pair) {
    const int tid = mk_tid(), lane = tid & 63, half = tid >> 8, ht = tid & 255, hw = (tid >> 6) & 3;
    const int item = pair * 2 + half, b = item >> 2, h = item & 3;
    float* ctl = (float*)(c.ws + WS_CTL);
    const bf16_t* PROJ = (const bf16_t*)(c.ws + WS_B); bf16_t* OY = (bf16_t*)(c.ws + WS_A);
    LAS float* vals = (LAS float*)lds + half * 3072;
    LAS float* red = vals + 1536;
    LAS float* red2 = red + 256;
    LAS float* os = red2 + 256;
    const int row0 = NTP + b * 4;
    for (int i = ht; i < 1536; i += 256) { const int ten = i >> 9, tok = (i >> 7) & 3, ch = i & 127; const int col = ten * 512 + h * 128 + ch; float a = 0.f;
#pragma unroll
        for (int j = 0; j < 4; ++j) { const int idx = tok + j; const float xv = idx < 3 ? c.state_gdn_conv[((size_t)b * 3 + idx) * 1536 + col] : bf2f(PROJ[(size_t)(row0 + idx - 3) * NPROJ + col]); a += xv * c.w_conv_qkv[j * 1536 + col]; }
        vals[i] = siluf_(a); }
    __syncthreads();
#pragma unroll
    for (int rep = 0; rep < 2; ++rep) { const int pr = hw * 2 + rep, ten = pr >> 2, tok = pr & 3; LAS float* v = vals + ten * 512 + tok * 128; const float a0 = v[lane], a1 = v[lane + 64]; float ss = a0 * a0 + a1 * a1;
#pragma unroll
        for (int o = 32; o >= 1; o >>= 1) ss += __shfl_xor(ss, o);
        const float sc = rsqrtf(ss + EPS) * (ten == 0 ? 0.08838834764831845f : 1.0f); v[lane] = a0 * sc; v[lane + 64] = a1 * sc; }
    __syncthreads();
    const int e = ht & 127, part = ht >> 7;
    float s[64];
    const float* S0 = c.state_gdn + ((size_t)item * 128 + part * 64) * 128 + e;
#pragma unroll
    for (int i = 0; i < 64; ++i) s[i] = S0[(size_t)i * 128];
#pragma unroll 1
    for (int t = 0; t < 4; ++t) {
        const float a = __expf(ctl[CTL_LA + (size_t)(row0 + t) * 4 + h]), bt = ctl[CTL_BETA + (size_t)(row0 + t) * 4 + h];
        LAS float* qv = vals + t * 128 + part * 64; LAS float* kv = vals + 512 + t * 128 + part * 64;
        float p = 0.f;
#pragma unroll
        for (int i = 0; i < 64; ++i) { s[i] *= a; p += s[i] * kv[i]; }
        red[part * 128 + e] = p;
        __syncthreads();
        const float rr = bt * (vals[1024 + t * 128 + e] - (red[e] + red[128 + e]));
        float po = 0.f;
#pragma unroll
        for (int i = 0; i < 64; ++i) { s[i] += kv[i] * rr; po += s[i] * qv[i]; }
        red2[part * 128 + e] = po;
        __syncthreads();
        if (part == 0) os[t * 128 + e] = red2[e] + red2[128 + e];
    }
    float* Sout = c.out + OFF_GS + ((size_t)item * 128 + part * 64) * 128 + e;
#pragma unroll
    for (int i = 0; i < 64; ++i) Sout[(size_t)i * 128] = s[i];
    __syncthreads();
#pragma unroll
    for (int rep = 0; rep < 2; ++rep) { const int tok = part * 2 + rep; float ss = 0.f;
        for (int i = 0; i < 128; ++i) { const float v = os[tok * 128 + i]; ss += v * v; }
        const float rs = rsqrtf(ss * (1.0f / 128.0f) + EPS); const int row = row0 + tok;
        const float z = bf2f(PROJ[(size_t)row * NPROJ + 1536 + h * 128 + e]);
        OY[(size_t)row * D + h * 128 + e] = f2bf(os[tok * 128 + e] * rs * c.w_gdn_norm[e] * siluf_(z)); }
    __syncthreads();
}

DI void shortconv_items(const Ctx& c, int item_lo, int item_hi, int bfirst, int bcount) {
    const int tid = mk_tid();
    const bf16_t* PROJ = (const bf16_t*)(c.ws + WS_B); bf16_t* OY = (bf16_t*)(c.ws + WS_A);
    for (int item = item_lo + bfirst * NTHREADS + tid; item < item_hi; item += bcount * NTHREADS) {
        const int row = item >> 6, c8 = (item & 63) * 8;
        const bool prm = row < NTP; const int sb = prm ? (row >> 11) : ((row - NTP) >> 2); const int t = prm ? (row & 2047) : ((row - NTP) & 3); const int T = prm ? 2048 : 4;
        float bv[8]; unpack8(*(const u32x4*)(PROJ + (size_t)row * NPROJ + 2048 + c8), bv);
        float acc[8], cur[8];
#pragma unroll
        for (int e = 0; e < 8; ++e) { acc[e] = 0.f; cur[e] = 0.f; }
#pragma unroll
        for (int d = 0; d < 3; ++d) { const int tt = t - 2 + d; float sc[8];
            if (tt >= 0) { float cv[8], hv[8]; const bf16_t* src = PROJ + (size_t)(row - (2 - d)) * NPROJ + c8; unpack8(*(const u32x4*)(src + 2560), cv); unpack8(*(const u32x4*)(src + 3072), hv);
#pragma unroll
                for (int e = 0; e < 8; ++e) sc[e] = cv[e] * hv[e]; }
            else if (!prm) { const float* sp = c.state_sc_conv + ((size_t)sb * 2 + (2 + tt)) * 512 + c8; const f32x4 s0 = *(const f32x4*)sp, s1 = *(const f32x4*)(sp + 4);
#pragma unroll
                for (int e = 0; e < 4; ++e) { sc[e] = s0[e]; sc[4 + e] = s1[e]; } }
            else {
#pragma unroll
                for (int e = 0; e < 8; ++e) sc[e] = 0.f; }
            const float* wp = c.w_conv_sc + d * 512 + c8; const f32x4 w0 = *(const f32x4*)wp, w1 = *(const f32x4*)(wp + 4);
#pragma unroll
            for (int e = 0; e < 4; ++e) { acc[e] += sc[e] * w0[e]; acc[4 + e] += sc[4 + e] * w1[e]; }
            if (d == 2) {
#pragma unroll
                for (int e = 0; e < 8; ++e) cur[e] = sc[e]; } }
#pragma unroll
        for (int e = 0; e < 8; ++e) acc[e] *= bv[e];
        *(u32x4*)(OY + (size_t)row * D + 512 + c8) = pack8(acc);
        if (t >= T - 2) { float* dst = (prm ? c.out + OFF_SCP : c.out + OFF_SCS) + ((size_t)sb * 2 + (t - (T - 2))) * 512 + c8;
            *(f32x4*)dst = (f32x4){cur[0], cur[1], cur[2], cur[3]}; *(f32x4*)(dst + 4) = (f32x4){cur[4], cur[5], cur[6], cur[7]}; }
    }
}
DI void conv_state_copies(const Ctx& c, int bfirst, int bcount) {
    const int tid = mk_tid();
    const bf16_t* PROJ = (const bf16_t*)(c.ws + WS_B);
    for (int idx = bfirst * NTHREADS + tid; idx < 136 * 4608; idx += bcount * NTHREADS) {
        const int seq = idx / 4608, rem = idx % 4608, j = rem / 1536, col = rem % 1536;
        if (seq < 8) c.out[OFF_GCP + idx] = bf2f(PROJ[(size_t)(seq * 2048 + 2045 + j) * NPROJ + col]);
        else c.out[OFF_GCS + (idx - 8 * 4608)] = bf2f(PROJ[(size_t)(NTP + (seq - 8) * 4 + 1 + j) * NPROJ + col]);
    }
}

constexpr int P3_BUF = 57344, P3_OB = 114688, L_XST = 148480, P3_WN = 148496;
DI void scan_seq(const Ctx& c, LAS unsigned char* lds, int bh) {
    const int tid = mk_tid(), lane = tid & 63, wid = tid >> 6, r = lane & 31, hh = lane >> 5;
    const int b = bh >> 2, h = bh & 3;
    const bool loader = wid >= 4; const int lt = tid & 255;
    const float* ctl = (const float*)(c.ws + WS_CTL);
    const bf16_t* PROJ = (const bf16_t*)(c.ws + WS_B); bf16_t* OY = (bf16_t*)(c.ws + WS_A);
    LAS float* OB = (LAS float*)(lds + P3_OB);
    const int ch0 = b * 128 + h;
    const u32x4* gQ = (const u32x4*)((const bf16_t*)c.out) ; const u32x4* gW = gQ + (size_t)1024 * 1024; const u32x4* gKT = gQ + (size_t)2048 * 1024;
    const u32x4* gQK = (const u32x4*)((const bf16_t*)(c.ws + WS_C) + (size_t)1024 * 8192);
    const bf16_t* gUT = (const bf16_t*)(c.ws + WS_C);
    f32x16 S[4];
#pragma unroll
    for (int kt = 0; kt < 4; ++kt)
#pragma unroll
        for (int i = 0; i < 16; ++i) S[kt][i] = 0.f;
    const int e0 = 32 * (wid & 3);
    u32x4 zr[4]; u32x4 un[4]; float decn = 1.f;
#define P3_DMA(gp, ldsp) __builtin_amdgcn_global_load_lds((const unsigned*)(gp), (LAS unsigned*)(ldsp), 16, 0, 0)
    const int lw = (wid & 3) * 1024;
    int srcA[4], srcB[4];
#pragma unroll
    for (int i = 0; i < 4; ++i) { const int q = lt + 256 * i; const int rowA = q >> 4, rowB = q >> 3; srcA[i] = rowA * 16 + ((q & 15) ^ (rowA & 15)); srcB[i] = rowB * 8 + ((q & 7) ^ ((rowB >> 1) & 7)); }
    const int gtok = lt >> 2, gpart = lt & 3;
    if (tid < 128) ((LAS float*)(lds + P3_WN))[tid] = c.w_gdn_norm[tid];
    unsigned* const flags = (unsigned*)(c.ws + WS_FLAGS);
#define P3_WAIT(chx) do { unsigned sp_ = 0u; while (__hip_atomic_load(flags + (chx), __ATOMIC_RELAXED, __HIP_MEMORY_SCOPE_AGENT) == 0u) { __builtin_amdgcn_s_sleep(2); if (++sp_ > (1u << 22)) break; } __builtin_amdgcn_fence(__ATOMIC_ACQUIRE, "agent"); } while (0)
    P3_WAIT(ch0);
    if (loader) {
        const size_t t0 = (size_t)ch0 * 1024;
#pragma unroll
        for (int i = 0; i < 4; ++i) { P3_DMA(gW + t0 + srcA[i], lds + lw + 4096 * i); P3_DMA(gQ + t0 + srcA[i], lds + 16384 + lw + 4096 * i); P3_DMA(gKT + t0 + srcB[i], lds + 32768 + lw + 4096 * i); }
#pragma unroll
        for (int i = 0; i < 2; ++i) P3_DMA(gQK + (size_t)ch0 * 512 + srcB[i], lds + 49152 + lw + 4096 * i);
        asm volatile("s_waitcnt vmcnt(0)" ::: "memory");
    } else {
        const bf16_t* up = gUT + (size_t)ch0 * 8192 + (e0 + r) * 64 + 8 * hh;
        un[0] = *(const u32x4*)up; un[1] = *(const u32x4*)(up + 16); un[2] = *(const u32x4*)(up + 32); un[3] = *(const u32x4*)(up + 48);
        decn = __expf(__hip_atomic_load(ctl + CTL_GL + ch0, __ATOMIC_RELAXED, __HIP_MEMORY_SCOPE_AGENT));
    }
    const int rw = r & 15, rk = (r >> 1) & 7;
    if (loader) {
#pragma unroll 1
        for (int n = 0; n <= 32; ++n) {
            __syncthreads();
            if (n < 31) { P3_WAIT(ch0 + 4 * (n + 1)); const size_t t1 = (size_t)(ch0 + 4 * (n + 1)) * 1024; LAS unsigned char* Bn = lds + ((n + 1) & 1) * P3_BUF;
#pragma unroll
                for (int i = 0; i < 4; ++i) { P3_DMA(gW + t1 + srcA[i], Bn + lw + 4096 * i); P3_DMA(gQ + t1 + srcA[i], Bn + 16384 + lw + 4096 * i); P3_DMA(gKT + t1 + srcB[i], Bn + 32768 + lw + 4096 * i); }
#pragma unroll
                for (int i = 0; i < 2; ++i) P3_DMA(gQK + (size_t)(ch0 + 4 * (n + 1)) * 512 + srcB[i], Bn + 49152 + lw + 4096 * i); }
            if (n >= 1) {
                const int row = b * 2048 + (n - 1) * 64 + gtok; LAS float* op = OB + gtok * 132 + gpart * 32;
                float o[32]; float ss = 0.f;
#pragma unroll
                for (int q = 0; q < 8; ++q) { const f32x4 v = *(LAS f32x4*)(op + 4 * q); o[4 * q] = v[0]; o[4 * q + 1] = v[1]; o[4 * q + 2] = v[2]; o[4 * q + 3] = v[3]; ss += (v[0] * v[0] + v[1] * v[1]) + (v[2] * v[2] + v[3] * v[3]); }
                ss += __shfl_xor(ss, 1); ss += __shfl_xor(ss, 2);
                const float rs = rsqrtf(ss * (1.0f / 128.0f) + EPS);
                float z[32]; unpack8(zr[0], z); unpack8(zr[1], z + 8); unpack8(zr[2], z + 16); unpack8(zr[3], z + 24);
#pragma unroll
                for (int e = 0; e < 32; ++e) o[e] = o[e] * rs * ((LAS float*)(lds + P3_WN))[gpart * 32 + e] * siluf_(z[e]);
                bf16_t* dst = OY + (size_t)row * D + h * 128 + gpart * 32;
                *(u32x4*)dst = pack8(o); *(u32x4*)(dst + 8) = pack8(o + 8); *(u32x4*)(dst + 16) = pack8(o + 16); *(u32x4*)(dst + 24) = pack8(o + 24);
            }
            __syncthreads();
            asm volatile("s_waitcnt vmcnt(0)" ::: "memory");
            if (n < 32) { const bf16_t* zp = PROJ + (size_t)(b * 2048 + n * 64 + gtok) * NPROJ + 1536 + h * 128 + gpart * 32;
                zr[0] = *(const u32x4*)zp; zr[1] = *(const u32x4*)(zp + 8); zr[2] = *(const u32x4*)(zp + 16); zr[3] = *(const u32x4*)(zp + 24); }
        }
    } else {
#pragma unroll 1
        for (int n = 0; n <= 32; ++n) {
            __syncthreads();
            LAS unsigned char* B = lds + (n & 1) * P3_BUF;
            f32x16 O[2];
            if (n < 32) {
                const f32x16 zero16 = {0.f, 0.f, 0.f, 0.f, 0.f, 0.f, 0.f, 0.f, 0.f, 0.f, 0.f, 0.f, 0.f, 0.f, 0.f, 0.f};
                f32x16 P[2]; P[0] = zero16; P[1] = zero16; O[0] = zero16; O[1] = zero16;
#pragma unroll
                for (int kt = 0; kt < 4; ++kt)
#pragma unroll
                    for (int s = 0; s < 2; ++s) { const bf16x8 sb = pack_step(S[kt], s);
#pragma unroll
                        for (int mi = 0; mi < 2; ++mi) { const int off = ((32 * mi + r) * 16 + ((4 * kt + 2 * s + hh) ^ rw)) * 16;
                            P[mi] = MFMA32(*(LAS bf16x8*)(B + off), sb, P[mi]); O[mi] = MFMA32(*(LAS bf16x8*)(B + 16384 + off), sb, O[mi]); } }
                bf16x8 vb[2][2];
#pragma unroll
                for (int tb = 0; tb < 2; ++tb) { float u[16]; unpack8(un[2 * tb], u); unpack8(un[2 * tb + 1], u + 8);
                    f32x16 vn;
#pragma unroll
                    for (int i = 0; i < 16; ++i) vn[i] = u[i] - P[tb][i];
                    vb[tb][0] = pack_step(vn, 0); vb[tb][1] = pack_step(vn, 1); }
                const float dec = decn;
                if (n < 31) { P3_WAIT(ch0 + 4 * (n + 1)); const bf16_t* up = gUT + (size_t)(ch0 + 4 * (n + 1)) * 8192 + (e0 + r) * 64 + 8 * hh;
                    un[0] = *(const u32x4*)up; un[1] = *(const u32x4*)(up + 16); un[2] = *(const u32x4*)(up + 32); un[3] = *(const u32x4*)(up + 48);
                    decn = __expf(__hip_atomic_load(ctl + CTL_GL + ch0 + 4 * (n + 1), __ATOMIC_RELAXED, __HIP_MEMORY_SCOPE_AGENT)); }
#pragma unroll
                for (int mi = 0; mi < 2; ++mi)
#pragma unroll
                    for (int tb = 0; tb <= mi; ++tb)
#pragma unroll
                        for (int s = 0; s < 2; ++s) O[mi] = MFMA32(*(LAS bf16x8*)(B + 49152 + ((32 * mi + r) * 8 + ((4 * tb + 2 * s + hh) ^ rk)) * 16), vb[tb][s], O[mi]);
#pragma unroll
                for (int kt = 0; kt < 4; ++kt) { S[kt] *= dec;
#pragma unroll
                    for (int tb = 0; tb < 2; ++tb)
#pragma unroll
                        for (int s = 0; s < 2; ++s) S[kt] = MFMA32(*(LAS bf16x8*)(B + 32768 + ((32 * kt + r) * 8 + ((4 * tb + 2 * s + hh) ^ rk)) * 16), vb[tb][s], S[kt]); }
            }
            __syncthreads();
            if (n < 32) {
#pragma unroll
                for (int mi = 0; mi < 2; ++mi)
#pragma unroll
                    for (int i = 0; i < 16; ++i) OB[(32 * mi + crow(i, hh)) * 132 + e0 + r] = O[mi][i];
            }
        }
    }
    if (!loader) { float* So = c.out + OFF_GP + (size_t)bh * 16384;
#pragma unroll
        for (int kt = 0; kt < 4; ++kt)
#pragma unroll
            for (int i = 0; i < 16; ++i) So[(32 * kt + crow(i, hh)) * 128 + e0 + r] = S[kt][i]; }
    __syncthreads();
}

DI void sub_barrier(unsigned* cnt, unsigned target, bool release = true) {
    asm volatile("s_waitcnt vmcnt(0)" ::: "memory");
    __syncthreads();
    if (mk_tid() == 0) {
        if (release) { __builtin_amdgcn_fence(__ATOMIC_RELEASE, "agent"); asm volatile("s_waitcnt vmcnt(0)" ::: "memory"); }
        (void)xb_add(cnt, 1u);
        unsigned sp = 0u; while (xb_ld(cnt) < target) { __builtin_amdgcn_s_sleep(1); if (++sp > (1u << 22)) break; }
        __builtin_amdgcn_fence(__ATOMIC_ACQUIRE, "agent");
        asm volatile("s_waitcnt vmcnt(0)" ::: "memory");
    }
    __syncthreads();
}

__global__ void __launch_bounds__(NTHREADS, 2) mega(Ctx c) {
    extern __shared__ __attribute__((aligned(16))) unsigned char shm[];
    LAS unsigned char* lds = (LAS unsigned char*)shm;
    { const unsigned t0 = threadIdx.x; if ((t0 & 63u) == 0u) ((LAS unsigned*)(lds + L_WTAB))[mk_slot()] = t0 >> 6; }
    __syncthreads();
    unsigned char* ws = c.ws; float* ctl = (float*)(ws + WS_CTL);
    const int lo = c.ph_lo, hi = c.ph_hi;
    if (hi > 1000) cg::this_grid().sync();
    volatile LAS unsigned* xst = (volatile LAS unsigned*)(lds + L_XST);
    if (mk_tid() < 4) xst[mk_tid()] = 0u;
    __syncthreads();
    XcdBarrier bar = xcd_barrier_post((unsigned*)(ws + WS_BAR), xst);
#ifdef ONLY
#define IN(k) ((k) == ONLY)
#else
#define IN(k) (lo <= (k) && (k) < hi)
#endif
#define SEAM(k) do { if (IN(k) && IN((k) + 1)) xcd_barrier(bar); } while (0)
    if (IN(0)) p0_phase(c, lds);
    SEAM(0);
    if (IN(1)) { pg8::Gemm g{(const bf16_t*)(ws + WS_A), (const bf16_t*)(ws + WS_WIN), NT, NPROJ, D, 0}; pg8::StaticOrder S; S.init(NT, NPROJ, gridDim.x, blockIdx.x);
        EpiProj E{(bf16_t*)(ws + WS_B), NPROJ, ctl + CTL_RS0}; pg8::gemm_phase<EpiProj, pg8::StaticOrder, false>(lds, g, S, E, nullptr); }
    SEAM(1);
    if (IN(3)) {
        unsigned* const chw = (unsigned*)(ws + WS_BAR) + 96;
        if (blockIdx.x < 32 || blockIdx.x >= 64) {
            const int q = blockIdx.x < 32 ? (int)blockIdx.x : (int)blockIdx.x - 32, nq = (int)gridDim.x - 32;
            for (int it = q; it < 256; it += nq) sample_gdn2(c, lds, it);
            shortconv_items(c, NTP * 64, NT * 64, q, nq);
            asm volatile("s_waitcnt vmcnt(0)" ::: "memory");
            __syncthreads();
            if (mk_tid() == 0) { __builtin_amdgcn_fence(__ATOMIC_RELEASE, "agent"); asm volatile("s_waitcnt vmcnt(0)" ::: "memory"); (void)xb_add(chw, 1u); }
        }
        if (blockIdx.x < 32) { scan_seq(c, lds, blockIdx.x); const int nq = (int)gridDim.x - 32, q = nq - 32 + (int)blockIdx.x; shortconv_items(c, 0, NTP * 64, q, nq); conv_state_copies(c, q, nq); }
        else if (blockIdx.x < 64) {
            if (mk_tid() == 0) { unsigned sp = 0u; while (xb_ld(chw) < gridDim.x - 32u) { __builtin_amdgcn_s_sleep(2); if (++sp > (1u << 22)) break; } __builtin_amdgcn_fence(__ATOMIC_ACQUIRE, "agent"); asm volatile("s_waitcnt vmcnt(0)" ::: "memory"); }
            __syncthreads();
            const int j = blockIdx.x - 32; unsigned* sc = (unsigned*)(ws + WS_BAR) + 64;
            { pg8::Gemm g{(const bf16_t*)(ws + WS_A), (const bf16_t*)(ws + WS_WOUT), NT, D, D, 0}; SubOrder S{64, 2, 4, 8, j < 8 ? j : -1};
              EpiRes<0> E{c.x_prompt, c.x_sample, (bf16_t*)(ws + WS_C), nullptr, ctl + CTL_SS1, nullptr, nullptr, 1}; pg8::gemm_phase<EpiRes<0>, SubOrder, false>(lds, g, S, E, nullptr); }
            { pg8::Gemm g{(const bf16_t*)(ws + WS_PB), (const bf16_t*)(ws + WS_WP), NT, D, PLE, 0}; SubOrder S{64, 2, 4, 8, (j >= 8 && j < 16) ? j - 8 : -1};
              EpiProj E{(bf16_t*)(ws + WS_PPS) - (size_t)NTP * D, D, nullptr, 1}; pg8::gemm_phase<EpiProj, SubOrder, false>(lds, g, S, E, nullptr); }
            sub_barrier(sc, 32u, false);
            { pg8::Gemm g{(const bf16_t*)(ws + WS_C), (const bf16_t*)(ws + WS_WUP), NT, DFF, D, 0}; SubOrder S{64, 2, 16, 32, j};
              EpiUp E{(bf16_t*)(ws + WS_B), ctl + CTL_SS1, 1}; pg8::gemm_phase<EpiUp, SubOrder, false>(lds, g, S, E, nullptr); }
            sub_barrier(sc, 64u, false);
            { const int kq = j >> 3; pg8::Gemm g{(const bf16_t*)(ws + WS_B) + kq * 1024, (const bf16_t*)(ws + WS_WDN) + kq * 1024, NT, D, 1024, DFF}; SubOrder S{64, 2, 4, 8, j & 7};
              EpiSplitK E{(float*)(ws + WS_B + SLAB_OFF), kq, (bf16_t*)(ws + WS_C), ctl + CTL_SS2, (unsigned*)(ws + WS_PCNT) + 66 * 32}; pg8::gemm_phase<EpiSplitK, SubOrder, false>(lds, g, S, E, nullptr); }
            sub_barrier(sc, 96u, false);
            { pg8::Gemm g{(const bf16_t*)(ws + WS_C), (const bf16_t*)(ws + WS_WG), NT, D, D, 0}; SubOrder S{64, 2, 4, 8, j < 8 ? j : -1};
              EpiFinal E{(const bf16_t*)(ws + WS_C), (const bf16_t*)(ws + WS_PPS) - (size_t)NTP * D, ctl + CTL_SS2, ctl + CTL_SS3, (unsigned*)(ws + WS_PCNT), c.norm_f, c.out}; pg8::gemm_phase<EpiFinal, SubOrder, false>(lds, g, S, E, nullptr); }
        }
        else { const int q = (int)blockIdx.x - 64, nq = (int)gridDim.x - 64;
            for (int i = q; i < 1024; i += nq) { const int n = i >> 5, bh = i & 31; prep_chunk(c, lds, ((bh >> 2) * 32 + n) * 4 + (bh & 3)); }
            shortconv_items(c, 0, NTP * 64, q, nq + 32);
            conv_state_copies(c, q, nq + 32); }
    }
    SEAM(3);
    if (IN(4)) { pg8::Gemm g{(const bf16_t*)(ws + WS_A), (const bf16_t*)(ws + WS_WOUT), NT, D, D, 0}; pg8::StaticOrder S; S.init(NTP, D, gridDim.x, blockIdx.x);
        EpiRes<0> E{c.x_prompt, c.x_sample, (bf16_t*)(ws + WS_C), nullptr, ctl + CTL_SS1, nullptr, nullptr}; pg8::gemm_phase<EpiRes<0>, pg8::StaticOrder, false>(lds, g, S, E, nullptr); }
    SEAM(4);
    if (IN(5)) { pg8::Gemm g{(const bf16_t*)(ws + WS_C), (const bf16_t*)(ws + WS_WUP), NT, DFF, D, 0}; pg8::StaticOrder S; S.init(NTP, DFF, gridDim.x, blockIdx.x);
        EpiUp E{(bf16_t*)(ws + WS_B), ctl + CTL_SS1}; pg8::gemm_phase<EpiUp, pg8::StaticOrder, false>(lds, g, S, E, nullptr); }
    SEAM(5);
    if (IN(6)) {
        { pg8::Gemm g{(const bf16_t*)(ws + WS_B), (const bf16_t*)(ws + WS_WDN), NT, D, DFF, 0}; pg8::StaticOrder S; S.init(NTP, D, gridDim.x, blockIdx.x);
          EpiRes<1> E{nullptr, nullptr, (bf16_t*)(ws + WS_C), nullptr, ctl + CTL_SS2, nullptr, nullptr}; pg8::gemm_phase<EpiRes<1>, pg8::StaticOrder, false>(lds, g, S, E, nullptr); }
        { pg8::Gemm g{(const bf16_t*)(ws + WS_PB), (const bf16_t*)(ws + WS_WP), NT, D, PLE, 0}; pg8::StaticOrder S; S.init(NTP, D, gridDim.x, blockIdx.x);
          EpiProj E{(bf16_t*)(ws + WS_A), D, nullptr}; pg8::gemm_phase<EpiProj, pg8::StaticOrder, false>(lds, g, S, E, nullptr); }
    }
    SEAM(6);
    if (IN(7)) { pg8::Gemm g{(const bf16_t*)(ws + WS_C), (const bf16_t*)(ws + WS_WG), NT, D, D, 0}; pg8::StaticOrder S; S.init(NTP, D, gridDim.x, blockIdx.x);
        EpiFinal E{(const bf16_t*)(ws + WS_C), (const bf16_t*)(ws + WS_A), ctl + CTL_SS2, ctl + CTL_SS3, (unsigned*)(ws + WS_PCNT), c.norm_f, c.out}; pg8::gemm_phase<EpiFinal, pg8::StaticOrder, false>(lds, g, S, E, nullptr); }
#undef IN
#undef SEAM
}

#ifndef N_LAUNCH_MODE
#define N_LAUNCH_MODE 1
#endif
extern "C" void kernel_launch(void* const* d_in, const int* in_sizes, int n_in, void* d_out, int out_size, void* d_ws, size_t ws_size, hipStream_t stream) {
    static int grid = 0;
    if (grid == 0) {
        int dev = 0, cus = 0, per_cu = 0;
        if (ws_size < WS_END) { fprintf(stderr, "kernel_launch: workspace too small: %zu < %zu\n", ws_size, (size_t)WS_END); grid = -1; return; }
        hipGetDevice(&dev); hipDeviceGetAttribute(&cus, hipDeviceAttributeMultiprocessorCount, dev);
        if (hipFuncSetAttribute((const void*)mega, hipFuncAttributeMaxDynamicSharedMemorySize, LDS_BYTES) != hipSuccess) { fprintf(stderr, "kernel_launch: hipFuncSetAttribute failed\n"); grid = -1; return; }
        if (hipOccupancyMaxActiveBlocksPerMultiprocessor(&per_cu, (const void*)mega, NTHREADS, LDS_BYTES) != hipSuccess || per_cu < 1) { fprintf(stderr, "kernel_launch: occupancy query says %d\n", per_cu); per_cu = 1; }
        (void)hipGetLastError();
        grid = cus * 1;
    }
    if (grid < 0) return;
    (void)hipMemsetAsync((unsigned char*)d_ws + WS_BAR, 0, 32768, stream);
    Ctx a{};
    const float** ap = (const float**)&a;
    for (int i = 0; i < 22; ++i) ap[i] = (const float*)d_in[i];
    a.out = (float*)d_out; a.ws = (unsigned char*)d_ws;
#if N_LAUNCH_MODE == 1
    a.ph_lo = 0; a.ph_hi = 8;
    void* args[] = {&a};
    hipError_t e = hipLaunchCooperativeKernel((const void*)mega, dim3(grid), dim3(NTHREADS), args, LDS_BYTES, stream);
    if (e != hipSuccess) fprintf(stderr, "cooperative launch failed: %s (grid %d)\n", hipGetErrorString(e), grid);
#else
    for (int ph = 0; ph < 8; ++ph) { a.ph_lo = ph; a.ph_hi = ph + 1; hipLaunchKernelGGL(mega, dim3(grid), dim3(NTHREADS), LDS_BYTES, stream, a); }
#endif
}
```

```cpp
#include <hip/hip_runtime.h>
#include <hip/hip_cooperative_groups.h>
#include <cstdio>
namespace cg = cooperative_groups;

constexpr int L_WTAB = 149008;
static __device__ __forceinline__ unsigned mk_lane() { return __builtin_amdgcn_mbcnt_hi(~0u, __builtin_amdgcn_mbcnt_lo(~0u, 0u)); }
static __device__ __forceinline__ unsigned mk_slot() { return (unsigned)__builtin_amdgcn_s_getreg(0x2804) & 63u; }
static __device__ __forceinline__ unsigned mk_tid() {
    extern __shared__ __attribute__((aligned(16))) unsigned char mk_shm[];
    const unsigned w = ((__attribute__((address_space(3))) unsigned*)((__attribute__((address_space(3))) unsigned char*)mk_shm + L_WTAB))[mk_slot()];
    return (unsigned)__builtin_amdgcn_readfirstlane((int)w) * 64u + mk_lane();
}
namespace pg8 {
#define PG8_LAS __attribute__((address_space(3)))
typedef unsigned short bf16_t;
typedef short bf16x8 __attribute__((ext_vector_type(8)));
typedef float f32x4 __attribute__((ext_vector_type(4)));
typedef unsigned u32x4 __attribute__((ext_vector_type(4)));
constexpr int BM = 256, BK = 64, HALF = 128, HTB = HALF * BK * 2  , STAGE_BYTES = 8 * HTB, NXCD = 8, WGM = 8;

__host__ __device__ __forceinline__ int lds_byte(int r, int c) { const int st = (r >> 4) * 2 + (c >> 5), rr = r & 15, cc = c & 31, ob = rr * 64 + cc * 2; return st * 1024 + (ob ^ (((ob >> 9) & 1) << 5)); }
__host__ __device__ __forceinline__ void stage_rc(int b, int& R, int& C) { const int st = b / 1024, sb = b % 1024, swz = sb ^ (((sb >> 9) & 1) << 5); R = (st >> 1) * 16 + swz / 64; C = (st & 1) * 32 + (swz % 64) / 2; }
__host__ __device__ __forceinline__ int perm32(int rho) { const int n = rho >> 4, i = rho & 15; return 8 * (i >> 2) + 4 * n + (i & 3); }

struct Unit { int pm, pn; };
struct Gemm { const bf16_t* A; const bf16_t* Bt; int M, N, K; int ld; };

struct StaticOrder {
    int nM, nN, nwg, G, c;
    __host__ __device__ void init(int M, int N, int G_, int c_) { nM = M / BM; nN = N / BM; nwg = nM * nN; G = G_; c = c_; }
    __host__ __device__ bool next(int i, Unit& u) const {
        const long L = (long)i * G + c; if (L >= nwg) return false;
        int wgid = (int)L; { const int q = nwg / NXCD, r = nwg % NXCD, xcd = wgid % NXCD, off = wgid / NXCD; wgid = (xcd < r ? xcd * (q + 1) : r * (q + 1) + (xcd - r) * q) + off; }
        const int nig = WGM * nN, gid = wgid / nig, fm = gid * WGM, gsz = (nM - fm) < WGM ? (nM - fm) : WGM;
        u.pm = fm + ((wgid % nig) % gsz); u.pn = (wgid % nig) / gsz; return true;
    }
    __device__ __forceinline__ void a_ready(const Unit&) const {}
    __device__ __forceinline__ void done(const Unit&) const {}
};
template <class Epi, class Sched, bool STAMP = false>
__device__ __forceinline__ void gemm_phase(PG8_LAS unsigned char* lds, const Gemm g, const Sched& S, const Epi& E, unsigned long long* stamps) {
    int tid = mk_tid(); asm volatile("" : "+v"(tid));
    const int wid = __builtin_amdgcn_readfirstlane(tid >> 6), lane = tid & 63, wr = wid >> 2, wc = wid & 3, fr = lane & 15, fq = lane >> 4;
    const int K = g.K, nt = K / BK, LD = g.ld ? g.ld : g.K;
    int ts_lo = 0, ts_hi = 0, nts = 0; const unsigned long long rt_entry = STAMP ? (unsigned long long)wall_clock64() : 0ull;
#define PG8_STAMP() do { if (STAMP && wid == 0 && nts < 64) { const unsigned long long _c = (unsigned long long)clock64(); \
        ts_lo = (lane == nts) ? (int)(unsigned)_c : ts_lo; ts_hi = (lane == nts) ? (int)(unsigned)(_c >> 32) : ts_hi; ++nts; } } while (0)
    PG8_STAMP();
    unsigned voffA[2], voffB[2];
#pragma unroll
    for (int i = 0; i < 2; ++i) { int R, C; stage_rc(tid * 16 + i * 8192, R, C); const int Rb = Epi::PERM ? ((R & ~31) + perm32(R & 31)) : R;
        voffA[i] = (unsigned)(R * LD + C) * 2u; voffB[i] = (unsigned)(Rb * LD + C) * 2u; }
    const size_t kstep = (size_t)(BK * 2);
    const size_t hstep = (size_t)HALF * LD * 2;
    const size_t tstep = 2 * hstep;
    const unsigned ldsw = (unsigned)wid * 1024u;
    const int aoff = lds_byte(wr * 64 + fr, fq * 8), boff = lds_byte(wc * 32 + fr, fq * 8);
#define PG8_SA(b, h) (((b) * 2 + (h)) * HTB)
#define PG8_SB(b, h) ((4 + (b) * 2 + (h)) * HTB)
#define PG8_STAGE(bufoff, gbase, voff) do { _Pragma("unroll") for (int _i = 0; _i < 2; ++_i) \
        __builtin_amdgcn_global_load_lds((const unsigned*)((const char*)(gbase) + (voff)[_i]), (PG8_LAS unsigned*)(lds + (bufoff) + ldsw + _i * 8192), 16, 0, 0); } while (0)
#define PG8_LDA(dst, b, h) do { _Pragma("unroll") for (int m = 0; m < 4; ++m) _Pragma("unroll") for (int k = 0; k < 2; ++k) dst[m][k] = *(const PG8_LAS bf16x8*)(lds + PG8_SA(b, h) + aoff + m * 2048 + k * 1024); } while (0)
#define PG8_LDB(dst, b, h) do { _Pragma("unroll") for (int n = 0; n < 2; ++n) _Pragma("unroll") for (int k = 0; k < 2; ++k) dst[n][k] = *(const PG8_LAS bf16x8*)(lds + PG8_SB(b, h) + boff + n * 2048 + k * 1024); } while (0)
#define PG8_MMA(ai, bj, At, Bt) do { __builtin_amdgcn_s_setprio(1); _Pragma("unroll") for (int m = 0; m < 4; ++m) _Pragma("unroll") for (int n = 0; n < 2; ++n) _Pragma("unroll") for (int k = 0; k < 2; ++k) \
        acc[ai][bj][m][n] = __builtin_amdgcn_mfma_f32_16x16x32_bf16(Bt[n][k], At[m][k], acc[ai][bj][m][n], 0, 0, 0); __builtin_amdgcn_s_setprio(0); } while (0)
#define PG8_WAIT_V(n) asm volatile("s_waitcnt vmcnt(" #n ")" ::: "memory")
#define PG8_WAIT_L(n) asm volatile("s_waitcnt lgkmcnt(" #n ")" ::: "memory")
#define PG8_BAR __builtin_amdgcn_s_barrier()
#define PG8_SCHED __builtin_amdgcn_sched_barrier(0)
    Unit cur, nxt; int ui = 0;
    if (!S.next(0, cur)) return;
    f32x4 acc[2][2][4][2];
#pragma unroll
    for (int a = 0; a < 2; ++a)
#pragma unroll
        for (int b = 0; b < 2; ++b)
#pragma unroll
            for (int m = 0; m < 4; ++m)
#pragma unroll
                for (int n = 0; n < 2; ++n) acc[a][b][m][n] = (f32x4){0.f, 0.f, 0.f, 0.f};
    bf16x8 At[4][2], B0[2][2], B1[2][2];
    const char* cA = (const char*)g.A + (size_t)cur.pm * tstep; const char* cB = (const char*)g.Bt + (size_t)cur.pn * tstep;
    S.a_ready(cur);
    PG8_STAGE(PG8_SB(0, 0), cB, voffB); PG8_STAGE(PG8_SA(0, 0), cA, voffA); PG8_STAGE(PG8_SB(0, 1), cB + hstep, voffB); PG8_STAGE(PG8_SA(0, 1), cA + hstep, voffA);
    if (wr == 1) PG8_BAR;
    PG8_WAIT_V(4); PG8_BAR;
    PG8_STAGE(PG8_SB(1, 0), cB + kstep, voffB); PG8_STAGE(PG8_SA(1, 0), cA + kstep, voffA); PG8_STAGE(PG8_SB(1, 1), cB + hstep + kstep, voffB);
    PG8_WAIT_V(6); PG8_BAR;
    PG8_STAMP();
    for (;;) {
        float rqv[8]; E.pre(cur, wr, fr, rqv);
        const bool has_next = S.next(ui + 1, nxt);
        const char* nA = has_next ? (const char*)g.A + (size_t)nxt.pm * tstep : cA; const char* nB = has_next ? (const char*)g.Bt + (size_t)nxt.pn * tstep : cB;
        for (int t = 0; t < nt; t += 2) {
            const bool last = (t == nt - 2);
            const char* a1 = cA + (size_t)(t + 1) * kstep;
            const char* a2 = last ? nA : cA + (size_t)(t + 2) * kstep; const char* b2 = last ? nB : cB + (size_t)(t + 2) * kstep;
            const char* a3 = a2 + kstep; const char* b3 = b2 + kstep;
            if (last && has_next) S.a_ready(nxt);
            PG8_LDB(B0, 0, 0); PG8_SCHED; PG8_LDA(At, 0, 0); PG8_STAGE(PG8_SA(1, 1), a1 + hstep, voffA);
            PG8_WAIT_L(8); PG8_BAR; PG8_WAIT_L(0); PG8_MMA(0, 0, At, B0); PG8_BAR; PG8_SCHED;
            PG8_LDB(B1, 0, 1); PG8_STAGE(PG8_SB(0, 0), b2, voffB);
            PG8_BAR; PG8_WAIT_L(0); PG8_MMA(0, 1, At, B1); PG8_BAR;
            PG8_LDA(At, 0, 1); PG8_STAGE(PG8_SA(0, 0), a2, voffA);
            PG8_BAR; PG8_WAIT_L(0); PG8_MMA(1, 0, At, B0); PG8_BAR; PG8_SCHED;
            PG8_STAGE(PG8_SB(0, 1), b2 + hstep, voffB);
            PG8_WAIT_V(6); PG8_BAR; PG8_MMA(1, 1, At, B1); PG8_BAR;
            PG8_LDB(B0, 1, 0); PG8_SCHED; PG8_LDA(At, 1, 0); PG8_STAGE(PG8_SA(0, 1), a2 + hstep, voffA);
            PG8_WAIT_L(8); PG8_BAR; PG8_WAIT_L(0); PG8_MMA(0, 0, At, B0); PG8_BAR; PG8_SCHED;
            PG8_LDB(B1, 1, 1); PG8_STAGE(PG8_SB(1, 0), b3, voffB);
            PG8_BAR; PG8_WAIT_L(0); PG8_MMA(0, 1, At, B1); PG8_BAR;
            PG8_LDA(At, 1, 1); PG8_STAGE(PG8_SA(1, 0), a3, voffA);
            PG8_BAR; PG8_WAIT_L(0); PG8_MMA(1, 0, At, B0); PG8_BAR; PG8_SCHED;
            PG8_STAGE(PG8_SB(1, 1), b3 + hstep, voffB);
            PG8_WAIT_V(6); PG8_BAR; PG8_MMA(1, 1, At, B1); PG8_BAR;
        }
        PG8_STAMP();
        if constexpr (!Epi::AFTER_DRAIN) { E(acc, cur, wr, wc, fr, fq, rqv); S.done(cur); }
        PG8_STAMP();
        if (!has_next) break;
#pragma unroll
        for (int a = 0; a < 2; ++a)
#pragma unroll
            for (int b = 0; b < 2; ++b)
#pragma unroll
                for (int m = 0; m < 4; ++m)
#pragma unroll
                    for (int n = 0; n < 2; ++n) acc[a][b][m][n] = (f32x4){0.f, 0.f, 0.f, 0.f};
        cur = nxt; cA = nA; cB = nB; ++ui;
    }
    PG8_WAIT_V(0);
    if (wr == 0) PG8_BAR;
    PG8_BAR;
    if constexpr (Epi::AFTER_DRAIN) { E.fused(acc, cur, wr, wc, fr, fq, lds, wid, lane); S.done(cur); }
    PG8_STAMP();
    if (STAMP && wid == 0) { stamps[lane] = lane < nts ? (((unsigned long long)(unsigned)ts_hi << 32) | (unsigned)ts_lo) : 0ull;
        if (lane == 62) stamps[62] = rt_entry; if (lane == 63) stamps[63] = (unsigned long long)wall_clock64(); }
#undef PG8_STAMP
#undef PG8_SA
#undef PG8_SB
#undef PG8_STAGE
#undef PG8_LDA
#undef PG8_LDB
#undef PG8_MMA
#undef PG8_WAIT_V
#undef PG8_WAIT_L
#undef PG8_BAR
#undef PG8_SCHED
}
}
#define LAS __attribute__((address_space(3)))
using pg8::bf16_t; using pg8::bf16x8; using pg8::f32x4; using pg8::u32x4;
typedef float f32x16 __attribute__((ext_vector_type(16)));
typedef float f32x2v __attribute__((ext_vector_type(2)));
typedef __bf16 bf16x2v __attribute__((ext_vector_type(2)));
typedef unsigned u32x2 __attribute__((ext_vector_type(2)));
#define DI __device__ __forceinline__
#define MFMA32(a, b, c) __builtin_amdgcn_mfma_f32_32x32x16_bf16((a), (b), (c), 0, 0, 0)

constexpr int D = 1024, NTP = 16384, NTS = 512, NT = NTP + NTS;
constexpr int NPROJ = 3584, INDIM = 3592, DFF = 4096, PLE = 256;
constexpr float EPS = 1e-6f;
constexpr int NTHREADS = 512;
constexpr int LDS_BYTES = 149008 + 256;
constexpr size_t WS_WIN = 0;
constexpr size_t WS_WOUT = WS_WIN + (size_t)NPROJ * D * 2;
constexpr size_t WS_WUP = WS_WOUT + (size_t)D * D * 2;
constexpr size_t WS_WDN = WS_WUP + (size_t)DFF * D * 2;
constexpr size_t WS_WG = WS_WDN + (size_t)D * DFF * 2;
constexpr size_t WS_WP = WS_WG + (size_t)D * D * 2;
constexpr size_t WS_CTL = WS_WP + (size_t)D * PLE * 2;
constexpr size_t CTL_RS0 = 0, CTL_SS1 = NT, CTL_SS2 = 2 * NT, CTL_SS3 = 3 * NT, CTL_LA = 4 * NT, CTL_BETA = 8 * NT, CTL_GL = 12 * NT, CTL_FLOATS = 12 * NT + 1024;
constexpr size_t WS_PB = WS_CTL + ((CTL_FLOATS * 4 + 4095) / 4096) * 4096;
constexpr size_t WS_A = WS_PB + (size_t)NT * PLE * 2;
constexpr size_t WS_B = WS_A + (size_t)NT * D * 2;
constexpr size_t WS_C = WS_B + (size_t)NT * DFF * 2;
constexpr size_t WS_BAR = WS_C + (size_t)NT * D * 2;
constexpr size_t WS_FLAGS = WS_BAR + 16384;
constexpr size_t WS_PCNT = WS_BAR + 20480;
constexpr size_t WS_PPS = WS_BAR + 32768;
constexpr size_t WS_END = WS_PPS + (size_t)NTS * D * 2;
constexpr size_t OFF_Y = 0, OFF_GCP = 17301504, OFF_GP = 17338368, OFF_SCP = 17862656, OFF_GCS = 17870848, OFF_GS = 18460672, OFF_SCS = 26849280;

struct Ctx {
    const float* x_prompt; const float* x_sample; const float* state_gdn_conv; const float* state_gdn; const float* state_sc_conv; const float* p_prompt; const float* p_sample;
    const float* norm_mix; const float* w_in; const float* w_conv_qkv; const float* a_log; const float* dt_bias; const float* w_gdn_norm; const float* w_conv_sc; const float* w_out;
    const float* norm_mlp; const float* w_up; const float* w_down; const float* norm_ple; const float* w_ple_gate; const float* w_ple_proj; const float* norm_f;
    float* out; unsigned char* ws; int ph_lo, ph_hi;
};

DI unsigned pk2(float lo, float hi) { f32x2v v = {lo, hi}; return __builtin_bit_cast(unsigned, __builtin_convertvector(v, bf16x2v)); }
DI bf16_t f2bf(float f) { return (bf16_t)(pk2(f, 0.f) & 0xffffu); }
DI float bf2f(bf16_t b) { return __uint_as_float((unsigned)b << 16); }
DI float bflo(unsigned u) { return __uint_as_float(u << 16); }
DI float bfhi(unsigned u) { return __uint_as_float(u & 0xffff0000u); }
DI void unpack8(const u32x4 v, float* f) { f[0] = bflo(v.x); f[1] = bfhi(v.x); f[2] = bflo(v.y); f[3] = bfhi(v.y); f[4] = bflo(v.z); f[5] = bfhi(v.z); f[6] = bflo(v.w); f[7] = bfhi(v.w); }
DI u32x4 pack8(const float* f) { u32x4 w; w.x = pk2(f[0], f[1]); w.y = pk2(f[2], f[3]); w.z = pk2(f[4], f[5]); w.w = pk2(f[6], f[7]); return w; }
DI void st16_wt(void* ptr, const u32x4 v) { asm volatile("global_store_dwordx4 %0, %1, off sc0 sc1\n\ts_nop 2" :: "v"(ptr), "v"(v) : "memory"); }
DI int crow(int reg, int h) { return (reg & 3) + 8 * (reg >> 2) + 4 * h; }
DI int swap23(int p) { return (p & ~12) | ((p & 4) << 1) | ((p & 8) >> 1); }
DI bf16x8 pack_step(const f32x16& x, int s) {
    u32x4 p; p.x = pk2(x[8 * s], x[8 * s + 1]); p.y = pk2(x[8 * s + 2], x[8 * s + 3]); p.z = pk2(x[8 * s + 4], x[8 * s + 5]); p.w = pk2(x[8 * s + 6], x[8 * s + 7]);
    return __builtin_bit_cast(bf16x8, p);
}
DI float sigmoidf_(float x) { return __builtin_amdgcn_rcpf(1.0f + __expf(-x)); }
DI float siluf_(float x) { return x * __builtin_amdgcn_rcpf(1.0f + __expf(-x)); }

struct EpiProj {
    static constexpr bool PERM = true, AFTER_DRAIN = false;
    bf16_t* O; int ldc; const float* rs; int wt = 0;
    DI void pre(const pg8::Unit& u, int wr, int fr, float (&rq)[8]) const { const int row0 = u.pm * 256 + wr * 64 + fr;
#pragma unroll
        for (int g = 0; g < 8; ++g) rq[g] = rs ? rs[row0 + (g >> 2) * 128 + (g & 3) * 16] : 1.0f; }
    DI void operator()(const f32x4 (&acc)[2][2][4][2], const pg8::Unit& u, int wr, int wc, int fr, int fq, const float (&rq)[8]) const {
        const int row0 = u.pm * 256 + wr * 64 + fr, col0 = u.pn * 256 + wc * 32 + 8 * fq;
#pragma unroll
        for (int ai = 0; ai < 2; ++ai)
#pragma unroll
            for (int m = 0; m < 4; ++m) { const int row = row0 + ai * 128 + m * 16; const float r = rq[ai * 4 + m]; bf16_t* rowp = O + (size_t)row * ldc + col0;
#pragma unroll
                for (int bj = 0; bj < 2; ++bj) { const f32x4 v0 = acc[ai][bj][m][0] * r, v1 = acc[ai][bj][m][1] * r;
                    u32x4 w; w.x = pk2(v0[0], v0[1]); w.y = pk2(v0[2], v0[3]); w.z = pk2(v1[0], v1[1]); w.w = pk2(v1[2], v1[3]);
                    if (wt) st16_wt(rowp + bj * 128, w); else *(u32x4*)(rowp + bj * 128) = w; } }
    }
};
struct EpiUp {
    static constexpr bool PERM = true, AFTER_DRAIN = false;
    bf16_t* O; const float* ss; int wt = 0;
    DI void pre(const pg8::Unit& u, int wr, int fr, float (&rq)[8]) const { const int row0 = u.pm * 256 + wr * 64 + fr;
#pragma unroll
        for (int g = 0; g < 8; ++g) rq[g] = ss[row0 + (g >> 2) * 128 + (g & 3) * 16]; }
    DI void operator()(const f32x4 (&acc)[2][2][4][2], const pg8::Unit& u, int wr, int wc, int fr, int fq, const float (&rq)[8]) const {
        const int row0 = u.pm * 256 + wr * 64 + fr, col0 = u.pn * 256 + wc * 32 + 8 * fq;
#pragma unroll
        for (int ai = 0; ai < 2; ++ai)
#pragma unroll
            for (int m = 0; m < 4; ++m) { const int row = row0 + ai * 128 + m * 16; const float r = rsqrtf(rq[ai * 4 + m] * (1.0f / 1024.0f) + EPS); bf16_t* rowp = O + (size_t)row * DFF + col0;
#pragma unroll
                for (int bj = 0; bj < 2; ++bj) { f32x4 v0 = acc[ai][bj][m][0] * r, v1 = acc[ai][bj][m][1] * r;
#pragma unroll
                    for (int j = 0; j < 4; ++j) { v0[j] = fmaxf(v0[j], 0.f); v0[j] *= v0[j]; v1[j] = fmaxf(v1[j], 0.f); v1[j] *= v1[j]; }
                    u32x4 w; w.x = pk2(v0[0], v0[1]); w.y = pk2(v0[2], v0[3]); w.z = pk2(v1[0], v1[1]); w.w = pk2(v1[2], v1[3]);
                    if (wt) st16_wt(rowp + bj * 128, w); else *(u32x4*)(rowp + bj * 128) = w; } }
    }
};
template <int MODE> struct EpiRes {
    static constexpr bool PERM = true, AFTER_DRAIN = false;
    const float* xp; const float* xs; bf16_t* XB; bf16_t* XO; float* ssn; const float* ssp; const bf16_t* PP; int wt = 0;
    DI void loadbase(int row, int col0, u32x4 (&b)[4]) const {
        const size_t off = (size_t)row * D + col0;
        if (MODE == 0) { const float* bp = (row < NTP ? xp + off : xs + (off - (size_t)NTP * D));
            b[0] = *(const u32x4*)bp; b[1] = *(const u32x4*)(bp + 4); b[2] = *(const u32x4*)(bp + 128); b[3] = *(const u32x4*)(bp + 132); }
        else { b[0] = *(const u32x4*)(XB + off); b[2] = *(const u32x4*)(XB + off + 128);
            if (MODE == 2) { b[1] = *(const u32x4*)(PP + off); b[3] = *(const u32x4*)(PP + off + 128); } else { b[1] = b[0]; b[3] = b[2]; } }
    }
    DI void pre(const pg8::Unit&, int, int, float (&rqx)[8]) const {
#pragma unroll
        for (int g = 0; g < 8; ++g) rqx[g] = 0.f; }
    DI void operator()(const f32x4 (&acc)[2][2][4][2], const pg8::Unit& u, int wr, int wc, int fr, int fq, const float (&)[8]) const {
        const int row0 = u.pm * 256 + wr * 64 + fr, col0 = u.pn * 256 + wc * 32 + 8 * fq;
        float rq[8];
        if (MODE == 2) {
#pragma unroll
            for (int g = 0; g < 8; ++g) rq[g] = ssp[row0 + (g >> 2) * 128 + (g & 3) * 16]; }
        u32x4 nb[4]; loadbase(row0, col0, nb);
#pragma unroll
        for (int g = 0; g < 8; ++g) { const int ai = g >> 2, m = g & 3; const int row = row0 + ai * 128 + m * 16; const size_t off = (size_t)row * D + col0;
            u32x4 cb[4];
#pragma unroll
            for (int q = 0; q < 4; ++q) cb[q] = nb[q];
            if (g < 7) loadbase(row0 + ((g + 1) >> 2) * 128 + ((g + 1) & 3) * 16, col0, nb);
            float r = 1.f; if (MODE == 2) r = rsqrtf(rq[g] * (1.0f / 1024.0f) + EPS);
            float sq = 0.f;
#pragma unroll
            for (int bj = 0; bj < 2; ++bj) { float v[8];
#pragma unroll
                for (int j = 0; j < 4; ++j) { v[j] = acc[ai][bj][m][0][j]; v[4 + j] = acc[ai][bj][m][1][j]; }
                if (MODE == 2) { float pf[8]; unpack8(cb[2 * bj + 1], pf);
#pragma unroll
                    for (int j = 0; j < 8; ++j) v[j] = sigmoidf_(v[j] * r) * pf[j]; }
                if (MODE == 0) { const f32x4 b0 = __builtin_bit_cast(f32x4, cb[2 * bj]), b1 = __builtin_bit_cast(f32x4, cb[2 * bj + 1]);
#pragma unroll
                    for (int j = 0; j < 4; ++j) { v[j] += b0[j]; v[4 + j] += b1[j]; } }
                else { float bf[8]; unpack8(cb[2 * bj], bf);
#pragma unroll
                    for (int j = 0; j < 8; ++j) v[j] += bf[j]; }
                if (wt) st16_wt((MODE == 2 ? XO : XB) + off + bj * 128, pack8(v)); else *(u32x4*)((MODE == 2 ? XO : XB) + off + bj * 128) = pack8(v);
#pragma unroll
                for (int j = 0; j < 8; ++j) sq += v[j] * v[j]; }
            sq += __shfl_xor(sq, 16); sq += __shfl_xor(sq, 32);
            if (fq == 0) atomicAdd(ssn + row, sq); }
    }
};
struct SubOrder {
    int pm0, nM, nN, G, c;
    DI bool next(int i, pg8::Unit& u) const { const int L = i * G + c; if (c < 0 || L >= nM * nN) return false; u.pm = pm0 + L % nM; u.pn = L / nM; return true; }
    DI void a_ready(const pg8::Unit&) const {}
    DI void done(const pg8::Unit&) const {}
};
constexpr size_t SLAB_OFF = 123000064;
constexpr size_t SLAB_FLOATS = (size_t)NTS * D;
struct EpiSplitK {
    static constexpr bool PERM = true, AFTER_DRAIN = true;
    DI void pre(const pg8::Unit&, int, int, float (&)[8]) const {}
    float* SLAB; int kq; bf16_t* XB; float* ssn; unsigned* cnt;
    DI void fused(f32x4 (&acc)[2][2][4][2], const pg8::Unit& u, int wr, int wc, int fr, int fq, LAS unsigned char* lds, int wid, int lane) const {
        const int row0 = u.pm * 256 + wr * 64 + fr, col0 = u.pn * 256 + wc * 32 + 8 * fq;
        float* mine = SLAB + (size_t)kq * SLAB_FLOATS - (size_t)NTP * D;
#pragma unroll
        for (int ai = 0; ai < 2; ++ai)
#pragma unroll
            for (int m = 0; m < 4; ++m) { float* rowp = mine + (size_t)(row0 + ai * 128 + m * 16) * D + col0;
#pragma unroll
                for (int bj = 0; bj < 2; ++bj) { st16_wt(rowp + bj * 128, __builtin_bit_cast(u32x4, acc[ai][bj][m][0])); st16_wt(rowp + bj * 128 + 4, __builtin_bit_cast(u32x4, acc[ai][bj][m][1])); } }
        asm volatile("s_waitcnt vmcnt(0)" ::: "memory");
        __syncthreads();
        volatile LAS unsigned* flag = (volatile LAS unsigned*)lds;
        if (wid == 0 && lane == 0) { const unsigned t = __hip_atomic_fetch_add(cnt + ((u.pm - 64) * 4 + u.pn) * 32, 1u, __ATOMIC_RELAXED, __HIP_MEMORY_SCOPE_AGENT);
            __builtin_amdgcn_fence(__ATOMIC_ACQUIRE, "agent"); asm volatile("s_waitcnt vmcnt(0)" ::: "memory"); flag[0] = (t == 3u) ? 1u : 0u; }
        __syncthreads();
        if (flag[0] != 0u) {
#pragma unroll
            for (int ai = 0; ai < 2; ++ai)
#pragma unroll
                for (int m = 0; m < 4; ++m) { const int row = row0 + ai * 128 + m * 16; const size_t off = (size_t)row * D + col0; float sq = 0.f;
#pragma unroll
                    for (int bj = 0; bj < 2; ++bj) { float v[8]; unpack8(*(const u32x4*)(XB + off + bj * 128), v);
#pragma unroll
                        for (int q = 0; q < 4; ++q) { const float* sp = SLAB + (size_t)q * SLAB_FLOATS + (off - (size_t)NTP * D) + bj * 128; const f32x4 a0 = *(const f32x4*)sp, a1 = *(const f32x4*)(sp + 4);
#pragma unroll
                            for (int j = 0; j < 4; ++j) { v[j] += a0[j]; v[4 + j] += a1[j]; } }
                        st16_wt(XB + off + bj * 128, pack8(v));
#pragma unroll
                        for (int j = 0; j < 8; ++j) sq += v[j] * v[j]; }
                    sq += __shfl_xor(sq, 16); sq += __shfl_xor(sq, 32);
                    if (fq == 0) atomicAdd(ssn + row, sq); }
        }
    }
};
struct EpiFinal {
    static constexpr bool PERM = true, AFTER_DRAIN = true;
    DI void pre(const pg8::Unit&, int, int, float (&)[8]) const {}
    const bf16_t* XB; const bf16_t* PP; const float* ssp; float* ssn; unsigned* cnt; const float* normf; float* Y;
    DI void fused(f32x4 (&acc)[2][2][4][2], const pg8::Unit& u, int wr, int wc, int fr, int fq, LAS unsigned char* lds, int wid, int lane) const {
        const int row0 = u.pm * 256 + wr * 64 + fr, col0 = u.pn * 256 + wc * 32 + 8 * fq;
        float rq[8];
#pragma unroll
        for (int g = 0; g < 8; ++g) rq[g] = ssp[row0 + (g >> 2) * 128 + (g & 3) * 16];
        u32x4 nb[4];
        { const size_t off = (size_t)row0 * D + col0; nb[0] = *(const u32x4*)(PP + off); nb[1] = *(const u32x4*)(XB + off); nb[2] = *(const u32x4*)(PP + off + 128); nb[3] = *(const u32x4*)(XB + off + 128); }
#pragma unroll
        for (int g = 0; g < 8; ++g) { const int ai = g >> 2, m = g & 3; const int row = row0 + ai * 128 + m * 16;
            u32x4 cb[4];
#pragma unroll
            for (int q = 0; q < 4; ++q) cb[q] = nb[q];
            if (g < 7) { const size_t off = (size_t)(row0 + ((g + 1) >> 2) * 128 + ((g + 1) & 3) * 16) * D + col0;
                nb[0] = *(const u32x4*)(PP + off); nb[1] = *(const u32x4*)(XB + off); nb[2] = *(const u32x4*)(PP + off + 128); nb[3] = *(const u32x4*)(XB + off + 128); }
            const float r = rsqrtf(rq[g] * (1.0f / 1024.0f) + EPS); float sq = 0.f;
#pragma unroll
            for (int bj = 0; bj < 2; ++bj) { float pf[8], bf[8]; unpack8(cb[2 * bj], pf); unpack8(cb[2 * bj + 1], bf);
#pragma unroll
                for (int j = 0; j < 4; ++j) { const float a = sigmoidf_(acc[ai][bj][m][0][j] * r) * pf[j] + bf[j], b = sigmoidf_(acc[ai][bj][m][1][j] * r) * pf[4 + j] + bf[4 + j];
                    acc[ai][bj][m][0][j] = a; acc[ai][bj][m][1][j] = b; sq += a * a + b * b; } }
            sq += __shfl_xor(sq, 16); sq += __shfl_xor(sq, 32);
            if (fq == 0) atomicAdd(ssn + row, sq); }
        asm volatile("s_waitcnt vmcnt(0)" ::: "memory");
        __syncthreads();
        if (mk_tid() == 0) { unsigned* cw = cnt + u.pm * 32; (void)__hip_atomic_fetch_add(cw, 1u, __ATOMIC_RELAXED, __HIP_MEMORY_SCOPE_AGENT);
            unsigned sp = 0u; while (__hip_atomic_load(cw, __ATOMIC_RELAXED, __HIP_MEMORY_SCOPE_AGENT) < 4u) { __builtin_amdgcn_s_sleep(1); if (++sp > (1u << 22)) break; }
            __builtin_amdgcn_fence(__ATOMIC_ACQUIRE, "agent"); asm volatile("s_waitcnt vmcnt(0)" ::: "memory"); }
        __syncthreads();
        float sq8[8]; f32x4 wv[2][2];
#pragma unroll
        for (int g = 0; g < 8; ++g) sq8[g] = __hip_atomic_load(ssn + row0 + (g >> 2) * 128 + (g & 3) * 16, __ATOMIC_RELAXED, __HIP_MEMORY_SCOPE_AGENT);
#pragma unroll
        for (int bj = 0; bj < 2; ++bj) { wv[bj][0] = *(const f32x4*)(normf + col0 + bj * 128); wv[bj][1] = *(const f32x4*)(normf + col0 + bj * 128 + 4); }
#pragma unroll
        for (int ai = 0; ai < 2; ++ai)
#pragma unroll
            for (int m = 0; m < 4; ++m) { const int row = row0 + ai * 128 + m * 16; const size_t off = (size_t)row * D + col0;
                const float rs = rsqrtf(sq8[ai * 4 + m] * (1.0f / 1024.0f) + EPS);
#pragma unroll
                for (int bj = 0; bj < 2; ++bj) { *(f32x4*)(Y + off + bj * 128) = acc[ai][bj][m][0] * rs * wv[bj][0]; *(f32x4*)(Y + off + bj * 128 + 4) = acc[ai][bj][m][1] * rs * wv[bj][1]; } }
    }
};
#define XB_TMO      128
#define XB_XCNT(j)  (256  + 64 * (j))
#define XB_XSUB(j)  (1280 + 64 * (j))
#define XB_XGEN(j)  (2304 + 64 * (j))
#define XB_TOP      3328
#define XB_TOPGEN   3392
#define XCD_BAR_WORDS 3456
#define XB_SPIN_CAP (1u << 18)

__device__ __forceinline__ unsigned xb_ld(unsigned* p)              { return __hip_atomic_load(p, __ATOMIC_RELAXED, __HIP_MEMORY_SCOPE_AGENT); }
__device__ __forceinline__ unsigned xb_add(unsigned* p, unsigned v) { return __hip_atomic_fetch_add(p, v, __ATOMIC_RELAXED, __HIP_MEMORY_SCOPE_AGENT); }
__device__ __forceinline__ unsigned xb_xcc_id() { return (unsigned)__builtin_amdgcn_s_getreg((3 << 11) | 20) & 0xFu; }
#define XB_SPIN(cond, bar) do { unsigned _sp = 0; while (cond) { __builtin_amdgcn_s_sleep(1); \
    if ((++_sp & 255u) == 0u) { if (xb_ld(&(bar)[XB_TMO])) break; if (_sp > XB_SPIN_CAP) { atomicAdd(&(bar)[XB_TMO], 1u); break; } } } } while (0)

struct XcdBarrier {
    unsigned* bar; unsigned x;
    volatile LAS unsigned* st;
};

__device__ __forceinline__ XcdBarrier xcd_barrier_post(unsigned* bar, volatile LAS unsigned* st) {
    XcdBarrier b; b.bar = bar; b.x = xb_xcc_id(); b.st = st;
    if (mk_tid() == 0) (void)xb_add(&bar[XB_XCNT(b.x)], 1u);
    return b;
}
__device__ __forceinline__ void xcd_barrier_complete(unsigned* bar, unsigned x, unsigned& nloc, unsigned& nx) {
    const unsigned G = gridDim.x * gridDim.y * gridDim.z;
    unsigned sum, cnt, mine, sp = 0u;
    for (;;) {
        sum = 0u; cnt = 0u; mine = 0u;
#pragma unroll
        for (unsigned j = 0; j < 16; ++j) { const unsigned c = xb_ld(&bar[XB_XCNT(j)]); sum += c; cnt += (c > 0u) ? 1u : 0u; mine = (j == x) ? c : mine; }
        if (sum == G) break;
        __builtin_amdgcn_s_sleep(1);
        if ((++sp & 255u) == 0u) { if (xb_ld(&bar[XB_TMO])) break; if (sp > XB_SPIN_CAP) { atomicAdd(&bar[XB_TMO], 1u); break; } }
    }
    nloc = mine > 0u ? mine : 1u; nx = cnt > 0u ? cnt : 1u;
}

__device__ __forceinline__ void xcd_barrier(const XcdBarrier& b) {
    asm volatile("s_waitcnt vmcnt(0)" ::: "memory");
    __syncthreads();
    if (mk_tid() == 0) {
        unsigned* bar = b.bar;
        __builtin_amdgcn_s_waitcnt(0);
        unsigned nloc = b.st[0], nx = b.st[1];
        if (nloc == 0u) { xcd_barrier_complete(bar, b.x, nloc, nx); b.st[0] = nloc; b.st[1] = nx; }
        const unsigned old = xb_add(&bar[XB_XSUB(b.x)], 1u);
        const unsigned gen = old / nloc;
        if (old + 1u == (gen + 1u) * nloc) {
            __builtin_amdgcn_fence(__ATOMIC_RELEASE, "agent");
            asm volatile("s_waitcnt vmcnt(0)" ::: "memory");
            const unsigned og = xb_add(&bar[XB_TOP], 1u);
            const unsigned tg = og / nx;
            if (og + 1u == (tg + 1u) * nx) xb_add(&bar[XB_TOPGEN], 1u);
            else XB_SPIN(xb_ld(&bar[XB_TOPGEN]) == tg, bar);
            __builtin_amdgcn_fence(__ATOMIC_ACQUIRE, "agent");
            xb_add(&bar[XB_XGEN(b.x)], 1u);
            asm volatile("s_waitcnt vmcnt(0)" ::: "memory");
        } else {
            XB_SPIN(xb_ld(&bar[XB_XGEN(b.x)]) == gen, bar);
            __builtin_amdgcn_fence(__ATOMIC_ACQUIRE, "agent");
            asm volatile("s_waitcnt vmcnt(0)" ::: "memory");
        }
    }
    __syncthreads();
}
struct TileDesc { const float* W; const float* nrm; bf16_t* Wt; int ldw, K, k0, n0src, n0dst; };
DI TileDesc p0_tile(const Ctx& c, unsigned char* ws, int t) {
    TileDesc d;
    if (t < 896) { const int kt = t / 56, nt = t % 56, n0 = nt * 64; d = TileDesc{c.w_in, c.norm_mix, (bf16_t*)(ws + WS_WIN), INDIM, D, kt * 64, n0 < 1536 ? n0 : n0 + 8, n0}; return d; }
    t -= 896;
    if (t < 256) { d = TileDesc{c.w_out, nullptr, (bf16_t*)(ws + WS_WOUT), D, D, (t / 16) * 64, (t % 16) * 64, (t % 16) * 64}; return d; }
    t -= 256;
    if (t < 1024) { d = TileDesc{c.w_up, c.norm_mlp, (bf16_t*)(ws + WS_WUP), DFF, D, (t / 64) * 64, (t % 64) * 64, (t % 64) * 64}; return d; }
    t -= 1024;
    if (t < 1024) { d = TileDesc{c.w_down, nullptr, (bf16_t*)(ws + WS_WDN), D, DFF, (t / 16) * 64, (t % 16) * 64, (t % 16) * 64}; return d; }
    t -= 1024;
    if (t < 256) { d = TileDesc{c.w_ple_gate, c.norm_ple, (bf16_t*)(ws + WS_WG), D, D, (t / 16) * 64, (t % 16) * 64, (t % 16) * 64}; return d; }
    t -= 256;
    d = TileDesc{c.w_ple_proj, nullptr, (bf16_t*)(ws + WS_WP), D, PLE, (t / 16) * 64, (t % 16) * 64, (t % 16) * 64}; return d;
}
DI void tile_load(const TileDesc& d, float (&v)[8]) {
    const int tid = mk_tid();
#pragma unroll
    for (int i = 0; i < 8; ++i) { const int kk = i * 8 + (tid >> 6), nn = tid & 63; float x = d.W[(size_t)(d.k0 + kk) * d.ldw + d.n0src + nn]; if (d.nrm) x *= d.nrm[d.k0 + kk]; v[i] = x; }
}
DI void tile_store(const TileDesc& d, const float (&v)[8], LAS float* tile) {
    const int tid = mk_tid();
#pragma unroll
    for (int i = 0; i < 8; ++i) { const int kk = i * 8 + (tid >> 6), nn = tid & 63; tile[kk * 65 + nn] = v[i]; }
    __syncthreads();
    { const int nn = tid >> 3, kq = tid & 7; float f[8];
#pragma unroll
      for (int e = 0; e < 8; ++e) f[e] = tile[(kq * 8 + e) * 65 + nn];
      *(u32x4*)(d.Wt + (size_t)(d.n0dst + nn) * d.K + d.k0 + kq * 8) = pack8(f); }
    __syncthreads();
}
DI void p0_phase(const Ctx& c, LAS unsigned char* lds) {
    const int tid = mk_tid(), lane = tid & 63, wid = tid >> 6;
    unsigned char* ws = c.ws;
    float* ctl = (float*)(ws + WS_CTL);
    bf16_t* XB = (bf16_t*)(ws + WS_A); bf16_t* PB = (bf16_t*)(ws + WS_PB);
    LAS float* wab = (LAS float*)lds;
    for (int i = tid; i < 1024 * 8; i += NTHREADS) { const int k = i >> 3, j = i & 7; wab[i] = c.w_in[(size_t)k * INDIM + 1536 + j] * c.norm_mix[k]; }
    __syncthreads();
    float xn[16]; f32x4 x4n[4], p4n;
#pragma unroll
    for (int i = 0; i < 4; ++i) x4n[i] = (f32x4){0.f, 0.f, 0.f, 0.f};
    p4n = (f32x4){0.f, 0.f, 0.f, 0.f};
    { const int row = blockIdx.x * 8 + wid; if (row < NT) { const float* xr = row < NTP ? c.x_prompt + (size_t)row * D : c.x_sample + (size_t)(row - NTP) * D;
        const float* pr0 = row < NTP ? c.p_prompt + (size_t)row * PLE : c.p_sample + (size_t)(row - NTP) * PLE;
#pragma unroll
        for (int i = 0; i < 16; ++i) xn[i] = xr[i * 64 + lane];
#pragma unroll
        for (int i = 0; i < 4; ++i) x4n[i] = *(const f32x4*)(xr + i * 256 + lane * 4);
        p4n = *(const f32x4*)(pr0 + lane * 4); } }
    for (int row = blockIdx.x * 8 + wid; row < NT; row += gridDim.x * 8) {
        const float* xr = row < NTP ? c.x_prompt + (size_t)row * D : c.x_sample + (size_t)(row - NTP) * D;
        const float* pr = row < NTP ? c.p_prompt + (size_t)row * PLE : c.p_sample + (size_t)(row - NTP) * PLE;
        float xc[16]; f32x4 x4c[4]; const f32x4 p4c = p4n;
#pragma unroll
        for (int i = 0; i < 16; ++i) xc[i] = xn[i];
#pragma unroll
        for (int i = 0; i < 4; ++i) x4c[i] = x4n[i];
        { const int rown = row + gridDim.x * 8; if (rown < NT) { const float* xq = rown < NTP ? c.x_prompt + (size_t)rown * D : c.x_sample + (size_t)(rown - NTP) * D;
            const float* pq = rown < NTP ? c.p_prompt + (size_t)rown * PLE : c.p_sample + (size_t)(rown - NTP) * PLE;
#pragma unroll
            for (int i = 0; i < 4; ++i) x4n[i] = *(const f32x4*)(xq + i * 256 + lane * 4);
            p4n = *(const f32x4*)(pq + lane * 4);
#pragma unroll
            for (int i = 0; i < 16; ++i) xn[i] = xq[i * 64 + lane]; } }
        float ss = 0.f, dot[8];
#pragma unroll
        for (int j = 0; j < 8; ++j) dot[j] = 0.f;
#pragma unroll
        for (int i = 0; i < 16; ++i) { const int k = i * 64 + lane; const float xv = xc[i]; ss += xv * xv;
            const f32x4 w0 = *(const LAS f32x4*)(wab + k * 8), w1 = *(const LAS f32x4*)(wab + k * 8 + 4);
            dot[0] += xv * w0[0]; dot[1] += xv * w0[1]; dot[2] += xv * w0[2]; dot[3] += xv * w0[3]; dot[4] += xv * w1[0]; dot[5] += xv * w1[1]; dot[6] += xv * w1[2]; dot[7] += xv * w1[3]; }
#pragma unroll
        for (int o = 32; o >= 1; o >>= 1) { ss += __shfl_xor(ss, o);
#pragma unroll
            for (int j = 0; j < 8; ++j) dot[j] += __shfl_xor(dot[j], o); }
        const float rs = rsqrtf(ss * (1.0f / 1024.0f) + EPS);
#pragma unroll
        for (int i = 0; i < 4; ++i) { const int k0 = i * 256 + lane * 4; const f32x4 v = x4c[i]; u32x2 w; w.x = pk2(v[0], v[1]); w.y = pk2(v[2], v[3]); *(u32x2*)(XB + (size_t)row * D + k0) = w; }
        { const f32x4 v = p4c; u32x2 w; w.x = pk2(v[0], v[1]); w.y = pk2(v[2], v[3]); *(u32x2*)(PB + (size_t)row * PLE + lane * 4) = w; }
        if (lane == 0) { ctl[CTL_RS0 + row] = rs; ctl[CTL_SS1 + row] = 0.f; ctl[CTL_SS2 + row] = 0.f; ctl[CTL_SS3 + row] = 0.f; }
        if (lane < 4) { const float da = lane == 0 ? dot[0] : lane == 1 ? dot[1] : lane == 2 ? dot[2] : dot[3]; const float db = lane == 0 ? dot[4] : lane == 1 ? dot[5] : lane == 2 ? dot[6] : dot[7];
            const float xa = da * rs + c.dt_bias[lane]; const float sp = xa > 20.f ? xa : log1pf(__expf(xa));
            ctl[CTL_LA + (size_t)row * 4 + lane] = -__expf(c.a_log[lane]) * sp; ctl[CTL_BETA + (size_t)row * 4 + lane] = sigmoidf_(db * rs); }
    }
    __syncthreads();
    LAS float* tile = (LAS float*)lds;
    {
        int tl = blockIdx.x; float va[8], vb[8];
        if (tl < 3520) { TileDesc d = p0_tile(c, ws, tl); tile_load(d, va);
            for (;;) {
                const int tn = tl + gridDim.x; TileDesc dn = d;
                if (tn < 3520) { dn = p0_tile(c, ws, tn); tile_load(dn, vb); }
                tile_store(d, va, tile);
                if (tn >= 3520) break;
#pragma unroll
                for (int i = 0; i < 8; ++i) va[i] = vb[i];
                d = dn; tl = tn;
            } }
    }
}

constexpr int L_QH = 0, L_KH = 17408, L_RT = 34816, L_AM = 71680, L_TB = 89088, L_G = 98304, L_WC = 98816, L_SSP = 104960;
DI void prep_chunk(const Ctx& c, LAS unsigned char* lds, int ch) {
    int tid = mk_tid(); asm volatile("" : "+v"(tid));
    const int lane = tid & 63, wid = __builtin_amdgcn_readfirstlane(tid >> 6);
    const int h = ch & 3, n = (ch >> 2) & 31, b = ch >> 7;
    const int row0 = b * 2048 + n * 64;
    float* ctl = (float*)(c.ws + WS_CTL);
    const bf16_t* PROJ = (const bf16_t*)(c.ws + WS_B);
    bf16_t* QP = (bf16_t*)c.out + (size_t)ch * 8192; bf16_t* WP = (bf16_t*)c.out + (size_t)(1024 + ch) * 8192; bf16_t* KTP = (bf16_t*)c.out + (size_t)(2048 + ch) * 8192;
    bf16_t* UT = (bf16_t*)(c.ws + WS_C) + (size_t)ch * 8192; bf16_t* QKP = (bf16_t*)(c.ws + WS_C) + (size_t)1024 * 8192 + (size_t)ch * 4096;
    LAS float* G = (LAS float*)(lds + L_G); LAS float* BT = G + 64;
    LAS float* WC = (LAS float*)(lds + L_WC);
    LAS float* SSP = (LAS float*)(lds + L_SSP);
    for (int i = tid; i < 1536; i += NTHREADS) { const int ten = i >> 9, jj = (i >> 7) & 3, cc = i & 127; WC[i] = c.w_conv_qkv[jj * 1536 + ten * 512 + h * 128 + cc]; }
    if (wid == 0) {
        float la = ctl[CTL_LA + (size_t)(row0 + lane) * 4 + h];
#pragma unroll
        for (int o = 1; o < 64; o <<= 1) { const float t = __int_as_float(__builtin_amdgcn_ds_bpermute(((lane - o) & 63) * 4, __float_as_int(la))); if (lane >= o) la += t; }
        G[lane] = la; BT[lane] = ctl[CTL_BETA + (size_t)(row0 + lane) * 4 + h];
        if (lane == 63) __hip_atomic_store(ctl + CTL_GL + ch, la, __ATOMIC_RELAXED, __HIP_MEMORY_SCOPE_AGENT);
    }
    {
        const int tok = lane, cg8 = wid;
        const int t_abs = n * 64 + tok;
        u32x4 xr[3][4][2];
#pragma unroll
        for (int ten = 0; ten < 3; ++ten)
#pragma unroll
            for (int j = 0; j < 4; ++j) { const int tt = t_abs - 3 + j;
                if (tt >= 0) { const bf16_t* src = PROJ + (size_t)(b * 2048 + tt) * NPROJ + ten * 512 + h * 128 + cg8 * 16; xr[ten][j][0] = *(const u32x4*)src; xr[ten][j][1] = *(const u32x4*)(src + 8); }
                else { xr[ten][j][0] = (u32x4){0u, 0u, 0u, 0u}; xr[ten][j][1] = (u32x4){0u, 0u, 0u, 0u}; } }
        __syncthreads();
        const float g = G[tok], bt = BT[tok];
        const float eg = __expf(g);
        float a[3][16];
#pragma unroll
        for (int ten = 0; ten < 3; ++ten) {
#pragma unroll
            for (int e = 0; e < 16; ++e) a[ten][e] = 0.f;
#pragma unroll
            for (int j = 0; j < 4; ++j) { float x[16]; unpack8(xr[ten][j][0], x); unpack8(xr[ten][j][1], x + 8);
                const LAS float* wj = WC + (ten * 4 + j) * 128 + cg8 * 16;
#pragma unroll
                for (int q = 0; q < 4; ++q) { const f32x4 w = *(const LAS f32x4*)(wj + 4 * q); a[ten][4 * q] += x[4 * q] * w[0]; a[ten][4 * q + 1] += x[4 * q + 1] * w[1]; a[ten][4 * q + 2] += x[4 * q + 2] * w[2]; a[ten][4 * q + 3] += x[4 * q + 3] * w[3]; } }
#pragma unroll
            for (int e = 0; e < 16; ++e) a[ten][e] = siluf_(a[ten][e]);
        }
        { float sq = 0.f, sk = 0.f;
#pragma unroll
          for (int e = 0; e < 16; ++e) { sq += a[0][e] * a[0][e]; sk += a[1][e] * a[1][e]; }
          SSP[cg8 * 64 + tok] = sq; SSP[512 + cg8 * 64 + tok] = sk; }
        __syncthreads();
        { float sq = 0.f, sk = 0.f;
#pragma unroll
          for (int w = 0; w < 8; ++w) { sq += SSP[w * 64 + tok]; sk += SSP[512 + w * 64 + tok]; }
          const float scq = rsqrtf(sq + EPS) * 0.08838834764831845f, sck = rsqrtf(sk + EPS);
#pragma unroll
          for (int e = 0; e < 16; ++e) { a[0][e] *= scq; a[1][e] *= sck; } }
        {
            LAS unsigned char* q = lds + L_QH + tok * 272 + cg8 * 32;
            *(LAS u32x4*)q = pack8(a[0]); *(LAS u32x4*)(q + 16) = pack8(a[0] + 8);
            float p[16];
#pragma unroll
            for (int e = 0; e < 16; ++e) p[swap23(e)] = a[0][e] * eg;
            bf16_t* dst = QP + tok * 128 + cg8 * 16; st16_wt(dst, pack8(p)); st16_wt(dst + 8, pack8(p + 8));
        }
        {
            LAS unsigned char* q = lds + L_KH + tok * 272 + cg8 * 32;
            *(LAS u32x4*)q = pack8(a[1]); *(LAS u32x4*)(q + 16) = pack8(a[1] + 8);
            const float f = bt * eg;
#pragma unroll
            for (int e = 0; e < 16; ++e) *(LAS bf16_t*)(lds + L_RT + (128 + cg8 * 16 + e) * 144 + tok * 2) = f2bf(a[1][e] * f);
        }
#pragma unroll
        for (int e = 0; e < 16; ++e) *(LAS bf16_t*)(lds + L_RT + (cg8 * 16 + e) * 144 + tok * 2) = f2bf(a[2][e] * bt);
    }
    __syncthreads();
    {
        int r = lane & 31, hh = lane >> 5; asm volatile("" : "+v"(r), "+v"(hh));
        const int blk = wid & 3, I = (blk == 1 || blk == 2) ? 1 : 0, J = (blk == 2 || blk == 3) ? 1 : 0; const bool isq = wid >= 4;
        f32x16 x;
#pragma unroll
        for (int i = 0; i < 16; ++i) x[i] = 0.f;
        if (blk != 3) {
            LAS unsigned char* Ab = lds + (isq ? L_QH : L_KH) + (32 * I + r) * 272 + hh * 16; LAS unsigned char* Bb = lds + L_KH + (32 * J + r) * 272 + hh * 16;
#pragma unroll
            for (int s = 0; s < 8; ++s) { const bf16x8 av = *(LAS bf16x8*)(Ab + s * 32), bv = *(LAS bf16x8*)(Bb + s * 32); x = isq ? MFMA32(bv, av, x) : MFMA32(av, bv, x); }
        }
        if (!isq) {
            const int jj = 32 * J + r; const float gj = G[jj];
            if (blk != 3) {
#pragma unroll
                for (int i = 0; i < 16; ++i) { const int ii = 32 * I + crow(i, hh); const float d = __expf(fminf(G[ii] - gj, 0.f)); ((LAS float*)(lds + L_AM))[ii * 68 + jj] = (ii > jj) ? BT[ii] * x[i] * d : 0.f; } }
        } else {
            const int ii = 32 * I + r; const float gi = G[ii]; float f[16];
#pragma unroll
            for (int i = 0; i < 16; ++i) { const int jj = 32 * J + crow(i, hh); const float d = __expf(fminf(gi - G[jj], 0.f)); f[i] = (ii >= jj && blk != 3) ? x[i] * d : 0.f; }
            bf16_t* dst = QKP + ii * 64 + 32 * J; st16_wt(dst + 8 * hh, pack8(f)); st16_wt(dst + 16 + 8 * hh, pack8(f + 8));
        }
    }
    {
        const int dk = tid & 127, tq = tid >> 7; const float glast = G[63]; float f[16];
#pragma unroll
        for (int t = 0; t < 16; ++t) { const int tk = 16 * tq + t; f[swap23(t)] = bf2f(*(LAS bf16_t*)(lds + L_KH + tk * 272 + dk * 2)) * __expf(glast - G[tk]); }
        bf16_t* dst = KTP + dk * 64 + 16 * tq; st16_wt(dst, pack8(f)); st16_wt(dst + 8, pack8(f + 8));
    }
    __syncthreads();
#ifndef NOINV
    if (wid == 0) {
        f32x2v t2[32]; f32x4 ab[2][16]; float lanef = (float)lane; asm volatile("" : "+v"(lanef));
        int zoff; asm volatile("v_mov_b32 %0, 0" : "=v"(zoff));
        LAS float* AM = (LAS float*)(lds + L_AM) + zoff;
        t2[0].x = fmaxf(1.0f - fabsf(lanef), 0.f); t2[0].y = 0.f;
        ab[1][0] = *(LAS f32x4*)(AM + 68);
#pragma unroll
        for (int i = 1; i < 64; ++i) {
            if (i + 1 < 64) {
#pragma unroll
                for (int q = 0; q < (i + 4) / 4; ++q) ab[(i + 1) & 1][q] = *(LAS f32x4*)(AM + (i + 1) * 68 + 4 * q); }
            __builtin_amdgcn_sched_barrier(0);
            f32x2v acc2 = {fmaxf(1.0f - fabsf(lanef - (float)i), 0.f), 0.f};
#pragma unroll
            for (int q = 0; q < (i + 3) / 4; ++q) { const f32x4 av = ab[i & 1][q]; const int j = 4 * q;
                if (j + 1 < i) acc2 -= (f32x2v){av[0], av[1]} * t2[j / 2]; else acc2.x -= av[0] * t2[j / 2].x;
                if (j + 3 < i) acc2 -= (f32x2v){av[2], av[3]} * t2[j / 2 + 1]; else if (j + 2 < i) acc2.x -= av[2] * t2[j / 2 + 1].x; }
            const float ti = acc2.x + acc2.y;
            if (i & 1) t2[i / 2].y = ti; else { t2[i / 2].x = ti; t2[i / 2].y = 0.f; }
            __builtin_amdgcn_sched_barrier(0);
        }
#pragma unroll
        for (int i = 0; i < 32; ++i) { *(LAS bf16_t*)(lds + L_TB + (2 * i) * 144 + lane * 2) = f2bf(t2[i].x); *(LAS bf16_t*)(lds + L_TB + (2 * i + 1) * 144 + lane * 2) = f2bf(t2[i].y); }
    }
#endif
    __syncthreads();
    {
        int r = lane & 31, hh = lane >> 5; asm volatile("" : "+v"(r), "+v"(hh));
#pragma unroll
        for (int tb = 0; tb < 2; ++tb) {
            f32x16 x;
#pragma unroll
            for (int i = 0; i < 16; ++i) x[i] = 0.f;
#pragma unroll
            for (int s = 0; s < 4; ++s) if (s < 2 || tb == 1) {
                const bf16x8 tf = *(LAS bf16x8*)(lds + L_TB + (32 * tb + r) * 144 + (16 * s + 8 * hh) * 2), rf = *(LAS bf16x8*)(lds + L_RT + (32 * wid + r) * 144 + (16 * s + 8 * hh) * 2);
                x = (wid < 4) ? MFMA32(tf, rf, x) : MFMA32(rf, tf, x); }
            float f[16];
#pragma unroll
            for (int i = 0; i < 16; ++i) f[i] = x[i];
            bf16_t* dst = (wid < 4) ? UT + (32 * wid + r) * 64 + 32 * tb : WP + (32 * tb + r) * 128 + 32 * (wid - 4);
            st16_wt(dst + 8 * hh, pack8(f)); st16_wt(dst + 16 + 8 * hh, pack8(f + 8));
        }
    }
    asm volatile("s_waitcnt vmcnt(0)" ::: "memory");
    __syncthreads();
    if (tid == 0) __hip_atomic_store((unsigned*)(c.ws + WS_FLAGS) + ch, 1u, __ATOMIC_RELAXED, __HIP_MEMORY_SCOPE_AGENT);
}

DI void sample_gdn2(const Ctx& c, LAS unsigned char* lds, int pair) {
    const int tid = mk_tid(), lane = tid & 63, half = tid >> 8, ht = tid & 255, hw = (tid >> 6) & 3;
    const int item = pair * 2 + half, b = item >> 2, h = item & 3;
    float* ctl = (float*)(c.ws + WS_CTL);
    const bf16_t* PROJ = (const bf16_t*)(c.ws + WS_B); bf16_t* OY = (bf16_t*)(c.ws + WS_A);
    LAS float* vals = (LAS float*)lds + half * 3072;
    LAS float* red = vals + 1536;
    LAS float* red2 = red + 256;
    LAS float* os = red2 + 256;
    const int row0 = NTP + b * 4;
    for (int i = ht; i < 1536; i += 256) { const int ten = i >> 9, tok = (i >> 7) & 3, ch = i & 127; const int col = ten * 512 + h * 128 + ch; float a = 0.f;
#pragma unroll
        for (int j = 0; j < 4; ++j) { const int idx = tok + j; const float xv = idx < 3 ? c.state_gdn_conv[((size_t)b * 3 + idx) * 1536 + col] : bf2f(PROJ[(size_t)(row0 + idx - 3) * NPROJ + col]); a += xv * c.w_conv_qkv[j * 1536 + col]; }
        vals[i] = siluf_(a); }
    __syncthreads();
#pragma unroll
    for (int rep = 0; rep < 2; ++rep) { const int pr = hw * 2 + rep, ten = pr >> 2, tok = pr & 3; LAS float* v = vals + ten * 512 + tok * 128; const float a0 = v[lane], a1 = v[lane + 64]; float ss = a0 * a0 + a1 * a1;
#pragma unroll
        for (int o = 32; o >= 1; o >>= 1) ss += __shfl_xor(ss, o);
        const float sc = rsqrtf(ss + EPS) * (ten == 0 ? 0.08838834764831845f : 1.0f); v[lane] = a0 * sc; v[lane + 64] = a1 * sc; }
    __syncthreads();
    const int e = ht & 127, part = ht >> 7;
    float s[64];
    const float* S0 = c.state_gdn + ((size_t)item * 128 + part * 64) * 128 + e;
#pragma unroll
    for (int i = 0; i < 64; ++i) s[i] = S0[(size_t)i * 128];
#pragma unroll 1
    for (int t = 0; t < 4; ++t) {
        const float a = __expf(ctl[CTL_LA + (size_t)(row0 + t) * 4 + h]), bt = ctl[CTL_BETA + (size_t)(row0 + t) * 4 + h];
        LAS float* qv = vals + t * 128 + part * 64; LAS float* kv = vals + 512 + t * 128 + part * 64;
        float p = 0.f;
#pragma unroll
        for (int i = 0; i < 64; ++i) { s[i] *= a; p += s[i] * kv[i]; }
        red[part * 128 + e] = p;
        __syncthreads();
        const float rr = bt * (vals[1024 + t * 128 + e] - (red[e] + red[128 + e]));
        float po = 0.f;
#pragma unroll
        for (int i = 0; i < 64; ++i) { s[i] += kv[i] * rr; po += s[i] * qv[i]; }
        red2[part * 128 + e] = po;
        __syncthreads();
        if (part == 0) os[t * 128 + e] = red2[e] + red2[128 + e];
    }
    float* Sout = c.out + OFF_GS + ((size_t)item * 128 + part * 64) * 128 + e;
#pragma unroll
    for (int i = 0; i < 64; ++i) Sout[(size_t)i * 128] = s[i];
    __syncthreads();
#pragma unroll
    for (int rep = 0; rep < 2; ++rep) { const int tok = part * 2 + rep; float ss = 0.f;
        for (int i = 0; i < 128; ++i) { const float v = os[tok * 128 + i]; ss += v * v; }
        const float rs = rsqrtf(ss * (1.0f / 128.0f) + EPS); const int row = row0 + tok;
        const float z = bf2f(PROJ[(size_t)row * NPROJ + 1536 + h * 128 + e]);
        OY[(size_t)row * D + h * 128 + e] = f2bf(os[tok * 128 + e] * rs * c.w_gdn_norm[e] * siluf_(z)); }
    __syncthreads();
}

DI void shortconv_items(const Ctx& c, int item_lo, int item_hi, int bfirst, int bcount) {
    const int tid = mk_tid();
    const bf16_t* PROJ = (const bf16_t*)(c.ws + WS_B); bf16_t* OY = (bf16_t*)(c.ws + WS_A);
    for (int item = item_lo + bfirst * NTHREADS + tid; item < item_hi; item += bcount * NTHREADS) {
        const int row = item >> 6, c8 = (item & 63) * 8;
        const bool prm = row < NTP; const int sb = prm ? (row >> 11) : ((row - NTP) >> 2); const int t = prm ? (row & 2047) : ((row - NTP) & 3); const int T = prm ? 2048 : 4;
        float bv[8]; unpack8(*(const u32x4*)(PROJ + (size_t)row * NPROJ + 2048 + c8), bv);
        float acc[8], cur[8];
#pragma unroll
        for (int e = 0; e < 8; ++e) { acc[e] = 0.f; cur[e] = 0.f; }
#pragma unroll
        for (int d = 0; d < 3; ++d) { const int tt = t - 2 + d; float sc[8];
            if (tt >= 0) { float cv[8], hv[8]; const bf16_t* src = PROJ + (size_t)(row - (2 - d)) * NPROJ + c8; unpack8(*(const u32x4*)(src + 2560), cv); unpack8(*(const u32x4*)(src + 3072), hv);
#pragma unroll
                for (int e = 0; e < 8; ++e) sc[e] = cv[e] * hv[e]; }
            else if (!prm) { const float* sp = c.state_sc_conv + ((size_t)sb * 2 + (2 + tt)) * 512 + c8; const f32x4 s0 = *(const f32x4*)sp, s1 = *(const f32x4*)(sp + 4);
#pragma unroll
                for (int e = 0; e < 4; ++e) { sc[e] = s0[e]; sc[4 + e] = s1[e]; } }
            else {
#pragma unroll
                for (int e = 0; e < 8; ++e) sc[e] = 0.f; }
            const float* wp = c.w_conv_sc + d * 512 + c8; const f32x4 w0 = *(const f32x4*)wp, w1 = *(const f32x4*)(wp + 4);
#pragma unroll
            for (int e = 0; e < 4; ++e) { acc[e] += sc[e] * w0[e]; acc[4 + e] += sc[4 + e] * w1[e]; }
            if (d == 2) {
#pragma unroll
                for (int e = 0; e < 8; ++e) cur[e] = sc[e]; } }
#pragma unroll
        for (int e = 0; e < 8; ++e) acc[e] *= bv[e];
        *(u32x4*)(OY + (size_t)row * D + 512 + c8) = pack8(acc);
        if (t >= T - 2) { float* dst = (prm ? c.out + OFF_SCP : c.out + OFF_SCS) + ((size_t)sb * 2 + (t - (T - 2))) * 512 + c8;
            *(f32x4*)dst = (f32x4){cur[0], cur[1], cur[2], cur[3]}; *(f32x4*)(dst + 4) = (f32x4){cur[4], cur[5], cur[6], cur[7]}; }
    }
}
DI void conv_state_copies(const Ctx& c, int bfirst, int bcount) {
    const int tid = mk_tid();
    const bf16_t* PROJ = (const bf16_t*)(c.ws + WS_B);
    for (int idx = bfirst * NTHREADS + tid; idx < 136 * 4608; idx += bcount * NTHREADS) {
        const int seq = idx / 4608, rem = idx % 4608, j = rem / 1536, col = rem % 1536;
        if (seq < 8) c.out[OFF_GCP + idx] = bf2f(PROJ[(size_t)(seq * 2048 + 2045 + j) * NPROJ + col]);
        else c.out[OFF_GCS + (idx - 8 * 4608)] = bf2f(PROJ[(size_t)(NTP + (seq - 8) * 4 + 1 + j) * NPROJ + col]);
    }
}

constexpr int P3_BUF = 57344, P3_OB = 114688, L_XST = 148480, P3_WN = 148496;
DI void scan_seq(const Ctx& c, LAS unsigned char* lds, int bh) {
    const int tid = mk_tid(), lane = tid & 63, wid = tid >> 6, r = lane & 31, hh = lane >> 5;
    const int b = bh >> 2, h = bh & 3;
    const bool loader = wid >= 4; const int lt = tid & 255;
    const float* ctl = (const float*)(c.ws + WS_CTL);
    const bf16_t* PROJ = (const bf16_t*)(c.ws + WS_B); bf16_t* OY = (bf16_t*)(c.ws + WS_A);
    LAS float* OB = (LAS float*)(lds + P3_OB);
    const int ch0 = b * 128 + h;
    const u32x4* gQ = (const u32x4*)((const bf16_t*)c.out) ; const u32x4* gW = gQ + (size_t)1024 * 1024; const u32x4* gKT = gQ + (size_t)2048 * 1024;
    const u32x4* gQK = (const u32x4*)((const bf16_t*)(c.ws + WS_C) + (size_t)1024 * 8192);
    const bf16_t* gUT = (const bf16_t*)(c.ws + WS_C);
    f32x16 S[4];
#pragma unroll
    for (int kt = 0; kt < 4; ++kt)
#pragma unroll
        for (int i = 0; i < 16; ++i) S[kt][i] = 0.f;
    const int e0 = 32 * (wid & 3);
    u32x4 zr[4]; u32x4 un[4]; float decn = 1.f;
#define P3_DMA(gp, ldsp) __builtin_amdgcn_global_load_lds((const unsigned*)(gp), (LAS unsigned*)(ldsp), 16, 0, 0)
    const int lw = (wid & 3) * 1024;
    int srcA[4], srcB[4];
#pragma unroll
    for (int i = 0; i < 4; ++i) { const int q = lt + 256 * i; const int rowA = q >> 4, rowB = q >> 3; srcA[i] = rowA * 16 + ((q & 15) ^ (rowA & 15)); srcB[i] = rowB * 8 + ((q & 7) ^ ((rowB >> 1) & 7)); }
    const int gtok = lt >> 2, gpart = lt & 3;
    if (tid < 128) ((LAS float*)(lds + P3_WN))[tid] = c.w_gdn_norm[tid];
    unsigned* const flags = (unsigned*)(c.ws + WS_FLAGS);
#define P3_WAIT(chx) do { unsigned sp_ = 0u; while (__hip_atomic_load(flags + (chx), __ATOMIC_RELAXED, __HIP_MEMORY_SCOPE_AGENT) == 0u) { __builtin_amdgcn_s_sleep(2); if (++sp_ > (1u << 22)) break; } __builtin_amdgcn_fence(__ATOMIC_ACQUIRE, "agent"); } while (0)
    P3_WAIT(ch0);
    if (loader) {
        const size_t t0 = (size_t)ch0 * 1024;
#pragma unroll
        for (int i = 0; i < 4; ++i) { P3_DMA(gW + t0 + srcA[i], lds + lw + 4096 * i); P3_DMA(gQ + t0 + srcA[i], lds + 16384 + lw + 4096 * i); P3_DMA(gKT + t0 + srcB[i], lds + 32768 + lw + 4096 * i); }
#pragma unroll
        for (int i = 0; i < 2; ++i) P3_DMA(gQK + (size_t)ch0 * 512 + srcB[i], lds + 49152 + lw + 4096 * i);
        asm volatile("s_waitcnt vmcnt(0)" ::: "memory");
    } else {
        const bf16_t* up = gUT + (size_t)ch0 * 8192 + (e0 + r) * 64 + 8 * hh;
        un[0] = *(const u32x4*)up; un[1] = *(const u32x4*)(up + 16); un[2] = *(const u32x4*)(up + 32); un[3] = *(const u32x4*)(up + 48);
        decn = __expf(__hip_atomic_load(ctl + CTL_GL + ch0, __ATOMIC_RELAXED, __HIP_MEMORY_SCOPE_AGENT));
    }
    const int rw = r & 15, rk = (r >> 1) & 7;
    if (loader) {
#pragma unroll 1
        for (int n = 0; n <= 32; ++n) {
            __syncthreads();
            if (n < 31) { P3_WAIT(ch0 + 4 * (n + 1)); const size_t t1 = (size_t)(ch0 + 4 * (n + 1)) * 1024; LAS unsigned char* Bn = lds + ((n + 1) & 1) * P3_BUF;
#pragma unroll
                for (int i = 0; i < 4; ++i) { P3_DMA(gW + t1 + srcA[i], Bn + lw + 4096 * i); P3_DMA(gQ + t1 + srcA[i], Bn + 16384 + lw + 4096 * i); P3_DMA(gKT + t1 + srcB[i], Bn + 32768 + lw + 4096 * i); }
#pragma unroll
                for (int i = 0; i < 2; ++i) P3_DMA(gQK + (size_t)(ch0 + 4 * (n + 1)) * 512 + srcB[i], Bn + 49152 + lw + 4096 * i); }
            if (n >= 1) {
                const int row = b * 2048 + (n - 1) * 64 + gtok; LAS float* op = OB + gtok * 132 + gpart * 32;
                float o[32]; float ss = 0.f;
#pragma unroll
                for (int q = 0; q < 8; ++q) { const f32x4 v = *(LAS f32x4*)(op + 4 * q); o[4 * q] = v[0]; o[4 * q + 1] = v[1]; o[4 * q + 2] = v[2]; o[4 * q + 3] = v[3]; ss += (v[0] * v[0] + v[1] * v[1]) + (v[2] * v[2] + v[3] * v[3]); }
                ss += __shfl_xor(ss, 1); ss += __shfl_xor(ss, 2);
                const float rs = rsqrtf(ss * (1.0f / 128.0f) + EPS);
                float z[32]; unpack8(zr[0], z); unpack8(zr[1], z + 8); unpack8(zr[2], z + 16); unpack8(zr[3], z + 24);
#pragma unroll
                for (int e = 0; e < 32; ++e) o[e] = o[e] * rs * ((LAS float*)(lds + P3_WN))[gpart * 32 + e] * siluf_(z[e]);
                bf16_t* dst = OY + (size_t)row * D + h * 128 + gpart * 32;
                *(u32x4*)dst = pack8(o); *(u32x4*)(dst + 8) = pack8(o + 8); *(u32x4*)(dst + 16) = pack8(o + 16); *(u32x4*)(dst + 24) = pack8(o + 24);
            }
            __syncthreads();
            asm volatile("s_waitcnt vmcnt(0)" ::: "memory");
            if (n < 32) { const bf16_t* zp = PROJ + (size_t)(b * 2048 + n * 64 + gtok) * NPROJ + 1536 + h * 128 + gpart * 32;
                zr[0] = *(const u32x4*)zp; zr[1] = *(const u32x4*)(zp + 8); zr[2] = *(const u32x4*)(zp + 16); zr[3] = *(const u32x4*)(zp + 24); }
        }
    } else {
#pragma unroll 1
        for (int n = 0; n <= 32; ++n) {
            __syncthreads();
            LAS unsigned char* B = lds + (n & 1) * P3_BUF;
            f32x16 O[2];
            if (n < 32) {
                const f32x16 zero16 = {0.f, 0.f, 0.f, 0.f, 0.f, 0.f, 0.f, 0.f, 0.f, 0.f, 0.f, 0.f, 0.f, 0.f, 0.f, 0.f};
                f32x16 P[2]; P[0] = zero16; P[1] = zero16; O[0] = zero16; O[1] = zero16;
#pragma unroll
                for (int kt = 0; kt < 4; ++kt)
#pragma unroll
                    for (int s = 0; s < 2; ++s) { const bf16x8 sb = pack_step(S[kt], s);
#pragma unroll
                        for (int mi = 0; mi < 2; ++mi) { const int off = ((32 * mi + r) * 16 + ((4 * kt + 2 * s + hh) ^ rw)) * 16;
                            P[mi] = MFMA32(*(LAS bf16x8*)(B + off), sb, P[mi]); O[mi] = MFMA32(*(LAS bf16x8*)(B + 16384 + off), sb, O[mi]); } }
                bf16x8 vb[2][2];
#pragma unroll
                for (int tb = 0; tb < 2; ++tb) { float u[16]; unpack8(un[2 * tb], u); unpack8(un[2 * tb + 1], u + 8);
                    f32x16 vn;
#pragma unroll
                    for (int i = 0; i < 16; ++i) vn[i] = u[i] - P[tb][i];
                    vb[tb][0] = pack_step(vn, 0); vb[tb][1] = pack_step(vn, 1); }
                const float dec = decn;
                if (n < 31) { P3_WAIT(ch0 + 4 * (n + 1)); const bf16_t* up = gUT + (size_t)(ch0 + 4 * (n + 1)) * 8192 + (e0 + r) * 64 + 8 * hh;
                    un[0] = *(const u32x4*)up; un[1] = *(const u32x4*)(up + 16); un[2] = *(const u32x4*)(up + 32); un[3] = *(const u32x4*)(up + 48);
                    decn = __expf(__hip_atomic_load(ctl + CTL_GL + ch0 + 4 * (n + 1), __ATOMIC_RELAXED, __HIP_MEMORY_SCOPE_AGENT)); }
#pragma unroll
                for (int mi = 0; mi < 2; ++mi)
#pragma unroll
                    for (int tb = 0; tb <= mi; ++tb)
#pragma unroll
                        for (int s = 0; s < 2; ++s) O[mi] = MFMA32(*(LAS bf16x8*)(B + 49152 + ((32 * mi + r) * 8 + ((4 * tb + 2 * s + hh) ^ rk)) * 16), vb[tb][s], O[mi]);
#pragma unroll
                for (int kt = 0; kt < 4; ++kt) { S[kt] *= dec;
#pragma unroll
                    for (int tb = 0; tb < 2; ++tb)
#pragma unroll
                        for (int s = 0; s < 2; ++s) S[kt] = MFMA32(*(LAS bf16x8*)(B + 32768 + ((32 * kt + r) * 8 + ((4 * tb + 2 * s + hh) ^ rk)) * 16), vb[tb][s], S[kt]); }
            }
            __syncthreads();
            if (n < 32) {
#pragma unroll
                for (int mi = 0; mi < 2; ++mi)
#pragma unroll
                    for (int i = 0; i < 16; ++i) OB[(32 * mi + crow(i, hh)) * 132 + e0 + r] = O[mi][i];
            }
        }
    }
    if (!loader) { float* So = c.out + OFF_GP + (size_t)bh * 16384;
#pragma unroll
        for (int kt = 0; kt < 4; ++kt)
#pragma unroll
            for (int i = 0; i < 16; ++i) So[(32 * kt + crow(i, hh)) * 128 + e0 + r] = S[kt][i]; }
    __syncthreads();
}

DI void sub_barrier(unsigned* cnt, unsigned target, bool release = true) {
    asm volatile("s_waitcnt vmcnt(0)" ::: "memory");
    __syncthreads();
    if (mk_tid() == 0) {
        if (release) { __builtin_amdgcn_fence(__ATOMIC_RELEASE, "agent"); asm volatile("s_waitcnt vmcnt(0)" ::: "memory"); }
        (void)xb_add(cnt, 1u);
        unsigned sp = 0u; while (xb_ld(cnt) < target) { __builtin_amdgcn_s_sleep(1); if (++sp > (1u << 22)) break; }
        __builtin_amdgcn_fence(__ATOMIC_ACQUIRE, "agent");
        asm volatile("s_waitcnt vmcnt(0)" ::: "memory");
    }
    __syncthreads();
}

__global__ void __launch_bounds__(NTHREADS, 2) mega(Ctx c) {
    extern __shared__ __attribute__((aligned(16))) unsigned char shm[];
    LAS unsigned char* lds = (LAS unsigned char*)shm;
    { const unsigned t0 = threadIdx.x; if ((t0 & 63u) == 0u) ((LAS unsigned*)(lds + L_WTAB))[mk_slot()] = t0 >> 6; }
    __syncthreads();
    unsigned char* ws = c.ws; float* ctl = (float*)(ws + WS_CTL);
    const int lo = c.ph_lo, hi = c.ph_hi;
    if (hi > 1000) cg::this_grid().sync();
    volatile LAS unsigned* xst = (volatile LAS unsigned*)(lds + L_XST);
    if (mk_tid() < 4) xst[mk_tid()] = 0u;
    __syncthreads();
    XcdBarrier bar = xcd_barrier_post((unsigned*)(ws + WS_BAR), xst);
#ifdef ONLY
#define IN(k) ((k) == ONLY)
#else
#define IN(k) (lo <= (k) && (k) < hi)
#endif
#define SEAM(k) do { if (IN(k) && IN((k) + 1)) xcd_barrier(bar); } while (0)
    if (IN(0)) p0_phase(c, lds);
    SEAM(0);
    if (IN(1)) { pg8::Gemm g{(const bf16_t*)(ws + WS_A), (const bf16_t*)(ws + WS_WIN), NT, NPROJ, D, 0}; pg8::StaticOrder S; S.init(NT, NPROJ, gridDim.x, blockIdx.x);
        EpiProj E{(bf16_t*)(ws + WS_B), NPROJ, ctl + CTL_RS0}; pg8::gemm_phase<EpiProj, pg8::StaticOrder, false>(lds, g, S, E, nullptr); }
    SEAM(1);
    if (IN(3)) {
        unsigned* const chw = (unsigned*)(ws + WS_BAR) + 96;
        if (blockIdx.x < 32 || blockIdx.x >= 64) {
            const int q = blockIdx.x < 32 ? (int)blockIdx.x : (int)blockIdx.x - 32, nq = (int)gridDim.x - 32;
            for (int it = q; it < 256; it += nq) sample_gdn2(c, lds, it);
            shortconv_items(c, NTP * 64, NT * 64, q, nq);
            asm volatile("s_waitcnt vmcnt(0)" ::: "memory");
            __syncthreads();
            if (mk_tid() == 0) { __builtin_amdgcn_fence(__ATOMIC_RELEASE, "agent"); asm volatile("s_waitcnt vmcnt(0)" ::: "memory"); (void)xb_add(chw, 1u); }
        }
        if (blockIdx.x < 32) { scan_seq(c, lds, blockIdx.x); const int nq = (int)gridDim.x - 32, q = nq - 32 + (int)blockIdx.x; shortconv_items(c, 0, NTP * 64, q, nq); conv_state_copies(c, q, nq); }
        else if (blockIdx.x < 64) {
            if (mk_tid() == 0) { unsigned sp = 0u; while (xb_ld(chw) < gridDim.x - 32u) { __builtin_amdgcn_s_sleep(2); if (++sp > (1u << 22)) break; } __builtin_amdgcn_fence(__ATOMIC_ACQUIRE, "agent"); asm volatile("s_waitcnt vmcnt(0)" ::: "memory"); }
            __syncthreads();
            const int j = blockIdx.x - 32; unsigned* sc = (unsigned*)(ws + WS_BAR) + 64;
            { pg8::Gemm g{(const bf16_t*)(ws + WS_A), (const bf16_t*)(ws + WS_WOUT), NT, D, D, 0}; SubOrder S{64, 2, 4, 8, j < 8 ? j : -1};
              EpiRes<0> E{c.x_prompt, c.x_sample, (bf16_t*)(ws + WS_C), nullptr, ctl + CTL_SS1, nullptr, nullptr, 1}; pg8::gemm_phase<EpiRes<0>, SubOrder, false>(lds, g, S, E, nullptr); }
            { pg8::Gemm g{(const bf16_t*)(ws + WS_PB), (const bf16_t*)(ws + WS_WP), NT, D, PLE, 0}; SubOrder S{64, 2, 4, 8, (j >= 8 && j < 16) ? j - 8 : -1};
              EpiProj E{(bf16_t*)(ws + WS_PPS) - (size_t)NTP * D, D, nullptr, 1}; pg8::gemm_phase<EpiProj, SubOrder, false>(lds, g, S, E, nullptr); }
            sub_barrier(sc, 32u, false);
            { pg8::Gemm g{(const bf16_t*)(ws + WS_C), (const bf16_t*)(ws + WS_WUP), NT, DFF, D, 0}; SubOrder S{64, 2, 16, 32, j};
              EpiUp E{(bf16_t*)(ws + WS_B), ctl + CTL_SS1, 1}; pg8::gemm_phase<EpiUp, SubOrder, false>(lds, g, S, E, nullptr); }
            sub_barrier(sc, 64u, false);
            { const int kq = j >> 3; pg8::Gemm g{(const bf16_t*)(ws + WS_B) + kq * 1024, (const bf16_t*)(ws + WS_WDN) + kq * 1024, NT, D, 1024, DFF}; SubOrder S{64, 2, 4, 8, j & 7};
              EpiSplitK E{(float*)(ws + WS_B + SLAB_OFF), kq, (bf16_t*)(ws + WS_C), ctl + CTL_SS2, (unsigned*)(ws + WS_PCNT) + 66 * 32}; pg8::gemm_phase<EpiSplitK, SubOrder, false>(lds, g, S, E, nullptr); }
            sub_barrier(sc, 96u, false);
            { pg8::Gemm g{(const bf16_t*)(ws + WS_C), (const bf16_t*)(ws + WS_WG), NT, D, D, 0}; SubOrder S{64, 2, 4, 8, j < 8 ? j : -1};
              EpiFinal E{(const bf16_t*)(ws + WS_C), (const bf16_t*)(ws + WS_PPS) - (size_t)NTP * D, ctl + CTL_SS2, ctl + CTL_SS3, (unsigned*)(ws + WS_PCNT), c.norm_f, c.out}; pg8::gemm_phase<EpiFinal, SubOrder, false>(lds, g, S, E, nullptr); }
        }
        else { const int q = (int)blockIdx.x - 64, nq = (int)gridDim.x - 64;
            for (int i = q; i < 1024; i += nq) { const int n = i >> 5, bh = i & 31; prep_chunk(c, lds, ((bh >> 2) * 32 + n) * 4 + (bh & 3)); }
            shortconv_items(c, 0, NTP * 64, q, nq + 32);
            conv_state_copies(c, q, nq + 32); }
    }
    SEAM(3);
    if (IN(4)) { pg8::Gemm g{(const bf16_t*)(ws + WS_A), (const bf16_t*)(ws + WS_WOUT), NT, D, D, 0}; pg8::StaticOrder S; S.init(NTP, D, gridDim.x, blockIdx.x);
        EpiRes<0> E{c.x_prompt, c.x_sample, (bf16_t*)(ws + WS_C), nullptr, ctl + CTL_SS1, nullptr, nullptr}; pg8::gemm_phase<EpiRes<0>, pg8::StaticOrder, false>(lds, g, S, E, nullptr); }
    SEAM(4);
    if (IN(5)) { pg8::Gemm g{(const bf16_t*)(ws + WS_C), (const bf16_t*)(ws + WS_WUP), NT, DFF, D, 0}; pg8::StaticOrder S; S.init(NTP, DFF, gridDim.x, blockIdx.x);
        EpiUp E{(bf16_t*)(ws + WS_B), ctl + CTL_SS1}; pg8::gemm_phase<EpiUp, pg8::StaticOrder, false>(lds, g, S, E, nullptr); }
    SEAM(5);
    if (IN(6)) {
        { pg8::Gemm g{(const bf16_t*)(ws + WS_B), (const bf16_t*)(ws + WS_WDN), NT, D, DFF, 0}; pg8::StaticOrder S; S.init(NTP, D, gridDim.x, blockIdx.x);
          EpiRes<1> E{nullptr, nullptr, (bf16_t*)(ws + WS_C), nullptr, ctl + CTL_SS2, nullptr, nullptr}; pg8::gemm_phase<EpiRes<1>, pg8::StaticOrder, false>(lds, g, S, E, nullptr); }
        { pg8::Gemm g{(const bf16_t*)(ws + WS_PB), (const bf16_t*)(ws + WS_WP), NT, D, PLE, 0}; pg8::StaticOrder S; S.init(NTP, D, gridDim.x, blockIdx.x);
          EpiProj E{(bf16_t*)(ws + WS_A), D, nullptr}; pg8::gemm_phase<EpiProj, pg8::StaticOrder, false>(lds, g, S, E, nullptr); }
    }
    SEAM(6);
    if (IN(7)) { pg8::Gemm g{(const bf16_t*)(ws + WS_C), (const bf16_t*)(ws + WS_WG), NT, D, D, 0}; pg8::StaticOrder S; S.init(NTP, D, gridDim.x, blockIdx.x);
        EpiFinal E{(const bf16_t*)(ws + WS_C), (const bf16_t*)(ws + WS_A), ctl + CTL_SS2, ctl + CTL_SS3, (unsigned*)(ws + WS_PCNT), c.norm_f, c.out}; pg8::gemm_phase<EpiFinal, pg8::StaticOrder, false>(lds, g, S, E, nullptr); }
#undef IN
#undef SEAM
}

#ifndef N_LAUNCH_MODE
#define N_LAUNCH_MODE 1
#endif
extern "C" void kernel_launch(void* const* d_in, const int* in_sizes, int n_in, void* d_out, int out_size, void* d_ws, size_t ws_size, hipStream_t stream) {
    static int grid = 0;
    if (grid == 0) {
        int dev = 0, cus = 0, per_cu = 0;
        if (ws_size < WS_END) { fprintf(stderr, "kernel_launch: workspace too small: %zu < %zu\n", ws_size, (size_t)WS_END); grid = -1; return; }
        hipGetDevice(&dev); hipDeviceGetAttribute(&cus, hipDeviceAttributeMultiprocessorCount, dev);
        if (hipFuncSetAttribute((const void*)mega, hipFuncAttributeMaxDynamicSharedMemorySize, LDS_BYTES) != hipSuccess) { fprintf(stderr, "kernel_launch: hipFuncSetAttribute failed\n"); grid = -1; return; }
        if (hipOccupancyMaxActiveBlocksPerMultiprocessor(&per_cu, (const void*)mega, NTHREADS, LDS_BYTES) != hipSuccess || per_cu < 1) { fprintf(stderr, "kernel_launch: occupancy query says %d\n", per_cu); per_cu = 1; }
        (void)hipGetLastError();
        grid = cus * 1;
    }
    if (grid < 0) return;
    (void)hipMemsetAsync((unsigned char*)d_ws + WS_BAR, 0, 32768, stream);
    Ctx a{};
    const float** ap = (const float**)&a;
    for (int i = 0; i < 22; ++i) ap[i] = (const float*)d_in[i];
    a.out = (float*)d_out; a.ws = (unsigned char*)d_ws;
#if N_LAUNCH_MODE == 1
    a.ph_lo = 0; a.ph_hi = 8;
    void* args[] = {&a};
    hipError_t e = hipLaunchCooperativeKernel((const void*)mega, dim3(grid), dim3(NTHREADS), args, LDS_BYTES, stream);
    if (e != hipSuccess) fprintf(stderr, "cooperative launch failed: %s (grid %d)\n", hipGetErrorString(e), grid);
#else
    for (int ph = 0; ph < 8; ++ph) { a.ph_lo = ph; a.ph_hi = ph + 1; hipLaunchKernelGGL(mega, dim3(grid), dim3(NTHREADS), LDS_BYTES, stream, a); }
#endif
}
```

```cpp
#include <hip/hip_runtime.h>
#include <hip/hip_cooperative_groups.h>
#include <cstdio>
namespace cg = cooperative_groups;

constexpr int L_WTAB = 149008;
static __device__ __forceinline__ unsigned mk_lane() { return __builtin_amdgcn_mbcnt_hi(~0u, __builtin_amdgcn_mbcnt_lo(~0u, 0u)); }
static __device__ __forceinline__ unsigned mk_slot() { return (unsigned)__builtin_amdgcn_s_getreg(0x2804) & 63u; }
static __device__ __forceinline__ unsigned mk_tid() {
    extern __shared__ __attribute__((aligned(16))) unsigned char mk_shm[];
    const unsigned w = ((__attribute__((address_space(3))) unsigned*)((__attribute__((address_space(3))) unsigned char*)mk_shm + L_WTAB))[mk_slot()];
    return (unsigned)__builtin_amdgcn_readfirstlane((int)w) * 64u + mk_lane();
}
namespace pg8 {
#define PG8_LAS __attribute__((address_space(3)))
typedef unsigned short bf16_t;
typedef short bf16x8 __attribute__((ext_vector_type(8)));
typedef float f32x4 __attribute__((ext_vector_type(4)));
typedef unsigned u32x4 __attribute__((ext_vector_type(4)));
constexpr int BM = 256, BK = 64, HALF = 128, HTB = HALF * BK * 2  , STAGE_BYTES = 8 * HTB, NXCD = 8, WGM = 8;

__host__ __device__ __forceinline__ int lds_byte(int r, int c) { const int st = (r >> 4) * 2 + (c >> 5), rr = r & 15, cc = c & 31, ob = rr * 64 + cc * 2; return st * 1024 + (ob ^ (((ob >> 9) & 1) << 5)); }
__host__ __device__ __forceinline__ void stage_rc(int b, int& R, int& C) { const int st = b / 1024, sb = b % 1024, swz = sb ^ (((sb >> 9) & 1) << 5); R = (st >> 1) * 16 + swz / 64; C = (st & 1) * 32 + (swz % 64) / 2; }
__host__ __device__ __forceinline__ int perm32(int rho) { const int n = rho >> 4, i = rho & 15; return 8 * (i >> 2) + 4 * n + (i & 3); }

struct Unit { int pm, pn; };
struct Gemm { const bf16_t* A; const bf16_t* Bt; int M, N, K; int ld; };

struct StaticOrder {
    int nM, nN, nwg, G, c;
    __host__ __device__ void init(int M, int N, int G_, int c_) { nM = M / BM; nN = N / BM; nwg = nM * nN; G = G_; c = c_; }
    __host__ __device__ bool next(int i, Unit& u) const {
        const long L = (long)i * G + c; if (L >= nwg) return false;
        int wgid = (int)L; { const int q = nwg / NXCD, r = nwg % NXCD, xcd = wgid % NXCD, off = wgid / NXCD; wgid = (xcd < r ? xcd * (q + 1) : r * (q + 1) + (xcd - r) * q) + off; }
        const int nig = WGM * nN, gid = wgid / nig, fm = gid * WGM, gsz = (nM - fm) < WGM ? (nM - fm) : WGM;
        u.pm = fm + ((wgid % nig) % gsz); u.pn = (wgid % nig) / gsz; return true;
    }
    __device__ __forceinline__ void a_ready(const Unit&) const {}
    __device__ __forceinline__ void done(const Unit&) const {}
};
template <class Epi, class Sched, bool STAMP = false>
__device__ __forceinline__ void gemm_phase(PG8_LAS unsigned char* lds, const Gemm g, const Sched& S, const Epi& E, unsigned long long* stamps) {
    int tid = mk_tid(); asm volatile("" : "+v"(tid));
    const int wid = __builtin_amdgcn_readfirstlane(tid >> 6), lane = tid & 63, wr = wid >> 2, wc = wid & 3, fr = lane & 15, fq = lane >> 4;
    const int K = g.K, nt = K / BK, LD = g.ld ? g.ld : g.K;
    int ts_lo = 0, ts_hi = 0, nts = 0; const unsigned long long rt_entry = STAMP ? (unsigned long long)wall_clock64() : 0ull;
#define PG8_STAMP() do { if (STAMP && wid == 0 && nts < 64) { const unsigned long long _c = (unsigned long long)clock64(); \
        ts_lo = (lane == nts) ? (int)(unsigned)_c : ts_lo; ts_hi = (lane == nts) ? (int)(unsigned)(_c >> 32) : ts_hi; ++nts; } } while (0)
    PG8_STAMP();
    unsigned voffA[2], voffB[2];
#pragma unroll
    for (int i = 0; i < 2; ++i) { int R, C; stage_rc(tid * 16 + i * 8192, R, C); const int Rb = Epi::PERM ? ((R & ~31) + perm32(R & 31)) : R;
        voffA[i] = (unsigned)(R * LD + C) * 2u; voffB[i] = (unsigned)(Rb * LD + C) * 2u; }
    const size_t kstep = (size_t)(BK * 2);
    const size_t hstep = (size_t)HALF * LD * 2;
    const size_t tstep = 2 * hstep;
    const unsigned ldsw = (unsigned)wid * 1024u;
    const int aoff = lds_byte(wr * 64 + fr, fq * 8), boff = lds_byte(wc * 32 + fr, fq * 8);
#define PG8_SA(b, h) (((b) * 2 + (h)) * HTB)
#define PG8_SB(b, h) ((4 + (b) * 2 + (h)) * HTB)
#define PG8_STAGE(bufoff, gbase, voff) do { _Pragma("unroll") for (int _i = 0; _i < 2; ++_i) \
        __builtin_amdgcn_global_load_lds((const unsigned*)((const char*)(gbase) + (voff)[_i]), (PG8_LAS unsigned*)(lds + (bufoff) + ldsw + _i * 8192), 16, 0, 0); } while (0)
#define PG8_LDA(dst, b, h) do { _Pragma("unroll") for (int m = 0; m < 4; ++m) _Pragma("unroll") for (int k = 0; k < 2; ++k) dst[m][k] = *(const PG8_LAS bf16x8*)(lds + PG8_SA(b, h) + aoff + m * 2048 + k * 1024); } while (0)
#define PG8_LDB(dst, b, h) do { _Pragma("unroll") for (int n = 0; n < 2; ++n) _Pragma("unroll") for (int k = 0; k < 2; ++k) dst[n][k] = *(const PG8_LAS bf16x8*)(lds + PG8_SB(b, h) + boff + n * 2048 + k * 1024); } while (0)
#define PG8_MMA(ai, bj, At, Bt) do { __builtin_amdgcn_s_setprio(1); _Pragma("unroll") for (int m = 0; m < 4; ++m) _Pragma("unroll") for (int n = 0; n < 2; ++n) _Pragma("unroll") for (int k = 0; k < 2; ++k) \
        acc[ai][bj][m][n] = __builtin_amdgcn_mfma_f32_16x16x32_bf16(Bt[n][k], At[m][k], acc[ai][bj][m][n], 0, 0, 0); __builtin_amdgcn_s_setprio(0); } while (0)
#define PG8_WAIT_V(n) asm volatile("s_waitcnt vmcnt(" #n ")" ::: "memory")
#define PG8_WAIT_L(n) asm volatile("s_waitcnt lgkmcnt(" #n ")" ::: "memory")
#define PG8_BAR __builtin_amdgcn_s_barrier()
#define PG8_SCHED __builtin_amdgcn_sched_barrier(0)
    Unit cur, nxt; int ui = 0;
    if (!S.next(0, cur)) return;
    f32x4 acc[2][2][4][2];
#pragma unroll
    for (int a = 0; a < 2; ++a)
#pragma unroll
        for (int b = 0; b < 2; ++b)
#pragma unroll
            for (int m = 0; m < 4; ++m)
#pragma unroll
                for (int n = 0; n < 2; ++n) acc[a][b][m][n] = (f32x4){0.f, 0.f, 0.f, 0.f};
    bf16x8 At[4][2], B0[2][2], B1[2][2];
    const char* cA = (const char*)g.A + (size_t)cur.pm * tstep; const char* cB = (const char*)g.Bt + (size_t)cur.pn * tstep;
    S.a_ready(cur);
    PG8_STAGE(PG8_SB(0, 0), cB, voffB); PG8_STAGE(PG8_SA(0, 0), cA, voffA); PG8_STAGE(PG8_SB(0, 1), cB + hstep, voffB); PG8_STAGE(PG8_SA(0, 1), cA + hstep, voffA);
    if (wr == 1) PG8_BAR;
    PG8_WAIT_V(4); PG8_BAR;
    PG8_STAGE(PG8_SB(1, 0), cB + kstep, voffB); PG8_STAGE(PG8_SA(1, 0), cA + kstep, voffA); PG8_STAGE(PG8_SB(1, 1), cB + hstep + kstep, voffB);
    PG8_WAIT_V(6); PG8_BAR;
    PG8_STAMP();
    for (;;) {
        float rqv[8]; E.pre(cur, wr, fr, rqv);
        const bool has_next = S.next(ui + 1, nxt);
        const char* nA = has_next ? (const char*)g.A + (size_t)nxt.pm * tstep : cA; const char* nB = has_next ? (const char*)g.Bt + (size_t)nxt.pn * tstep : cB;
        for (int t = 0; t < nt; t += 2) {
            const bool last = (t == nt - 2);
            const char* a1 = cA + (size_t)(t + 1) * kstep;
            const char* a2 = last ? nA : cA + (size_t)(t + 2) * kstep; const char* b2 = last ? nB : cB + (size_t)(t + 2) * kstep;
            const char* a3 = a2 + kstep; const char* b3 = b2 + kstep;
            if (last && has_next) S.a_ready(nxt);
            PG8_LDB(B0, 0, 0); PG8_SCHED; PG8_LDA(At, 0, 0); PG8_STAGE(PG8_SA(1, 1), a1 + hstep, voffA);
            PG8_WAIT_L(8); PG8_BAR; PG8_WAIT_L(0); PG8_MMA(0, 0, At, B0); PG8_BAR; PG8_SCHED;
            PG8_LDB(B1, 0, 1); PG8_STAGE(PG8_SB(0, 0), b2, voffB);
            PG8_BAR; PG8_WAIT_L(0); PG8_MMA(0, 1, At, B1); PG8_BAR;
            PG8_LDA(At, 0, 1); PG8_STAGE(PG8_SA(0, 0), a2, voffA);
            PG8_BAR; PG8_WAIT_L(0); PG8_MMA(1, 0, At, B0); PG8_BAR; PG8_SCHED;
            PG8_STAGE(PG8_SB(0, 1), b2 + hstep, voffB);
            PG8_WAIT_V(6); PG8_BAR; PG8_MMA(1, 1, At, B1); PG8_BAR;
            PG8_LDB(B0, 1, 0); PG8_SCHED; PG8_LDA(At, 1, 0); PG8_STAGE(PG8_SA(0, 1), a2 + hstep, voffA);
            PG8_WAIT_L(8); PG8_BAR; PG8_WAIT_L(0); PG8_MMA(0, 0, At, B0); PG8_BAR; PG8_SCHED;
            PG8_LDB(B1, 1, 1); PG8_STAGE(PG8_SB(1, 0), b3, voffB);
            PG8_BAR; PG8_WAIT_L(0); PG8_MMA(0, 1, At, B1); PG8_BAR;
            PG8_LDA(At, 1, 1); PG8_STAGE(PG8_SA(1, 0), a3, voffA);
            PG8_BAR; PG8_WAIT_L(0); PG8_MMA(1, 0, At, B0); PG8_BAR; PG8_SCHED;
            PG8_STAGE(PG8_SB(1, 1), b3 + hstep, voffB);
            PG8_WAIT_V(6); PG8_BAR; PG8_MMA(1, 1, At, B1); PG8_BAR;
        }
        PG8_STAMP();
        if constexpr (!Epi::AFTER_DRAIN) { E(acc, cur, wr, wc, fr, fq, rqv); S.done(cur); }
        PG8_STAMP();
        if (!has_next) break;
#pragma unroll
        for (int a = 0; a < 2; ++a)
#pragma unroll
            for (int b = 0; b < 2; ++b)
#pragma unroll
                for (int m = 0; m < 4; ++m)
#pragma unroll
                    for (int n = 0; n < 2; ++n) acc[a][b][m][n] = (f32x4){0.f, 0.f, 0.f, 0.f};
        cur = nxt; cA = nA; cB = nB; ++ui;
    }
    PG8_WAIT_V(0);
    if (wr == 0) PG8_BAR;
    PG8_BAR;
    if constexpr (Epi::AFTER_DRAIN) { E.fused(acc, cur, wr, wc, fr, fq, lds, wid, lane); S.done(cur); }
    PG8_STAMP();
    if (STAMP && wid == 0) { stamps[lane] = lane < nts ? (((unsigned long long)(unsigned)ts_hi << 32) | (unsigned)ts_lo) : 0ull;
        if (lane == 62) stamps[62] = rt_entry; if (lane == 63) stamps[63] = (unsigned long long)wall_clock64(); }
#undef PG8_STAMP
#undef PG8_SA
#undef PG8_SB
#undef PG8_STAGE
#undef PG8_LDA
#undef PG8_LDB
#undef PG8_MMA
#undef PG8_WAIT_V
#undef PG8_WAIT_L
#undef PG8_BAR
#undef PG8_SCHED
}
}
#define LAS __attribute__((address_space(3)))
using pg8::bf16_t; using pg8::bf16x8; using pg8::f32x4; using pg8::u32x4;
typedef float f32x16 __attribute__((ext_vector_type(16)));
typedef float f32x2v __attribute__((ext_vector_type(2)));
typedef __bf16 bf16x2v __attribute__((ext_vector_type(2)));
typedef unsigned u32x2 __attribute__((ext_vector_type(2)));
#define DI __device__ __forceinline__
#define MFMA32(a, b, c) __builtin_amdgcn_mfma_f32_32x32x16_bf16((a), (b), (c), 0, 0, 0)

constexpr int D = 1024, NTP = 16384, NTS = 512, NT = NTP + NTS;
constexpr int NPROJ = 3584, INDIM = 3592, DFF = 4096, PLE = 256;
constexpr float EPS = 1e-6f;
constexpr int NTHREADS = 512;
constexpr int LDS_BYTES = 149008 + 256;
constexpr size_t WS_WIN = 0;
constexpr size_t WS_WOUT = WS_WIN + (size_t)NPROJ * D * 2;
constexpr size_t WS_WUP = WS_WOUT + (size_t)D * D * 2;
constexpr size_t WS_WDN = WS_WUP + (size_t)DFF * D * 2;
constexpr size_t WS_WG = WS_WDN + (size_t)D * DFF * 2;
constexpr size_t WS_WP = WS_WG + (size_t)D * D * 2;
constexpr size_t WS_CTL = WS_WP + (size_t)D * PLE * 2;
constexpr size_t CTL_RS0 = 0, CTL_SS1 = NT, CTL_SS2 = 2 * NT, CTL_SS3 = 3 * NT, CTL_LA = 4 * NT, CTL_BETA = 8 * NT, CTL_GL = 12 * NT, CTL_FLOATS = 12 * NT + 1024;
constexpr size_t WS_PB = WS_CTL + ((CTL_FLOATS * 4 + 4095) / 4096) * 4096;
constexpr size_t WS_A = WS_PB + (size_t)NT * PLE * 2;
constexpr size_t WS_B = WS_A + (size_t)NT * D * 2;
constexpr size_t WS_C = WS_B + (size_t)NT * DFF * 2;
constexpr size_t WS_BAR = WS_C + (size_t)NT * D * 2;
constexpr size_t WS_FLAGS = WS_BAR + 16384;
constexpr size_t WS_PCNT = WS_BAR + 20480;
constexpr size_t WS_PPS = WS_BAR + 32768;
constexpr size_t WS_END = WS_PPS + (size_t)NTS * D * 2;
constexpr size_t OFF_Y = 0, OFF_GCP = 17301504, OFF_GP = 17338368, OFF_SCP = 17862656, OFF_GCS = 17870848, OFF_GS = 18460672, OFF_SCS = 26849280;

struct Ctx {
    const float* x_prompt; const float* x_sample; const float* state_gdn_conv; const float* state_gdn; const float* state_sc_conv; const float* p_prompt; const float* p_sample;
    const float* norm_mix; const float* w_in; const float* w_conv_qkv; const float* a_log; const float* dt_bias; const float* w_gdn_norm; const float* w_conv_sc; const float* w_out;
    const float* norm_mlp; const float* w_up; const float* w_down; const float* norm_ple; const float* w_ple_gate; const float* w_ple_proj; const float* norm_f;
    float* out; unsigned char* ws; int ph_lo, ph_hi;
};

DI unsigned pk2(float lo, float hi) { f32x2v v = {lo, hi}; return __builtin_bit_cast(unsigned, __builtin_convertvector(v, bf16x2v)); }
DI bf16_t f2bf(float f) { return (bf16_t)(pk2(f, 0.f) & 0xffffu); }
DI float bf2f(bf16_t b) { return __uint_as_float((unsigned)b << 16); }
DI float bflo(unsigned u) { return __uint_as_float(u << 16); }
DI float bfhi(unsigned u) { return __uint_as_float(u & 0xffff0000u); }
DI void unpack8(const u32x4 v, float* f) { f[0] = bflo(v.x); f[1] = bfhi(v.x); f[2] = bflo(v.y); f[3] = bfhi(v.y); f[4] = bflo(v.z); f[5] = bfhi(v.z); f[6] = bflo(v.w); f[7] = bfhi(v.w); }
DI u32x4 pack8(const float* f) { u32x4 w; w.x = pk2(f[0], f[1]); w.y = pk2(f[2], f[3]); w.z = pk2(f[4], f[5]); w.w = pk2(f[6], f[7]); return w; }
DI void st16_wt(void* ptr, const u32x4 v) { asm volatile("global_store_dwordx4 %0, %1, off sc0 sc1\n\ts_nop 2" :: "v"(ptr), "v"(v) : "memory"); }
DI int crow(int reg, int h) { return (reg & 3) + 8 * (reg >> 2) + 4 * h; }
DI int swap23(int p) { return (p & ~12) | ((p & 4) << 1) | ((p & 8) >> 1); }
DI bf16x8 pack_step(const f32x16& x, int s) {
    u32x4 p; p.x = pk2(x[8 * s], x[8 * s + 1]); p.y = pk2(x[8 * s + 2], x[8 * s + 3]); p.z = pk2(x[8 * s + 4], x[8 * s + 5]); p.w = pk2(x[8 * s + 6], x[8 * s + 7]);
    return __builtin_bit_cast(bf16x8, p);
}
DI float sigmoidf_(float x) { return __builtin_amdgcn_rcpf(1.0f + __expf(-x)); }
DI float siluf_(float x) { return x * __builtin_amdgcn_rcpf(1.0f + __expf(-x)); }

struct EpiProj {
    static constexpr bool PERM = true, AFTER_DRAIN = false;
    bf16_t* O; int ldc; const float* rs; int wt = 0;
    DI void pre(const pg8::Unit& u, int wr, int fr, float (&rq)[8]) const { const int row0 = u.pm * 256 + wr * 64 + fr;
#pragma unroll
        for (int g = 0; g < 8; ++g) rq[g] = rs ? rs[row0 + (g >> 2) * 128 + (g & 3) * 16] : 1.0f; }
    DI void operator()(const f32x4 (&acc)[2][2][4][2], const pg8::Unit& u, int wr, int wc, int fr, int fq, const float (&rq)[8]) const {
        const int row0 = u.pm * 256 + wr * 64 + fr, col0 = u.pn * 256 + wc * 32 + 8 * fq;
#pragma unroll
        for (int ai = 0; ai < 2; ++ai)
#pragma unroll
            for (int m = 0; m < 4; ++m) { const int row = row0 + ai * 128 + m * 16; const float r = rq[ai * 4 + m]; bf16_t* rowp = O + (size_t)row * ldc + col0;
#pragma unroll
                for (int bj = 0; bj < 2; ++bj) { const f32x4 v0 = acc[ai][bj][m][0] * r, v1 = acc[ai][bj][m][1] * r;
                    u32x4 w; w.x = pk2(v0[0], v0[1]); w.y = pk2(v0[2], v0[3]); w.z = pk2(v1[0], v1[1]); w.w = pk2(v1[2], v1[3]);
                    if (wt) st16_wt(rowp + bj * 128, w); else *(u32x4*)(rowp + bj * 128) = w; } }
    }
};
struct EpiUp {
    static constexpr bool PERM = true, AFTER_DRAIN = false;
    bf16_t* O; const float* ss; int wt = 0;
    DI void pre(const pg8::Unit& u, int wr, int fr, float (&rq)[8]) const { const int row0 = u.pm * 256 + wr * 64 + fr;
#pragma unroll
        for (int g = 0; g < 8; ++g) rq[g] = ss[row0 + (g >> 2) * 128 + (g & 3) * 16]; }
    DI void operator()(const f32x4 (&acc)[2][2][4][2], const pg8::Unit& u, int wr, int wc, int fr, int fq, const float (&rq)[8]) const {
        const int row0 = u.pm * 256 + wr * 64 + fr, col0 = u.pn * 256 + wc * 32 + 8 * fq;
#pragma unroll
        for (int ai = 0; ai < 2; ++ai)
#pragma unroll
            for (int m = 0; m < 4; ++m) { const int row = row0 + ai * 128 + m * 16; const float r = rsqrtf(rq[ai * 4 + m] * (1.0f / 1024.0f) + EPS); bf16_t* rowp = O + (size_t)row * DFF + col0;
#pragma unroll
                for (int bj = 0; bj < 2; ++bj) { f32x4 v0 = acc[ai][bj][m][0] * r, v1 = acc[ai][bj][m][1] * r;
#pragma unroll
                    for (int j = 0; j < 4; ++j) { v0[j] = fmaxf(v0[j], 0.f); v0[j] *= v0[j]; v1[j] = fmaxf(v1[j], 0.f); v1[j] *= v1[j]; }
                    u32x4 w; w.x = pk2(v0[0], v0[1]); w.y = pk2(v0[2], v0[3]); w.z = pk2(v1[0], v1[1]); w.w = pk2(v1[2], v1[3]);
                    if (wt) st16_wt(rowp + bj * 128, w); else *(u32x4*)(rowp + bj * 128) = w; } }
    }
};
template <int MODE> struct EpiRes {
    static constexpr bool PERM = true, AFTER_DRAIN = false;
    const float* xp; const float* xs; bf16_t* XB; bf16_t* XO; float* ssn; const float* ssp; const bf16_t* PP; int wt = 0;
    DI void loadbase(int row, int col0, u32x4 (&b)[4]) const {
        const size_t off = (size_t)row * D + col0;
        if (MODE == 0) { const float* bp = (row < NTP ? xp + off : xs + (off - (size_t)NTP * D));
            b[0] = *(const u32x4*)bp; b[1] = *(const u32x4*)(bp + 4); b[2] = *(const u32x4*)(bp + 128); b[3] = *(const u32x4*)(bp + 132); }
        else { b[0] = *(const u32x4*)(XB + off); b[2] = *(const u32x4*)(XB + off + 128);
            if (MODE == 2) { b[1] = *(const u32x4*)(PP + off); b[3] = *(const u32x4*)(PP + off + 128); } else { b[1] = b[0]; b[3] = b[2]; } }
    }
    DI void pre(const pg8::Unit&, int, int, float (&rqx)[8]) const {
#pragma unroll
        for (int g = 0; g < 8; ++g) rqx[g] = 0.f; }
    DI void operator()(const f32x4 (&acc)[2][2][4][2], const pg8::Unit& u, int wr, int wc, int fr, int fq, const float (&)[8]) const {
        const int row0 = u.pm * 256 + wr * 64 + fr, col0 = u.pn * 256 + wc * 32 + 8 * fq;
        float rq[8];
        if (MODE == 2) {
#pragma unroll
            for (int g = 0; g < 8; ++g) rq[g] = ssp[row0 + (g >> 2) * 128 + (g & 3) * 16]; }
        u32x4 nb[4]; loadbase(row0, col0, nb);
#pragma unroll
        for (int g = 0; g < 8; ++g) { const int ai = g >> 2, m = g & 3; const int row = row0 + ai * 128 + m * 16; const size_t off = (size_t)row * D + col0;
            u32x4 cb[4];
#pragma unroll
            for (int q = 0; q < 4; ++q) cb[q] = nb[q];
            if (g < 7) loadbase(row0 + ((g + 1) >> 2) * 128 + ((g + 1) & 3) * 16, col0, nb);
            float r = 1.f; if (MODE == 2) r = rsqrtf(rq[g] * (1.0f / 1024.0f) + EPS);
            float sq = 0.f;
#pragma unroll
            for (int bj = 0; bj < 2; ++bj) { float v[8];
#pragma unroll
                for (int j = 0; j < 4; ++j) { v[j] = acc[ai][bj][m][0][j]; v[4 + j] = acc[ai][bj][m][1][j]; }
                if (MODE == 2) { float pf[8]; unpack8(cb[2 * bj + 1], pf);
#pragma unroll
                    for (int j = 0; j < 8; ++j) v[j] = sigmoidf_(v[j] * r) * pf[j]; }
                if (MODE == 0) { const f32x4 b0 = __builtin_bit_cast(f32x4, cb[2 * bj]), b1 = __builtin_bit_cast(f32x4, cb[2 * bj + 1]);
#pragma unroll
                    for (int j = 0; j < 4; ++j) { v[j] += b0[j]; v[4 + j] += b1[j]; } }
                else { float bf[8]; unpack8(cb[2 * bj], bf);
#pragma unroll
                    for (int j = 0; j < 8; ++j) v[j] += bf[j]; }
                if (wt) st16_wt((MODE == 2 ? XO : XB) + off + bj * 128, pack8(v)); else *(u32x4*)((MODE == 2 ? XO : XB) + off + bj * 128) = pack8(v);
#pragma unroll
                for (int j = 0; j < 8; ++j) sq += v[j] * v[j]; }
            sq += __shfl_xor(sq, 16); sq += __shfl_xor(sq, 32);
            if (fq == 0) atomicAdd(ssn + row, sq); }
    }
};
struct SubOrder {
    int pm0, nM, nN, G, c;
    DI bool next(int i, pg8::Unit& u) const { const int L = i * G + c; if (c < 0 || L >= nM * nN) return false; u.pm = pm0 + L % nM; u.pn = L / nM; return true; }
    DI void a_ready(const pg8::Unit&) const {}
    DI void done(const pg8::Unit&) const {}
};
constexpr size_t SLAB_OFF = 123000064;
constexpr size_t SLAB_FLOATS = (size_t)NTS * D;
struct EpiSplitK {
    static constexpr bool PERM = true, AFTER_DRAIN = true;
    DI void pre(const pg8::Unit&, int, int, float (&)[8]) const {}
    float* SLAB; int kq; bf16_t* XB; float* ssn; unsigned* cnt;
    DI void fused(f32x4 (&acc)[2][2][4][2], const pg8::Unit& u, int wr, int wc, int fr, int fq, LAS unsigned char* lds, int wid, int lane) const {
        const int row0 = u.pm * 256 + wr * 64 + fr, col0 = u.pn * 256 + wc * 32 + 8 * fq;
        float* mine = SLAB + (size_t)kq * SLAB_FLOATS - (size_t)NTP * D;
#pragma unroll
        for (int ai = 0; ai < 2; ++ai)
#pragma unroll
            for (int m = 0; m < 4; ++m) { float* rowp = mine + (size_t)(row0 + ai * 128 + m * 16) * D + col0;
#pragma unroll
                for (int bj = 0; bj < 2; ++bj) { st16_wt(rowp + bj * 128, __builtin_bit_cast(u32x4, acc[ai][bj][m][0])); st16_wt(rowp + bj * 128 + 4, __builtin_bit_cast(u32x4, acc[ai][bj][m][1])); } }
        asm volatile("s_waitcnt vmcnt(0)" ::: "memory");
        __syncthreads();
        volatile LAS unsigned* flag = (volatile LAS unsigned*)lds;
        if (wid == 0 && lane == 0) { const unsigned t = __hip_atomic_fetch_add(cnt + ((u.pm - 64) * 4 + u.pn) * 32, 1u, __ATOMIC_RELAXED, __HIP_MEMORY_SCOPE_AGENT);
            __builtin_amdgcn_fence(__ATOMIC_ACQUIRE, "agent"); asm volatile("s_waitcnt vmcnt(0)" ::: "memory"); flag[0] = (t == 3u) ? 1u : 0u; }
        __syncthreads();
        if (flag[0] != 0u) {
#pragma unroll
            for (int ai = 0; ai < 2; ++ai)
#pragma unroll
                for (int m = 0; m < 4; ++m) { const int row = row0 + ai * 128 + m * 16; const size_t off = (size_t)row * D + col0; float sq = 0.f;
#pragma unroll
                    for (int bj = 0; bj < 2; ++bj) { float v[8]; unpack8(*(const u32x4*)(XB + off + bj * 128), v);
#pragma unroll
                        for (int q = 0; q < 4; ++q) { const float* sp = SLAB + (size_t)q * SLAB_FLOATS + (off - (size_t)NTP * D) + bj * 128; const f32x4 a0 = *(const f32x4*)sp, a1 = *(const f32x4*)(sp + 4);
#pragma unroll
                            for (int j = 0; j < 4; ++j) { v[j] += a0[j]; v[4 + j] += a1[j]; } }
                        st16_wt(XB + off + bj * 128, pack8(v));
#pragma unroll
                        for (int j = 0; j < 8; ++j) sq += v[j] * v[j]; }
                    sq += __shfl_xor(sq, 16); sq += __shfl_xor(sq, 32);
                    if (fq == 0) atomicAdd(ssn + row, sq); }
        }
    }
};
struct EpiFinal {
    static constexpr bool PERM = true, AFTER_DRAIN = true;
    DI void pre(const pg8::Unit&, int, int, float (&)[8]) const {}
    const bf16_t* XB; const bf16_t* PP; const float* ssp; float* ssn; unsigned* cnt; const float* normf; float* Y;
    DI void fused(f32x4 (&acc)[2][2][4][2], const pg8::Unit& u, int wr, int wc, int fr, int fq, LAS unsigned char* lds, int wid, int lane) const {
        const int row0 = u.pm * 256 + wr * 64 + fr, col0 = u.pn * 256 + wc * 32 + 8 * fq;
        float rq[8];
#pragma unroll
        for (int g = 0; g < 8; ++g) rq[g] = ssp[row0 + (g >> 2) * 128 + (g & 3) * 16];
        u32x4 nb[4];
        { const size_t off = (size_t)row0 * D + col0; nb[0] = *(const u32x4*)(PP + off); nb[1] = *(const u32x4*)(XB + off); nb[2] = *(const u32x4*)(PP + off + 128); nb[3] = *(const u32x4*)(XB + off + 128); }
#pragma unroll
        for (int g = 0; g < 8; ++g) { const int ai = g >> 2, m = g & 3; const int row = row0 + ai * 128 + m * 16;
            u32x4 cb[4];
#pragma unroll
            for (int q = 0; q < 4; ++q) cb[q] = nb[q];
            if (g < 7) { const size_t off = (size_t)(row0 + ((g + 1) >> 2) * 128 + ((g + 1) & 3) * 16) * D + col0;
                nb[0] = *(const u32x4*)(PP + off); nb[1] = *(const u32x4*)(XB + off); nb[2] = *(const u32x4*)(PP + off + 128); nb[3] = *(const u32x4*)(XB + off + 128); }
            const float r = rsqrtf(rq[g] * (1.0f / 1024.0f) + EPS); float sq = 0.f;
#pragma unroll
            for (int bj = 0; bj < 2; ++bj) { float pf[8], bf[8]; unpack8(cb[2 * bj], pf); unpack8(cb[2 * bj + 1], bf);
#pragma unroll
                for (int j = 0; j < 4; ++j) { const float a = sigmoidf_(acc[ai][bj][m][0][j] * r) * pf[j] + bf[j], b = sigmoidf_(acc[ai][bj][m][1][j] * r) * pf[4 + j] + bf[4 + j];
                    acc[ai][bj][m][0][j] = a; acc[ai][bj][m][1][j] = b; sq += a * a + b * b; } }
            sq += __shfl_xor(sq, 16); sq += __shfl_xor(sq, 32);
            if (fq == 0) atomicAdd(ssn + row, sq); }
        asm volatile("s_waitcnt vmcnt(0)" ::: "memory");
        __syncthreads();
        if (mk_tid() == 0) { unsigned* cw = cnt + u.pm * 32; (void)__hip_atomic_fetch_add(cw, 1u, __ATOMIC_RELAXED, __HIP_MEMORY_SCOPE_AGENT);
            unsigned sp = 0u; while (__hip_atomic_load(cw, __ATOMIC_RELAXED, __HIP_MEMORY_SCOPE_AGENT) < 4u) { __builtin_amdgcn_s_sleep(1); if (++sp > (1u << 22)) break; }
            __builtin_amdgcn_fence(__ATOMIC_ACQUIRE, "agent"); asm volatile("s_waitcnt vmcnt(0)" ::: "memory"); }
        __syncthreads();
        float sq8[8]; f32x4 wv[2][2];
#pragma unroll
        for (int g = 0; g < 8; ++g) sq8[g] = __hip_atomic_load(ssn + row0 + (g >> 2) * 128 + (g & 3) * 16, __ATOMIC_RELAXED, __HIP_MEMORY_SCOPE_AGENT);
#pragma unroll
        for (int bj = 0; bj < 2; ++bj) { wv[bj][0] = *(const f32x4*)(normf + col0 + bj * 128); wv[bj][1] = *(const f32x4*)(normf + col0 + bj * 128 + 4); }
#pragma unroll
        for (int ai = 0; ai < 2; ++ai)
#pragma unroll
            for (int m = 0; m < 4; ++m) { const int row = row0 + ai * 128 + m * 16; const size_t off = (size_t)row * D + col0;
                const float rs = rsqrtf(sq8[ai * 4 + m] * (1.0f / 1024.0f) + EPS);
#pragma unroll
                for (int bj = 0; bj < 2; ++bj) { *(f32x4*)(Y + off + bj * 128) = acc[ai][bj][m][0] * rs * wv[bj][0]; *(f32x4*)(Y + off + bj * 128 + 4) = acc[ai][bj][m][1] * rs * wv[bj][1]; } }
    }
};
#define XB_TMO      128
#define XB_XCNT(j)  (256  + 64 * (j))
#define XB_XSUB(j)  (1280 + 64 * (j))
#define XB_XGEN(j)  (2304 + 64 * (j))
#define XB_TOP      3328
#define XB_TOPGEN   3392
#define XCD_BAR_WORDS 3456
#define XB_SPIN_CAP (1u << 18)

__device__ __forceinline__ unsigned xb_ld(unsigned* p)              { return __hip_atomic_load(p, __ATOMIC_RELAXED, __HIP_MEMORY_SCOPE_AGENT); }
__device__ __forceinline__ unsigned xb_add(unsigned* p, unsigned v) { return __hip_atomic_fetch_add(p, v, __ATOMIC_RELAXED, __HIP_MEMORY_SCOPE_AGENT); }
__device__ __forceinline__ unsigned xb_xcc_id() { return (unsigned)__builtin_amdgcn_s_getreg((3 << 11) | 20) & 0xFu; }
#define XB_SPIN(cond, bar) do { unsigned _sp = 0; while (cond) { __builtin_amdgcn_s_sleep(1); \
    if ((++_sp & 255u) == 0u) { if (xb_ld(&(bar)[XB_TMO])) break; if (_sp > XB_SPIN_CAP) { atomicAdd(&(bar)[XB_TMO], 1u); break; } } } } while (0)

struct XcdBarrier {
    unsigned* bar; unsigned x;
    volatile LAS unsigned* st;
};

__device__ __forceinline__ XcdBarrier xcd_barrier_post(unsigned* bar, volatile LAS unsigned* st) {
    XcdBarrier b; b.bar = bar; b.x = xb_xcc_id(); b.st = st;
    if (mk_tid() == 0) (void)xb_add(&bar[XB_XCNT(b.x)], 1u);
    return b;
}
__device__ __forceinline__ void xcd_barrier_complete(unsigned* bar, unsigned x, unsigned& nloc, unsigned& nx) {
    const unsigned G = gridDim.x * gridDim.y * gridDim.z;
    unsigned sum, cnt, mine, sp = 0u;
    for (;;) {
        sum = 0u; cnt = 0u; mine = 0u;
#pragma unroll
        for (unsigned j = 0; j < 16; ++j) { const unsigned c = xb_ld(&bar[XB_XCNT(j)]); sum += c; cnt += (c > 0u) ? 1u : 0u; mine = (j == x) ? c : mine; }
        if (sum == G) break;
        __builtin_amdgcn_s_sleep(1);
        if ((++sp & 255u) == 0u) { if (xb_ld(&bar[XB_TMO])) break; if (sp > XB_SPIN_CAP) { atomicAdd(&bar[XB_TMO], 1u); break; } }
    }
    nloc = mine > 0u ? mine : 1u; nx = cnt > 0u ? cnt : 1u;
}

__device__ __forceinline__ void xcd_barrier(const XcdBarrier& b) {
    asm volatile("s_waitcnt vmcnt(0)" ::: "memory");
    __syncthreads();
    if (mk_tid() == 0) {
        unsigned* bar = b.bar;
        __builtin_amdgcn_s_waitcnt(0);
        unsigned nloc = b.st[0], nx = b.st[1];
        if (nloc == 0u) { xcd_barrier_complete(bar, b.x, nloc, nx); b.st[0] = nloc; b.st[1] = nx; }
        const unsigned old = xb_add(&bar[XB_XSUB(b.x)], 1u);
        const unsigned gen = old / nloc;
        if (old + 1u == (gen + 1u) * nloc) {
            __builtin_amdgcn_fence(__ATOMIC_RELEASE, "agent");
            asm volatile("s_waitcnt vmcnt(0)" ::: "memory");
            const unsigned og = xb_add(&bar[XB_TOP], 1u);
            const unsigned tg = og / nx;
            if (og + 1u == (tg + 1u) * nx) xb_add(&bar[XB_TOPGEN], 1u);
            else XB_SPIN(xb_ld(&bar[XB_TOPGEN]) == tg, bar);
            __builtin_amdgcn_fence(__ATOMIC_ACQUIRE, "agent");
            xb_add(&bar[XB_XGEN(b.x)], 1u);
            asm volatile("s_waitcnt vmcnt(0)" ::: "memory");
        } else {
            XB_SPIN(xb_ld(&bar[XB_XGEN(b.x)]) == gen, bar);
            __builtin_amdgcn_fence(__ATOMIC_ACQUIRE, "agent");
            asm volatile("s_waitcnt vmcnt(0)" ::: "memory");
        }
    }
    __syncthreads();
}
struct TileDesc { const float* W; const float* nrm; bf16_t* Wt; int ldw, K, k0, n0src, n0dst; };
DI TileDesc p0_tile(const Ctx& c, unsigned char* ws, int t) {
    TileDesc d;
    if (t < 896) { const int kt = t / 56, nt = t % 56, n0 = nt * 64; d = TileDesc{c.w_in, c.norm_mix, (bf16_t*)(ws + WS_WIN), INDIM, D, kt * 64, n0 < 1536 ? n0 : n0 + 8, n0}; return d; }
    t -= 896;
    if (t < 256) { d = TileDesc{c.w_out, nullptr, (bf16_t*)(ws + WS_WOUT), D, D, (t / 16) * 64, (t % 16) * 64, (t % 16) * 64}; return d; }
    t -= 256;
    if (t < 1024) { d = TileDesc{c.w_up, c.norm_mlp, (bf16_t*)(ws + WS_WUP), DFF, D, (t / 64) * 64, (t % 64) * 64, (t % 64) * 64}; return d; }
    t -= 1024;
    if (t < 1024) { d = TileDesc{c.w_down, nullptr, (bf16_t*)(ws + WS_WDN), D, DFF, (t / 16) * 64, (t % 16) * 64, (t % 16) * 64}; return d; }
    t -= 1024;
    if (t < 256) { d = TileDesc{c.w_ple_gate, c.norm_ple, (bf16_t*)(ws + WS_WG), D, D, (t / 16) * 64, (t % 16) * 64, (t % 16) * 64}; return d; }
    t -= 256;
    d = TileDesc{c.w_ple_proj, nullptr, (bf16_t*)(ws + WS_WP), D, PLE, (t / 16) * 64, (t % 16) * 64, (t % 16) * 64}; return d;
}
DI void tile_load(const TileDesc& d, float (&v)[8]) {
    const int tid = mk_tid();
#pragma unroll
    for (int i = 0; i < 8; ++i) { const int kk = i * 8 + (tid >> 6), nn = tid & 63; float x = d.W[(size_t)(d.k0 + kk) * d.ldw + d.n0src + nn]; if (d.nrm) x *= d.nrm[d.k0 + kk]; v[i] = x; }
}
DI void tile_store(const TileDesc& d, const float (&v)[8], LAS float* tile) {
    const int tid = mk_tid();
#pragma unroll
    for (int i = 0; i < 8; ++i) { const int kk = i * 8 + (tid >> 6), nn = tid & 63; tile[kk * 65 + nn] = v[i]; }
    __syncthreads();
    { const int nn = tid >> 3, kq = tid & 7; float f[8];
#pragma unroll
      for (int e = 0; e < 8; ++e) f[e] = tile[(kq * 8 + e) * 65 + nn];
      *(u32x4*)(d.Wt + (size_t)(d.n0dst + nn) * d.K + d.k0 + kq * 8) = pack8(f); }
    __syncthreads();
}
constexpr int P0_TILES = 2520;
DI void tiles_range(const Ctx& c, unsigned char* ws, LAS float* tile, int first, int stride, int hi) {
    int tl = first; float va[8], vb[8];
    if (tl < hi) { TileDesc d = p0_tile(c, ws, tl); tile_load(d, va);
        for (;;) {
            const int tn = tl + stride; TileDesc dn = d;
            if (tn < hi) { dn = p0_tile(c, ws, tn); tile_load(dn, vb); }
            tile_store(d, va, tile);
            if (tn >= hi) break;
#pragma unroll
            for (int i = 0; i < 8; ++i) va[i] = vb[i];
            d = dn; tl = tn;
        } }
}
DI void p0_phase(const Ctx& c, LAS unsigned char* lds) {
    const int tid = mk_tid(), lane = tid & 63, wid = tid >> 6;
    unsigned char* ws = c.ws;
    float* ctl = (float*)(ws + WS_CTL);
    bf16_t* XB = (bf16_t*)(ws + WS_A); bf16_t* PB = (bf16_t*)(ws + WS_PB);
    LAS float* wab = (LAS float*)lds;
    for (int i = tid; i < 1024 * 8; i += NTHREADS) { const int k = i >> 3, j = i & 7; wab[i] = c.w_in[(size_t)k * INDIM + 1536 + j] * c.norm_mix[k]; }
    __syncthreads();
    float xn[16]; f32x4 x4n[4], p4n;
#pragma unroll
    for (int i = 0; i < 4; ++i) x4n[i] = (f32x4){0.f, 0.f, 0.f, 0.f};
    p4n = (f32x4){0.f, 0.f, 0.f, 0.f};
    { const int row = blockIdx.x * 8 + wid; if (row < NT) { const float* xr = row < NTP ? c.x_prompt + (size_t)row * D : c.x_sample + (size_t)(row - NTP) * D;
        const float* pr0 = row < NTP ? c.p_prompt + (size_t)row * PLE : c.p_sample + (size_t)(row - NTP) * PLE;
#pragma unroll
        for (int i = 0; i < 16; ++i) xn[i] = xr[i * 64 + lane];
#pragma unroll
        for (int i = 0; i < 4; ++i) x4n[i] = *(const f32x4*)(xr + i * 256 + lane * 4);
        p4n = *(const f32x4*)(pr0 + lane * 4); } }
    for (int row = blockIdx.x * 8 + wid; row < NT; row += gridDim.x * 8) {
        const float* xr = row < NTP ? c.x_prompt + (size_t)row * D : c.x_sample + (size_t)(row - NTP) * D;
        const float* pr = row < NTP ? c.p_prompt + (size_t)row * PLE : c.p_sample + (size_t)(row - NTP) * PLE;
        float xc[16]; f32x4 x4c[4]; const f32x4 p4c = p4n;
#pragma unroll
        for (int i = 0; i < 16; ++i) xc[i] = xn[i];
#pragma unroll
        for (int i = 0; i < 4; ++i) x4c[i] = x4n[i];
        { const int rown = row + gridDim.x * 8; if (rown < NT) { const float* xq = rown < NTP ? c.x_prompt + (size_t)rown * D : c.x_sample + (size_t)(rown - NTP) * D;
            const float* pq = rown < NTP ? c.p_prompt + (size_t)rown * PLE : c.p_sample + (size_t)(rown - NTP) * PLE;
#pragma unroll
            for (int i = 0; i < 4; ++i) x4n[i] = *(const f32x4*)(xq + i * 256 + lane * 4);
            p4n = *(const f32x4*)(pq + lane * 4);
#pragma unroll
            for (int i = 0; i < 16; ++i) xn[i] = xq[i * 64 + lane]; } }
        float ss = 0.f, dot[8];
#pragma unroll
        for (int j = 0; j < 8; ++j) dot[j] = 0.f;
#pragma unroll
        for (int i = 0; i < 16; ++i) { const int k = i * 64 + lane; const float xv = xc[i]; ss += xv * xv;
            const f32x4 w0 = *(const LAS f32x4*)(wab + k * 8), w1 = *(const LAS f32x4*)(wab + k * 8 + 4);
            dot[0] += xv * w0[0]; dot[1] += xv * w0[1]; dot[2] += xv * w0[2]; dot[3] += xv * w0[3]; dot[4] += xv * w1[0]; dot[5] += xv * w1[1]; dot[6] += xv * w1[2]; dot[7] += xv * w1[3]; }
#pragma unroll
        for (int o = 32; o >= 1; o >>= 1) { ss += __shfl_xor(ss, o);
#pragma unroll
            for (int j = 0; j < 8; ++j) dot[j] += __shfl_xor(dot[j], o); }
        const float rs = rsqrtf(ss * (1.0f / 1024.0f) + EPS);
#pragma unroll
        for (int i = 0; i < 4; ++i) { const int k0 = i * 256 + lane * 4; const f32x4 v = x4c[i]; u32x2 w; w.x = pk2(v[0], v[1]); w.y = pk2(v[2], v[3]); *(u32x2*)(XB + (size_t)row * D + k0) = w; }
        { const f32x4 v = p4c; u32x2 w; w.x = pk2(v[0], v[1]); w.y = pk2(v[2], v[3]); *(u32x2*)(PB + (size_t)row * PLE + lane * 4) = w; }
        if (lane == 0) { ctl[CTL_RS0 + row] = rs; ctl[CTL_SS1 + row] = 0.f; ctl[CTL_SS2 + row] = 0.f; ctl[CTL_SS3 + row] = 0.f; }
        if (lane < 4) { const float da = lane == 0 ? dot[0] : lane == 1 ? dot[1] : lane == 2 ? dot[2] : dot[3]; const float db = lane == 0 ? dot[4] : lane == 1 ? dot[5] : lane == 2 ? dot[6] : dot[7];
            const float xa = da * rs + c.dt_bias[lane]; const float sp = xa > 20.f ? xa : log1pf(__expf(xa));
            ctl[CTL_LA + (size_t)row * 4 + lane] = -__expf(c.a_log[lane]) * sp; ctl[CTL_BETA + (size_t)row * 4 + lane] = sigmoidf_(db * rs); }
    }
    __syncthreads();
    tiles_range(c, ws, (LAS float*)lds, (int)blockIdx.x, (int)gridDim.x, P0_TILES);
}

constexpr int L_QH = 0, L_KH = 17408, L_RT = 34816, L_AM = 71680, L_TB = 89088, L_G = 98304, L_WC = 98816, L_SSP = 104960;
DI void prep_chunk(const Ctx& c, LAS unsigned char* lds, int ch) {
    int tid = mk_tid(); asm volatile("" : "+v"(tid));
    const int lane = tid & 63, wid = __builtin_amdgcn_readfirstlane(tid >> 6);
    const int h = ch & 3, n = (ch >> 2) & 31, b = ch >> 7;
    const int row0 = b * 2048 + n * 64;
    float* ctl = (float*)(c.ws + WS_CTL);
    const bf16_t* PROJ = (const bf16_t*)(c.ws + WS_B);
    bf16_t* QP = (bf16_t*)c.out + (size_t)ch * 8192; bf16_t* WP = (bf16_t*)c.out + (size_t)(1024 + ch) * 8192; bf16_t* KTP = (bf16_t*)c.out + (size_t)(2048 + ch) * 8192;
    bf16_t* UT = (bf16_t*)(c.ws + WS_C) + (size_t)ch * 8192; bf16_t* QKP = (bf16_t*)(c.ws + WS_C) + (size_t)1024 * 8192 + (size_t)ch * 4096;
    LAS float* G = (LAS float*)(lds + L_G); LAS float* BT = G + 64;
    LAS float* WC = (LAS float*)(lds + L_WC);
    LAS float* SSP = (LAS float*)(lds + L_SSP);
    for (int i = tid; i < 1536; i += NTHREADS) { const int ten = i >> 9, jj = (i >> 7) & 3, cc = i & 127; WC[i] = c.w_conv_qkv[jj * 1536 + ten * 512 + h * 128 + cc]; }
    if (wid == 0) {
        float la = ctl[CTL_LA + (size_t)(row0 + lane) * 4 + h];
#pragma unroll
        for (int o = 1; o < 64; o <<= 1) { const float t = __int_as_float(__builtin_amdgcn_ds_bpermute(((lane - o) & 63) * 4, __float_as_int(la))); if (lane >= o) la += t; }
        G[lane] = la; BT[lane] = ctl[CTL_BETA + (size_t)(row0 + lane) * 4 + h];
        if (lane == 63) __hip_atomic_store(ctl + CTL_GL + ch, la, __ATOMIC_RELAXED, __HIP_MEMORY_SCOPE_AGENT);
    }
    {
        const int tok = lane, cg8 = wid;
        const int t_abs = n * 64 + tok;
        u32x4 xr[3][4][2];
#pragma unroll
        for (int ten = 0; ten < 3; ++ten)
#pragma unroll
            for (int j = 0; j < 4; ++j) { const int tt = t_abs - 3 + j;
                if (tt >= 0) { const bf16_t* src = PROJ + (size_t)(b * 2048 + tt) * NPROJ + ten * 512 + h * 128 + cg8 * 16; xr[ten][j][0] = *(const u32x4*)src; xr[ten][j][1] = *(const u32x4*)(src + 8); }
                else { xr[ten][j][0] = (u32x4){0u, 0u, 0u, 0u}; xr[ten][j][1] = (u32x4){0u, 0u, 0u, 0u}; } }
        __syncthreads();
        const float g = G[tok], bt = BT[tok];
        const float eg = __expf(g);
        float a[3][16];
#pragma unroll
        for (int ten = 0; ten < 3; ++ten) {
#pragma unroll
            for (int e = 0; e < 16; ++e) a[ten][e] = 0.f;
#pragma unroll
            for (int j = 0; j < 4; ++j) { float x[16]; unpack8(xr[ten][j][0], x); unpack8(xr[ten][j][1], x + 8);
                const LAS float* wj = WC + (ten * 4 + j) * 128 + cg8 * 16;
#pragma unroll
                for (int q = 0; q < 4; ++q) { const f32x4 w = *(const LAS f32x4*)(wj + 4 * q); a[ten][4 * q] += x[4 * q] * w[0]; a[ten][4 * q + 1] += x[4 * q + 1] * w[1]; a[ten][4 * q + 2] += x[4 * q + 2] * w[2]; a[ten][4 * q + 3] += x[4 * q + 3] * w[3]; } }
#pragma unroll
            for (int e = 0; e < 16; ++e) a[ten][e] = siluf_(a[ten][e]);
        }
        { float sq = 0.f, sk = 0.f;
#pragma unroll
          for (int e = 0; e < 16; ++e) { sq += a[0][e] * a[0][e]; sk += a[1][e] * a[1][e]; }
          SSP[cg8 * 64 + tok] = sq; SSP[512 + cg8 * 64 + tok] = sk; }
        __syncthreads();
        { float sq = 0.f, sk = 0.f;
#pragma unroll
          for (int w = 0; w < 8; ++w) { sq += SSP[w * 64 + tok]; sk += SSP[512 + w * 64 + tok]; }
          const float scq = rsqrtf(sq + EPS) * 0.08838834764831845f, sck = rsqrtf(sk + EPS);
#pragma unroll
          for (int e = 0; e < 16; ++e) { a[0][e] *= scq; a[1][e] *= sck; } }
        {
            LAS unsigned char* q = lds + L_QH + tok * 272 + cg8 * 32;
            *(LAS u32x4*)q = pack8(a[0]); *(LAS u32x4*)(q + 16) = pack8(a[0] + 8);
            float p[16];
#pragma unroll
            for (int e = 0; e < 16; ++e) p[swap23(e)] = a[0][e] * eg;
            bf16_t* dst = QP + tok * 128 + cg8 * 16; st16_wt(dst, pack8(p)); st16_wt(dst + 8, pack8(p + 8));
        }
        {
            LAS unsigned char* q = lds + L_KH + tok * 272 + cg8 * 32;
            *(LAS u32x4*)q = pack8(a[1]); *(LAS u32x4*)(q + 16) = pack8(a[1] + 8);
            const float f = bt * eg;
#pragma unroll
            for (int e = 0; e < 16; ++e) *(LAS bf16_t*)(lds + L_RT + (128 + cg8 * 16 + e) * 144 + tok * 2) = f2bf(a[1][e] * f);
        }
#pragma unroll
        for (int e = 0; e < 16; ++e) *(LAS bf16_t*)(lds + L_RT + (cg8 * 16 + e) * 144 + tok * 2) = f2bf(a[2][e] * bt);
    }
    __syncthreads();
    {
        int r = lane & 31, hh = lane >> 5; asm volatile("" : "+v"(r), "+v"(hh));
        const int blk = wid & 3, I = (blk == 1 || blk == 2) ? 1 : 0, J = (blk == 2 || blk == 3) ? 1 : 0; const bool isq = wid >= 4;
        f32x16 x;
#pragma unroll
        for (int i = 0; i < 16; ++i) x[i] = 0.f;
        if (blk != 3) {
            LAS unsigned char* Ab = lds + (isq ? L_QH : L_KH) + (32 * I + r) * 272 + hh * 16; LAS unsigned char* Bb = lds + L_KH + (32 * J + r) * 272 + hh * 16;
#pragma unroll
            for (int s = 0; s < 8; ++s) { const bf16x8 av = *(LAS bf16x8*)(Ab + s * 32), bv = *(LAS bf16x8*)(Bb + s * 32); x = isq ? MFMA32(bv, av, x) : MFMA32(av, bv, x); }
        }
        if (!isq) {
            const int jj = 32 * J + r; const float gj = G[jj];
            if (blk != 3) {
#pragma unroll
                for (int i = 0; i < 16; ++i) { const int ii = 32 * I + crow(i, hh); const float d = __expf(fminf(G[ii] - gj, 0.f)); ((LAS float*)(lds + L_AM))[ii * 68 + jj] = (ii > jj) ? BT[ii] * x[i] * d : 0.f; } }
        } else {
            const int ii = 32 * I + r; const float gi = G[ii]; float f[16];
#pragma unroll
            for (int i = 0; i < 16; ++i) { const int jj = 32 * J + crow(i, hh); const float d = __expf(fminf(gi - G[jj], 0.f)); f[i] = (ii >= jj && blk != 3) ? x[i] * d : 0.f; }
            bf16_t* dst = QKP + ii * 64 + 32 * J; st16_wt(dst + 8 * hh, pack8(f)); st16_wt(dst + 16 + 8 * hh, pack8(f + 8));
        }
    }
    {
        const int dk = tid & 127, tq = tid >> 7; const float glast = G[63]; float f[16];
#pragma unroll
        for (int t = 0; t < 16; ++t) { const int tk = 16 * tq + t; f[swap23(t)] = bf2f(*(LAS bf16_t*)(lds + L_KH + tk * 272 + dk * 2)) * __expf(glast - G[tk]); }
        bf16_t* dst = KTP + dk * 64 + 16 * tq; st16_wt(dst, pack8(f)); st16_wt(dst + 8, pack8(f + 8));
    }
    __syncthreads();
#ifndef NOINV
    if (wid == 0) {
        f32x2v t2[32]; f32x4 ab[2][16]; float lanef = (float)lane; asm volatile("" : "+v"(lanef));
        int zoff; asm volatile("v_mov_b32 %0, 0" : "=v"(zoff));
        LAS float* AM = (LAS float*)(lds + L_AM) + zoff;
        t2[0].x = fmaxf(1.0f - fabsf(lanef), 0.f); t2[0].y = 0.f;
        ab[1][0] = *(LAS f32x4*)(AM + 68);
#pragma unroll
        for (int i = 1; i < 64; ++i) {
            if (i + 1 < 64) {
#pragma unroll
                for (int q = 0; q < (i + 4) / 4; ++q) ab[(i + 1) & 1][q] = *(LAS f32x4*)(AM + (i + 1) * 68 + 4 * q); }
            __builtin_amdgcn_sched_barrier(0);
            f32x2v acc2 = {fmaxf(1.0f - fabsf(lanef - (float)i), 0.f), 0.f};
#pragma unroll
            for (int q = 0; q < (i + 3) / 4; ++q) { const f32x4 av = ab[i & 1][q]; const int j = 4 * q;
                if (j + 1 < i) acc2 -= (f32x2v){av[0], av[1]} * t2[j / 2]; else acc2.x -= av[0] * t2[j / 2].x;
                if (j + 3 < i) acc2 -= (f32x2v){av[2], av[3]} * t2[j / 2 + 1]; else if (j + 2 < i) acc2.x -= av[2] * t2[j / 2 + 1].x; }
            const float ti = acc2.x + acc2.y;
            if (i & 1) t2[i / 2].y = ti; else { t2[i / 2].x = ti; t2[i / 2].y = 0.f; }
            __builtin_amdgcn_sched_barrier(0);
        }
#pragma unroll
        for (int i = 0; i < 32; ++i) { *(LAS bf16_t*)(lds + L_TB + (2 * i) * 144 + lane * 2) = f2bf(t2[i].x); *(LAS bf16_t*)(lds + L_TB + (2 * i + 1) * 144 + lane * 2) = f2bf(t2[i].y); }
    }
#endif
    __syncthreads();
    {
        int r = lane & 31, hh = lane >> 5; asm volatile("" : "+v"(r), "+v"(hh));
#pragma unroll
        for (int tb = 0; tb < 2; ++tb) {
            f32x16 x;
#pragma unroll
            for (int i = 0; i < 16; ++i) x[i] = 0.f;
#pragma unroll
            for (int s = 0; s < 4; ++s) if (s < 2 || tb == 1) {
                const bf16x8 tf = *(LAS bf16x8*)(lds + L_TB + (32 * tb + r) * 144 + (16 * s + 8 * hh) * 2), rf = *(LAS bf16x8*)(lds + L_RT + (32 * wid + r) * 144 + (16 * s + 8 * hh) * 2);
                x = (wid < 4) ? MFMA32(tf, rf, x) : MFMA32(rf, tf, x); }
            float f[16];
#pragma unroll
            for (int i = 0; i < 16; ++i) f[i] = x[i];
            bf16_t* dst = (wid < 4) ? UT + (32 * wid + r) * 64 + 32 * tb : WP + (32 * tb + r) * 128 + 32 * (wid - 4);
            st16_wt(dst + 8 * hh, pack8(f)); st16_wt(dst + 16 + 8 * hh, pack8(f + 8));
        }
    }
    asm volatile("s_waitcnt vmcnt(0)" ::: "memory");
    __syncthreads();
    if (tid == 0) __hip_atomic_store((unsigned*)(c.ws + WS_FLAGS) + ch, 1u, __ATOMIC_RELAXED, __HIP_MEMORY_SCOPE_AGENT);
}

DI void sample_gdn2(const Ctx& c, LAS unsigned char* lds, int pair) {
    const int tid = mk_tid(), lane = tid & 63, half = tid >> 8, ht = tid & 255, hw = (tid >> 6) & 3;
    const int item = pair * 2 + half, b = item >> 2, h = item & 3;
    float* ctl = (float*)(c.ws + WS_CTL);
    const bf16_t* PROJ = (const bf16_t*)(c.ws + WS_B); bf16_t* OY = (bf16_t*)(c.ws + WS_A);
    LAS float* vals = (LAS float*)lds + half * 3072;
    LAS float* red = vals + 1536;
    LAS float* red2 = red + 256;
    LAS float* os = red2 + 256;
    const int row0 = NTP + b * 4;
    for (int i = ht; i < 1536; i += 256) { const int ten = i >> 9, tok = (i >> 7) & 3, ch = i & 127; const int col = ten * 512 + h * 128 + ch; float a = 0.f;
#pragma unroll
        for (int j = 0; j < 4; ++j) { const int idx = tok + j; const float xv = idx < 3 ? c.state_gdn_conv[((size_t)b * 3 + idx) * 1536 + col] : bf2f(PROJ[(size_t)(row0 + idx - 3) * NPROJ + col]); a += xv * c.w_conv_qkv[j * 1536 + col]; }
        vals[i] = siluf_(a); }
    __syncthreads();
#pragma unroll
    for (int rep = 0; rep < 2; ++rep) { const int pr = hw * 2 + rep, ten = pr >> 2, tok = pr & 3; LAS float* v = vals + ten * 512 + tok * 128; const float a0 = v[lane], a1 = v[lane + 64]; float ss = a0 * a0 + a1 * a1;
#pragma unroll
        for (int o = 32; o >= 1; o >>= 1) ss += __shfl_xor(ss, o);
        const float sc = rsqrtf(ss + EPS) * (ten == 0 ? 0.08838834764831845f : 1.0f); v[lane] = a0 * sc; v[lane + 64] = a1 * sc; }
    __syncthreads();
    const int e = ht & 127, part = ht >> 7;
    float s[64];
    const float* S0 = c.state_gdn + ((size_t)item * 128 + part * 64) * 128 + e;
#pragma unroll
    for (int i = 0; i < 64; ++i) s[i] = S0[(size_t)i * 128];
#pragma unroll 1
    for (int t = 0; t < 4; ++t) {
        const float a = __expf(ctl[CTL_LA + (size_t)(row0 + t) * 4 + h]), bt = ctl[CTL_BETA + (size_t)(row0 + t) * 4 + h];
        LAS float* qv = vals + t * 128 + part * 64; LAS float* kv = vals + 512 + t * 128 + part * 64;
        float p = 0.f;
#pragma unroll
        for (int i = 0; i < 64; ++i) { s[i] *= a; p += s[i] * kv[i]; }
        red[part * 128 + e] = p;
        __syncthreads();
        const float rr = bt * (vals[1024 + t * 128 + e] - (red[e] + red[128 + e]));
        float po = 0.f;
#pragma unroll
        for (int i = 0; i < 64; ++i) { s[i] += kv[i] * rr; po += s[i] * qv[i]; }
        red2[part * 128 + e] = po;
        __syncthreads();
        if (part == 0) os[t * 128 + e] = red2[e] + red2[128 + e];
    }
    float* Sout = c.out + OFF_GS + ((size_t)item * 128 + part * 64) * 128 + e;
#pragma unroll
    for (int i = 0; i < 64; ++i) Sout[(size_t)i * 128] = s[i];
    __syncthreads();
#pragma unroll
    for (int rep = 0; rep < 2; ++rep) { const int tok = part * 2 + rep; float ss = 0.f;
        for (int i = 0; i < 128; ++i) { const float v = os[tok * 128 + i]; ss += v * v; }
        const float rs = rsqrtf(ss * (1.0f / 128.0f) + EPS); const int row = row0 + tok;
        const float z = bf2f(PROJ[(size_t)row * NPROJ + 1536 + h * 128 + e]);
        OY[(size_t)row * D + h * 128 + e] = f2bf(os[tok * 128 + e] * rs * c.w_gdn_norm[e] * siluf_(z)); }
    __syncthreads();
}

DI void shortconv_items(const Ctx& c, int item_lo, int item_hi, int bfirst, int bcount) {
    const int tid = mk_tid();
    const bf16_t* PROJ = (const bf16_t*)(c.ws + WS_B); bf16_t* OY = (bf16_t*)(c.ws + WS_A);
    for (int item = item_lo + bfirst * NTHREADS + tid; item < item_hi; item += bcount * NTHREADS) {
        const int row = item >> 6, c8 = (item & 63) * 8;
        const bool prm = row < NTP; const int sb = prm ? (row >> 11) : ((row - NTP) >> 2); const int t = prm ? (row & 2047) : ((row - NTP) & 3); const int T = prm ? 2048 : 4;
        float bv[8]; unpack8(*(const u32x4*)(PROJ + (size_t)row * NPROJ + 2048 + c8), bv);
        float acc[8], cur[8];
#pragma unroll
        for (int e = 0; e < 8; ++e) { acc[e] = 0.f; cur[e] = 0.f; }
#pragma unroll
        for (int d = 0; d < 3; ++d) { const int tt = t - 2 + d; float sc[8];
            if (tt >= 0) { float cv[8], hv[8]; const bf16_t* src = PROJ + (size_t)(row - (2 - d)) * NPROJ + c8; unpack8(*(const u32x4*)(src + 2560), cv); unpack8(*(const u32x4*)(src + 3072), hv);
#pragma unroll
                for (int e = 0; e < 8; ++e) sc[e] = cv[e] * hv[e]; }
            else if (!prm) { const float* sp = c.state_sc_conv + ((size_t)sb * 2 + (2 + tt)) * 512 + c8; const f32x4 s0 = *(const f32x4*)sp, s1 = *(const f32x4*)(sp + 4);
#pragma unroll
                for (int e = 0; e < 4; ++e) { sc[e] = s0[e]; sc[4 + e] = s1[e]; } }
            else {
#pragma unroll
                for (int e = 0; e < 8; ++e) sc[e] = 0.f; }
            const float* wp = c.w_conv_sc + d * 512 + c8; const f32x4 w0 = *(const f32x4*)wp, w1 = *(const f32x4*)(wp + 4);
#pragma unroll
            for (int e = 0; e < 4; ++e) { acc[e] += sc[e] * w0[e]; acc[4 + e] += sc[4 + e] * w1[e]; }
            if (d == 2) {
#pragma unroll
                for (int e = 0; e < 8; ++e) cur[e] = sc[e]; } }
#pragma unroll
        for (int e = 0; e < 8; ++e) acc[e] *= bv[e];
        *(u32x4*)(OY + (size_t)row * D + 512 + c8) = pack8(acc);
        if (t >= T - 2) { float* dst = (prm ? c.out + OFF_SCP : c.out + OFF_SCS) + ((size_t)sb * 2 + (t - (T - 2))) * 512 + c8;
            *(f32x4*)dst = (f32x4){cur[0], cur[1], cur[2], cur[3]}; *(f32x4*)(dst + 4) = (f32x4){cur[4], cur[5], cur[6], cur[7]}; }
    }
}
DI void conv_state_copies(const Ctx& c, int bfirst, int bcount) {
    const int tid = mk_tid();
    const bf16_t* PROJ = (const bf16_t*)(c.ws + WS_B);
    for (int idx = bfirst * NTHREADS + tid; idx < 136 * 4608; idx += bcount * NTHREADS) {
        const int seq = idx / 4608, rem = idx % 4608, j = rem / 1536, col = rem % 1536;
        if (seq < 8) c.out[OFF_GCP + idx] = bf2f(PROJ[(size_t)(seq * 2048 + 2045 + j) * NPROJ + col]);
        else c.out[OFF_GCS + (idx - 8 * 4608)] = bf2f(PROJ[(size_t)(NTP + (seq - 8) * 4 + 1 + j) * NPROJ + col]);
    }
}

constexpr int P3_BUF = 57344, P3_OB = 114688, L_XST = 148480, P3_WN = 148496;
DI void scan_seq(const Ctx& c, LAS unsigned char* lds, int bh) {
    const int tid = mk_tid(), lane = tid & 63, wid = tid >> 6, r = lane & 31, hh = lane >> 5;
    const int b = bh >> 2, h = bh & 3;
    const bool loader = wid >= 4; const int lt = tid & 255;
    const float* ctl = (const float*)(c.ws + WS_CTL);
    const bf16_t* PROJ = (const bf16_t*)(c.ws + WS_B); bf16_t* OY = (bf16_t*)(c.ws + WS_A);
    LAS float* OB = (LAS float*)(lds + P3_OB);
    const int ch0 = b * 128 + h;
    const u32x4* gQ = (const u32x4*)((const bf16_t*)c.out) ; const u32x4* gW = gQ + (size_t)1024 * 1024; const u32x4* gKT = gQ + (size_t)2048 * 1024;
    const u32x4* gQK = (const u32x4*)((const bf16_t*)(c.ws + WS_C) + (size_t)1024 * 8192);
    const bf16_t* gUT = (const bf16_t*)(c.ws + WS_C);
    f32x16 S[4];
#pragma unroll
    for (int kt = 0; kt < 4; ++kt)
#pragma unroll
        for (int i = 0; i < 16; ++i) S[kt][i] = 0.f;
    const int e0 = 32 * (wid & 3);
    u32x4 zr[4]; u32x4 un[4]; float decn = 1.f;
#define P3_DMA(gp, ldsp) __builtin_amdgcn_global_load_lds((const unsigned*)(gp), (LAS unsigned*)(ldsp), 16, 0, 0)
    const int lw = (wid & 3) * 1024;
    int srcA[4], srcB[4];
#pragma unroll
    for (int i = 0; i < 4; ++i) { const int q = lt + 256 * i; const int rowA = q >> 4, rowB = q >> 3; srcA[i] = rowA * 16 + ((q & 15) ^ (rowA & 15)); srcB[i] = rowB * 8 + ((q & 7) ^ ((rowB >> 1) & 7)); }
    const int gtok = lt >> 2, gpart = lt & 3;
    if (tid < 128) ((LAS float*)(lds + P3_WN))[tid] = c.w_gdn_norm[tid];
    unsigned* const flags = (unsigned*)(c.ws + WS_FLAGS);
#define P3_WAIT(chx) do { unsigned sp_ = 0u; while (__hip_atomic_load(flags + (chx), __ATOMIC_RELAXED, __HIP_MEMORY_SCOPE_AGENT) == 0u) { __builtin_amdgcn_s_sleep(2); if (++sp_ > (1u << 22)) break; } __builtin_amdgcn_fence(__ATOMIC_ACQUIRE, "agent"); } while (0)
    P3_WAIT(ch0);
    if (loader) {
        const size_t t0 = (size_t)ch0 * 1024;
#pragma unroll
        for (int i = 0; i < 4; ++i) { P3_DMA(gW + t0 + srcA[i], lds + lw + 4096 * i); P3_DMA(gQ + t0 + srcA[i], lds + 16384 + lw + 4096 * i); P3_DMA(gKT + t0 + srcB[i], lds + 32768 + lw + 4096 * i); }
#pragma unroll
        for (int i = 0; i < 2; ++i) P3_DMA(gQK + (size_t)ch0 * 512 + srcB[i], lds + 49152 + lw + 4096 * i);
        asm volatile("s_waitcnt vmcnt(0)" ::: "memory");
    } else {
        const bf16_t* up = gUT + (size_t)ch0 * 8192 + (e0 + r) * 64 + 8 * hh;
        un[0] = *(const u32x4*)up; un[1] = *(const u32x4*)(up + 16); un[2] = *(const u32x4*)(up + 32); un[3] = *(const u32x4*)(up + 48);
        decn = __expf(__hip_atomic_load(ctl + CTL_GL + ch0, __ATOMIC_RELAXED, __HIP_MEMORY_SCOPE_AGENT));
    }
    const int rw = r & 15, rk = (r >> 1) & 7;
    if (loader) {
#pragma unroll 1
        for (int n = 0; n <= 32; ++n) {
            __syncthreads();
            if (n < 31) { P3_WAIT(ch0 + 4 * (n + 1)); const size_t t1 = (size_t)(ch0 + 4 * (n + 1)) * 1024; LAS unsigned char* Bn = lds + ((n + 1) & 1) * P3_BUF;
#pragma unroll
                for (int i = 0; i < 4; ++i) { P3_DMA(gW + t1 + srcA[i], Bn + lw + 4096 * i); P3_DMA(gQ + t1 + srcA[i], Bn + 16384 + lw + 4096 * i); P3_DMA(gKT + t1 + srcB[i], Bn + 32768 + lw + 4096 * i); }
#pragma unroll
                for (int i = 0; i < 2; ++i) P3_DMA(gQK + (size_t)(ch0 + 4 * (n + 1)) * 512 + srcB[i], Bn + 49152 + lw + 4096 * i); }
            if (n >= 1) {
                const int row = b * 2048 + (n - 1) * 64 + gtok; LAS float* op = OB + gtok * 132 + gpart * 32;
                float o[32]; float ss = 0.f;
#pragma unroll
                for (int q = 0; q < 8; ++q) { const f32x4 v = *(LAS f32x4*)(op + 4 * q); o[4 * q] = v[0]; o[4 * q + 1] = v[1]; o[4 * q + 2] = v[2]; o[4 * q + 3] = v[3]; ss += (v[0] * v[0] + v[1] * v[1]) + (v[2] * v[2] + v[3] * v[3]); }
                ss += __shfl_xor(ss, 1); ss += __shfl_xor(ss, 2);
                const float rs = rsqrtf(ss * (1.0f / 128.0f) + EPS);
                float z[32]; unpack8(zr[0], z); unpack8(zr[1], z + 8); unpack8(zr[2], z + 16); unpack8(zr[3], z + 24);
#pragma unroll
                for (int e = 0; e < 32; ++e) o[e] = o[e] * rs * ((LAS float*)(lds + P3_WN))[gpart * 32 + e] * siluf_(z[e]);
                bf16_t* dst = OY + (size_t)row * D + h * 128 + gpart * 32;
                *(u32x4*)dst = pack8(o); *(u32x4*)(dst + 8) = pack8(o + 8); *(u32x4*)(dst + 16) = pack8(o + 16); *(u32x4*)(dst + 24) = pack8(o + 24);
            }
            __syncthreads();
            asm volatile("s_waitcnt vmcnt(0)" ::: "memory");
            if (n < 32) { const bf16_t* zp = PROJ + (size_t)(b * 2048 + n * 64 + gtok) * NPROJ + 1536 + h * 128 + gpart * 32;
                zr[0] = *(const u32x4*)zp; zr[1] = *(const u32x4*)(zp + 8); zr[2] = *(const u32x4*)(zp + 16); zr[3] = *(const u32x4*)(zp + 24); }
        }
    } else {
#pragma unroll 1
        for (int n = 0; n <= 32; ++n) {
            __syncthreads();
            LAS unsigned char* B = lds + (n & 1) * P3_BUF;
            f32x16 O[2];
            if (n < 32) {
                const f32x16 zero16 = {0.f, 0.f, 0.f, 0.f, 0.f, 0.f, 0.f, 0.f, 0.f, 0.f, 0.f, 0.f, 0.f, 0.f, 0.f, 0.f};
                f32x16 P[2]; P[0] = zero16; P[1] = zero16; O[0] = zero16; O[1] = zero16;
#pragma unroll
                for (int kt = 0; kt < 4; ++kt)
#pragma unroll
                    for (int s = 0; s < 2; ++s) { const bf16x8 sb = pack_step(S[kt], s);
#pragma unroll
                        for (int mi = 0; mi < 2; ++mi) { const int off = ((32 * mi + r) * 16 + ((4 * kt + 2 * s + hh) ^ rw)) * 16;
                            P[mi] = MFMA32(*(LAS bf16x8*)(B + off), sb, P[mi]); O[mi] = MFMA32(*(LAS bf16x8*)(B + 16384 + off), sb, O[mi]); } }
                bf16x8 vb[2][2];
#pragma unroll
                for (int tb = 0; tb < 2; ++tb) { float u[16]; unpack8(un[2 * tb], u); unpack8(un[2 * tb + 1], u + 8);
                    f32x16 vn;
#pragma unroll
                    for (int i = 0; i < 16; ++i) vn[i] = u[i] - P[tb][i];
                    vb[tb][0] = pack_step(vn, 0); vb[tb][1] = pack_step(vn, 1); }
                const float dec = decn;
                if (n < 31) { P3_WAIT(ch0 + 4 * (n + 1)); const bf16_t* up = gUT + (size_t)(ch0 + 4 * (n + 1)) * 8192 + (e0 + r) * 64 + 8 * hh;
                    un[0] = *(const u32x4*)up; un[1] = *(const u32x4*)(up + 16); un[2] = *(const u32x4*)(up + 32); un[3] = *(const u32x4*)(up + 48);
                    decn = __expf(__hip_atomic_load(ctl + CTL_GL + ch0 + 4 * (n + 1), __ATOMIC_RELAXED, __HIP_MEMORY_SCOPE_AGENT)); }
#pragma unroll
                for (int mi = 0; mi < 2; ++mi)
#pragma unroll
                    for (int tb = 0; tb <= mi; ++tb)
#pragma unroll
                        for (int s = 0; s < 2; ++s) O[mi] = MFMA32(*(LAS bf16x8*)(B + 49152 + ((32 * mi + r) * 8 + ((4 * tb + 2 * s + hh) ^ rk)) * 16), vb[tb][s], O[mi]);
#pragma unroll
                for (int kt = 0; kt < 4; ++kt) { S[kt] *= dec;
#pragma unroll
                    for (int tb = 0; tb < 2; ++tb)
#pragma unroll
                        for (int s = 0; s < 2; ++s) S[kt] = MFMA32(*(LAS bf16x8*)(B + 32768 + ((32 * kt + r) * 8 + ((4 * tb + 2 * s + hh) ^ rk)) * 16), vb[tb][s], S[kt]); }
            }
            __syncthreads();
            if (n < 32) {
#pragma unroll
                for (int mi = 0; mi < 2; ++mi)
#pragma unroll
                    for (int i = 0; i < 16; ++i) OB[(32 * mi + crow(i, hh)) * 132 + e0 + r] = O[mi][i];
            }
        }
    }
    if (!loader) { float* So = c.out + OFF_GP + (size_t)bh * 16384;
#pragma unroll
        for (int kt = 0; kt < 4; ++kt)
#pragma unroll
            for (int i = 0; i < 16; ++i) So[(32 * kt + crow(i, hh)) * 128 + e0 + r] = S[kt][i]; }
    __syncthreads();
}

DI void sub_barrier(unsigned* cnt, unsigned target, bool release = true) {
    asm volatile("s_waitcnt vmcnt(0)" ::: "memory");
    __syncthreads();
    if (mk_tid() == 0) {
        if (release) { __builtin_amdgcn_fence(__ATOMIC_RELEASE, "agent"); asm volatile("s_waitcnt vmcnt(0)" ::: "memory"); }
        (void)xb_add(cnt, 1u);
        unsigned sp = 0u; while (xb_ld(cnt) < target) { __builtin_amdgcn_s_sleep(1); if (++sp > (1u << 22)) break; }
        __builtin_amdgcn_fence(__ATOMIC_ACQUIRE, "agent");
        asm volatile("s_waitcnt vmcnt(0)" ::: "memory");
    }
    __syncthreads();
}

__global__ void __launch_bounds__(NTHREADS, 2) mega(Ctx c) {
    extern __shared__ __attribute__((aligned(16))) unsigned char shm[];
    LAS unsigned char* lds = (LAS unsigned char*)shm;
    { const unsigned t0 = threadIdx.x; if ((t0 & 63u) == 0u) ((LAS unsigned*)(lds + L_WTAB))[mk_slot()] = t0 >> 6; }
    __syncthreads();
    unsigned char* ws = c.ws; float* ctl = (float*)(ws + WS_CTL);
    const int lo = c.ph_lo, hi = c.ph_hi;
    if (hi > 1000) cg::this_grid().sync();
    volatile LAS unsigned* xst = (volatile LAS unsigned*)(lds + L_XST);
    if (mk_tid() < 4) xst[mk_tid()] = 0u;
    __syncthreads();
    XcdBarrier bar = xcd_barrier_post((unsigned*)(ws + WS_BAR), xst);
#ifdef ONLY
#define IN(k) ((k) == ONLY)
#else
#define IN(k) (lo <= (k) && (k) < hi)
#endif
#define SEAM(k) do { if (IN(k) && IN((k) + 1)) xcd_barrier(bar); } while (0)
    if (IN(0)) p0_phase(c, lds);
    SEAM(0);
    if (IN(1)) { pg8::Gemm g{(const bf16_t*)(ws + WS_A), (const bf16_t*)(ws + WS_WIN), NT, NPROJ, D, 0}; pg8::StaticOrder S; S.init(NT, NPROJ, gridDim.x, blockIdx.x);
        EpiProj E{(bf16_t*)(ws + WS_B), NPROJ, ctl + CTL_RS0}; pg8::gemm_phase<EpiProj, pg8::StaticOrder, false>(lds, g, S, E, nullptr);
        { const int G = (int)gridDim.x, rem = ((NT / 256) * (NPROJ / 256)) % G;
          if (rem > 0) { if ((int)blockIdx.x >= rem) tiles_range(c, ws, (LAS float*)lds, P0_TILES + ((int)blockIdx.x - rem), G - rem, 3520); }
          else tiles_range(c, ws, (LAS float*)lds, P0_TILES + (int)blockIdx.x, G, 3520); } }
    SEAM(1);
    if (IN(3)) {
        unsigned* const chw = (unsigned*)(ws + WS_BAR) + 96;
        if (blockIdx.x < 32 || blockIdx.x >= 64) {
            const int q = blockIdx.x < 32 ? (int)blockIdx.x : (int)blockIdx.x - 32, nq = (int)gridDim.x - 32;
            for (int it = q; it < 256; it += nq) sample_gdn2(c, lds, it);
            shortconv_items(c, NTP * 64, NT * 64, q, nq);
            asm volatile("s_waitcnt vmcnt(0)" ::: "memory");
            __syncthreads();
            if (mk_tid() == 0) { __builtin_amdgcn_fence(__ATOMIC_RELEASE, "agent"); asm volatile("s_waitcnt vmcnt(0)" ::: "memory"); (void)xb_add(chw, 1u); }
        }
        if (blockIdx.x < 32) { scan_seq(c, lds, blockIdx.x); const int nq = (int)gridDim.x - 32, q = nq - 32 + (int)blockIdx.x; shortconv_items(c, 0, NTP * 64, q, nq); conv_state_copies(c, q, nq); }
        else if (blockIdx.x < 64) {
            if (mk_tid() == 0) { unsigned sp = 0u; while (xb_ld(chw) < gridDim.x - 32u) { __builtin_amdgcn_s_sleep(2); if (++sp > (1u << 22)) break; } __builtin_amdgcn_fence(__ATOMIC_ACQUIRE, "agent"); asm volatile("s_waitcnt vmcnt(0)" ::: "memory"); }
            __syncthreads();
            const int j = blockIdx.x - 32; unsigned* sc = (unsigned*)(ws + WS_BAR) + 64;
            { pg8::Gemm g{(const bf16_t*)(ws + WS_A), (const bf16_t*)(ws + WS_WOUT), NT, D, D, 0}; SubOrder S{64, 2, 4, 8, j < 8 ? j : -1};
              EpiRes<0> E{c.x_prompt, c.x_sample, (bf16_t*)(ws + WS_C), nullptr, ctl + CTL_SS1, nullptr, nullptr, 1}; pg8::gemm_phase<EpiRes<0>, SubOrder, false>(lds, g, S, E, nullptr); }
            { pg8::Gemm g{(const bf16_t*)(ws + WS_PB), (const bf16_t*)(ws + WS_WP), NT, D, PLE, 0}; SubOrder S{64, 2, 4, 8, (j >= 8 && j < 16) ? j - 8 : -1};
              EpiProj E{(bf16_t*)(ws + WS_PPS) - (size_t)NTP * D, D, nullptr, 1}; pg8::gemm_phase<EpiProj, SubOrder, false>(lds, g, S, E, nullptr); }
            sub_barrier(sc, 32u, false);
            { pg8::Gemm g{(const bf16_t*)(ws + WS_C), (const bf16_t*)(ws + WS_WUP), NT, DFF, D, 0}; SubOrder S{64, 2, 16, 32, j};
              EpiUp E{(bf16_t*)(ws + WS_B), ctl + CTL_SS1, 1}; pg8::gemm_phase<EpiUp, SubOrder, false>(lds, g, S, E, nullptr); }
            sub_barrier(sc, 64u, false);
            { const int kq = j >> 3; pg8::Gemm g{(const bf16_t*)(ws + WS_B) + kq * 1024, (const bf16_t*)(ws + WS_WDN) + kq * 1024, NT, D, 1024, DFF}; SubOrder S{64, 2, 4, 8, j & 7};
              EpiSplitK E{(float*)(ws + WS_B + SLAB_OFF), kq, (bf16_t*)(ws + WS_C), ctl + CTL_SS2, (unsigned*)(ws + WS_PCNT) + 66 * 32}; pg8::gemm_phase<EpiSplitK, SubOrder, false>(lds, g, S, E, nullptr); }
            sub_barrier(sc, 96u, false);
            { pg8::Gemm g{(const bf16_t*)(ws + WS_C), (const bf16_t*)(ws + WS_WG), NT, D, D, 0}; SubOrder S{64, 2, 4, 8, j < 8 ? j : -1};
              EpiFinal E{(const bf16_t*)(ws + WS_C), (const bf16_t*)(ws + WS_PPS) - (size_t)NTP * D, ctl + CTL_SS2, ctl + CTL_SS3, (unsigned*)(ws + WS_PCNT), c.norm_f, c.out}; pg8::gemm_phase<EpiFinal, SubOrder, false>(lds, g, S, E, nullptr); }
        }
        else { const int q = (int)blockIdx.x - 64, nq = (int)gridDim.x - 64;
            for (int i = q; i < 1024; i += nq) { const int n = i >> 5, bh = i & 31; prep_chunk(c, lds, ((bh >> 2) * 32 + n) * 4 + (bh & 3)); }
            shortconv_items(c, 0, NTP * 64, q, nq + 32);
            conv_state_copies(c, q, nq + 32); }
    }
    SEAM(3);
    if (IN(4)) { pg8::Gemm g{(const bf16_t*)(ws + WS_A), (const bf16_t*)(ws + WS_WOUT), NT, D, D, 0}; pg8::StaticOrder S; S.init(NTP, D, gridDim.x, blockIdx.x);
        EpiRes<0> E{c.x_prompt, c.x_sample, (bf16_t*)(ws + WS_C), nullptr, ctl + CTL_SS1, nullptr, nullptr}; pg8::gemm_phase<EpiRes<0>, pg8::StaticOrder, false>(lds, g, S, E, nullptr); }
    SEAM(4);
    if (IN(5)) { pg8::Gemm g{(const bf16_t*)(ws + WS_C), (const bf16_t*)(ws + WS_WUP), NT, DFF, D, 0}; pg8::StaticOrder S; S.init(NTP, DFF, gridDim.x, blockIdx.x);
        EpiUp E{(bf16_t*)(ws + WS_B), ctl + CTL_SS1}; pg8::gemm_phase<EpiUp, pg8::StaticOrder, false>(lds, g, S, E, nullptr); }
    SEAM(5);
    if (IN(6)) {
        { pg8::Gemm g{(const bf16_t*)(ws + WS_B), (const bf16_t*)(ws + WS_WDN), NT, D, DFF, 0}; pg8::StaticOrder S; S.init(NTP, D, gridDim.x, blockIdx.x);
          EpiRes<1> E{nullptr, nullptr, (bf16_t*)(ws + WS_C), nullptr, ctl + CTL_SS2, nullptr, nullptr}; pg8::gemm_phase<EpiRes<1>, pg8::StaticOrder, false>(lds, g, S, E, nullptr); }
        { pg8::Gemm g{(const bf16_t*)(ws + WS_PB), (const bf16_t*)(ws + WS_WP), NT, D, PLE, 0}; pg8::StaticOrder S; S.init(NTP, D, gridDim.x, blockIdx.x);
          EpiProj E{(bf16_t*)(ws + WS_A), D, nullptr}; pg8::gemm_phase<EpiProj, pg8::StaticOrder, false>(lds, g, S, E, nullptr); }
    }
    SEAM(6);
    if (IN(7)) { pg8::Gemm g{(const bf16_t*)(ws + WS_C), (const bf16_t*)(ws + WS_WG), NT, D, D, 0}; pg8::StaticOrder S; S.init(NTP, D, gridDim.x, blockIdx.x);
        EpiFinal E{(const bf16_t*)(ws + WS_C), (const bf16_t*)(ws + WS_A), ctl + CTL_SS2, ctl + CTL_SS3, (unsigned*)(ws + WS_PCNT), c.norm_f, c.out}; pg8::gemm_phase<EpiFinal, pg8::StaticOrder, false>(lds, g, S, E, nullptr); }
#undef IN
#undef SEAM
}

#ifndef N_LAUNCH_MODE
#define N_LAUNCH_MODE 1
#endif
extern "C" void kernel_launch(void* const* d_in, const int* in_sizes, int n_in, void* d_out, int out_size, void* d_ws, size_t ws_size, hipStream_t stream) {
    static int grid = 0;
    if (grid == 0) {
        int dev = 0, cus = 0, per_cu = 0;
        if (ws_size < WS_END) { fprintf(stderr, "kernel_launch: workspace too small: %zu < %zu\n", ws_size, (size_t)WS_END); grid = -1; return; }
        hipGetDevice(&dev); hipDeviceGetAttribute(&cus, hipDeviceAttributeMultiprocessorCount, dev);
        if (hipFuncSetAttribute((const void*)mega, hipFuncAttributeMaxDynamicSharedMemorySize, LDS_BYTES) != hipSuccess) { fprintf(stderr, "kernel_launch: hipFuncSetAttribute failed\n"); grid = -1; return; }
        if (hipOccupancyMaxActiveBlocksPerMultiprocessor(&per_cu, (const void*)mega, NTHREADS, LDS_BYTES) != hipSuccess || per_cu < 1) { fprintf(stderr, "kernel_launch: occupancy query says %d\n", per_cu); per_cu = 1; }
        (void)hipGetLastError();
        grid = cus * 1;
    }
    if (grid < 0) return;
    (void)hipMemsetAsync((unsigned char*)d_ws + WS_BAR, 0, 32768, stream);
    Ctx a{};
    const float** ap = (const float**)&a;
    for (int i = 0; i < 22; ++i) ap[i] = (const float*)d_in[i];
    a.out = (float*)d_out; a.ws = (unsigned char*)d_ws;
#if N_LAUNCH_MODE == 1
    a.ph_lo = 0; a.ph_hi = 8;
    void* args[] = {&a};
    hipError_t e = hipLaunchCooperativeKernel((const void*)mega, dim3(grid), dim3(NTHREADS), args, LDS_BYTES, stream);
    if (e != hipSuccess) fprintf(stderr, "cooperative launch failed: %s (grid %d)\n", hipGetErrorString(e), grid);
#else
    for (int ph = 0; ph < 8; ++ph) { a.ph_lo = ph; a.ph_hi = ph + 1; hipLaunchKernelGGL(mega, dim3(grid), dim3(NTHREADS), LDS_BYTES, stream, a); }
#endif
}
```

```cpp
#include <hip/hip_runtime.h>
#include <hip/hip_cooperative_groups.h>
#include <cstdio>
namespace cg = cooperative_groups;

constexpr int L_WTAB = 149008;
static __device__ __forceinline__ unsigned mk_lane() { return __builtin_amdgcn_mbcnt_hi(~0u, __builtin_amdgcn_mbcnt_lo(~0u, 0u)); }
static __device__ __forceinline__ unsigned mk_slot() { return (unsigned)__builtin_amdgcn_s_getreg(0x2804) & 63u; }
static __device__ __forceinline__ unsigned mk_tid() {
    extern __shared__ __attribute__((aligned(16))) unsigned char mk_shm[];
    const unsigned w = ((__attribute__((address_space(3))) unsigned*)((__attribute__((address_space(3))) unsigned char*)mk_shm + L_WTAB))[mk_slot()];
    return (unsigned)__builtin_amdgcn_readfirstlane((int)w) * 64u + mk_lane();
}
namespace pg8 {
#define PG8_LAS __attribute__((address_space(3)))
typedef unsigned short bf16_t;
typedef short bf16x8 __attribute__((ext_vector_type(8)));
typedef float f32x4 __attribute__((ext_vector_type(4)));
typedef unsigned u32x4 __attribute__((ext_vector_type(4)));
constexpr int BM = 256, BK = 64, HALF = 128, HTB = HALF * BK * 2  , STAGE_BYTES = 8 * HTB, NXCD = 8, WGM = 8;

__host__ __device__ __forceinline__ int lds_byte(int r, int c) { const int st = (r >> 4) * 2 + (c >> 5), rr = r & 15, cc = c & 31, ob = rr * 64 + cc * 2; return st * 1024 + (ob ^ (((ob >> 9) & 1) << 5)); }
__host__ __device__ __forceinline__ void stage_rc(int b, int& R, int& C) { const int st = b / 1024, sb = b % 1024, swz = sb ^ (((sb >> 9) & 1) << 5); R = (st >> 1) * 16 + swz / 64; C = (st & 1) * 32 + (swz % 64) / 2; }
__host__ __device__ __forceinline__ int perm32(int rho) { const int n = rho >> 4, i = rho & 15; return 8 * (i >> 2) + 4 * n + (i & 3); }

struct Unit { int pm, pn; };
struct Gemm { const bf16_t* A; const bf16_t* Bt; int M, N, K; int ld; };

struct StaticOrder {
    int nM, nN, nwg, G, c;
    __host__ __device__ void init(int M, int N, int G_, int c_) { nM = M / BM; nN = N / BM; nwg = nM * nN; G = G_; c = c_; }
    __host__ __device__ bool next(int i, Unit& u) const {
        const long L = (long)i * G + c; if (L >= nwg) return false;
        int wgid = (int)L; { const int q = nwg / NXCD, r = nwg % NXCD, xcd = wgid % NXCD, off = wgid / NXCD; wgid = (xcd < r ? xcd * (q + 1) : r * (q + 1) + (xcd - r) * q) + off; }
        const int nig = WGM * nN, gid = wgid / nig, fm = gid * WGM, gsz = (nM - fm) < WGM ? (nM - fm) : WGM;
        u.pm = fm + ((wgid % nig) % gsz); u.pn = (wgid % nig) / gsz; return true;
    }
    __device__ __forceinline__ void a_ready(const Unit&) const {}
    __device__ __forceinline__ void done(const Unit&) const {}
};
template <class Epi, class Sched, bool STAMP = false>
__device__ __forceinline__ void gemm_phase(PG8_LAS unsigned char* lds, const Gemm g, const Sched& S, const Epi& E, unsigned long long* stamps) {
    int tid = mk_tid(); asm volatile("" : "+v"(tid));
    const int wid = __builtin_amdgcn_readfirstlane(tid >> 6), lane = tid & 63, wr = wid >> 2, wc = wid & 3, fr = lane & 15, fq = lane >> 4;
    const int K = g.K, nt = K / BK, LD = g.ld ? g.ld : g.K;
    int ts_lo = 0, ts_hi = 0, nts = 0; const unsigned long long rt_entry = STAMP ? (unsigned long long)wall_clock64() : 0ull;
#define PG8_STAMP() do { if (STAMP && wid == 0 && nts < 64) { const unsigned long long _c = (unsigned long long)clock64(); \
        ts_lo = (lane == nts) ? (int)(unsigned)_c : ts_lo; ts_hi = (lane == nts) ? (int)(unsigned)(_c >> 32) : ts_hi; ++nts; } } while (0)
    PG8_STAMP();
    unsigned voffA[2], voffB[2];
#pragma unroll
    for (int i = 0; i < 2; ++i) { int R, C; stage_rc(tid * 16 + i * 8192, R, C); const int Rb = Epi::PERM ? ((R & ~31) + perm32(R & 31)) : R;
        voffA[i] = (unsigned)(R * LD + C) * 2u; voffB[i] = (unsigned)(Rb * LD + C) * 2u; }
    const size_t kstep = (size_t)(BK * 2);
    const size_t hstep = (size_t)HALF * LD * 2;
    const size_t tstep = 2 * hstep;
    const unsigned ldsw = (unsigned)wid * 1024u;
    const int aoff = lds_byte(wr * 64 + fr, fq * 8), boff = lds_byte(wc * 32 + fr, fq * 8);
#define PG8_SA(b, h) (((b) * 2 + (h)) * HTB)
#define PG8_SB(b, h) ((4 + (b) * 2 + (h)) * HTB)
#define PG8_STAGE(bufoff, gbase, voff) do { _Pragma("unroll") for (int _i = 0; _i < 2; ++_i) \
        __builtin_amdgcn_global_load_lds((const unsigned*)((const char*)(gbase) + (voff)[_i]), (PG8_LAS unsigned*)(lds + (bufoff) + ldsw + _i * 8192), 16, 0, 0); } while (0)
#define PG8_LDA(dst, b, h) do { _Pragma("unroll") for (int m = 0; m < 4; ++m) _Pragma("unroll") for (int k = 0; k < 2; ++k) dst[m][k] = *(const PG8_LAS bf16x8*)(lds + PG8_SA(b, h) + aoff + m * 2048 + k * 1024); } while (0)
#define PG8_LDB(dst, b, h) do { _Pragma("unroll") for (int n = 0; n < 2; ++n) _Pragma("unroll") for (int k = 0; k < 2; ++k) dst[n][k] = *(const PG8_LAS bf16x8*)(lds + PG8_SB(b, h) + boff + n * 2048 + k * 1024); } while (0)
#define PG8_MMA(ai, bj, At, Bt) do { __builtin_amdgcn_s_setprio(1); _Pragma("unroll") for (int m = 0; m < 4; ++m) _Pragma("unroll") for (int n = 0; n < 2; ++n) _Pragma("unroll") for (int k = 0; k < 2; ++k) \
        acc[ai][bj][m][n] = __builtin_amdgcn_mfma_f32_16x16x32_bf16(Bt[n][k], At[m][k], acc[ai][bj][m][n], 0, 0, 0); __builtin_amdgcn_s_setprio(0); } while (0)
#define PG8_WAIT_V(n) asm volatile("s_waitcnt vmcnt(" #n ")" ::: "memory")
#define PG8_WAIT_L(n) asm volatile("s_waitcnt lgkmcnt(" #n ")" ::: "memory")
#define PG8_BAR __builtin_amdgcn_s_barrier()
#define PG8_SCHED __builtin_amdgcn_sched_barrier(0)
    Unit cur, nxt; int ui = 0;
    if (!S.next(0, cur)) return;
    f32x4 acc[2][2][4][2];
#pragma unroll
    for (int a = 0; a < 2; ++a)
#pragma unroll
        for (int b = 0; b < 2; ++b)
#pragma unroll
            for (int m = 0; m < 4; ++m)
#pragma unroll
                for (int n = 0; n < 2; ++n) acc[a][b][m][n] = (f32x4){0.f, 0.f, 0.f, 0.f};
    bf16x8 At[4][2], B0[2][2], B1[2][2];
    const char* cA = (const char*)g.A + (size_t)cur.pm * tstep; const char* cB = (const char*)g.Bt + (size_t)cur.pn * tstep;
    S.a_ready(cur);
    PG8_STAGE(PG8_SB(0, 0), cB, voffB); PG8_STAGE(PG8_SA(0, 0), cA, voffA); PG8_STAGE(PG8_SB(0, 1), cB + hstep, voffB); PG8_STAGE(PG8_SA(0, 1), cA + hstep, voffA);
    if (wr == 1) PG8_BAR;
    PG8_WAIT_V(4); PG8_BAR;
    PG8_STAGE(PG8_SB(1, 0), cB + kstep, voffB); PG8_STAGE(PG8_SA(1, 0), cA + kstep, voffA); PG8_STAGE(PG8_SB(1, 1), cB + hstep + kstep, voffB);
    PG8_WAIT_V(6); PG8_BAR;
    PG8_STAMP();
    for (;;) {
        float rqv[8]; E.pre(cur, wr, fr, rqv);
        const bool has_next = S.next(ui + 1, nxt);
        const char* nA = has_next ? (const char*)g.A + (size_t)nxt.pm * tstep : cA; const char* nB = has_next ? (const char*)g.Bt + (size_t)nxt.pn * tstep : cB;
        for (int t = 0; t < nt; t += 2) {
            const bool last = (t == nt - 2);
            const char* a1 = cA + (size_t)(t + 1) * kstep;
            const char* a2 = last ? nA : cA + (size_t)(t + 2) * kstep; const char* b2 = last ? nB : cB + (size_t)(t + 2) * kstep;
            const char* a3 = a2 + kstep; const char* b3 = b2 + kstep;
            if (last && has_next) S.a_ready(nxt);
            PG8_LDB(B0, 0, 0); PG8_SCHED; PG8_LDA(At, 0, 0); PG8_STAGE(PG8_SA(1, 1), a1 + hstep, voffA);
            PG8_WAIT_L(8); PG8_BAR; PG8_WAIT_L(0); PG8_MMA(0, 0, At, B0); PG8_BAR; PG8_SCHED;
            PG8_LDB(B1, 0, 1); PG8_STAGE(PG8_SB(0, 0), b2, voffB);
            PG8_BAR; PG8_WAIT_L(0); PG8_MMA(0, 1, At, B1); PG8_BAR;
            PG8_LDA(At, 0, 1); PG8_STAGE(PG8_SA(0, 0), a2, voffA);
            PG8_BAR; PG8_WAIT_L(0); PG8_MMA(1, 0, At, B0); PG8_BAR; PG8_SCHED;
            PG8_STAGE(PG8_SB(0, 1), b2 + hstep, voffB);
            PG8_WAIT_V(6); PG8_BAR; PG8_MMA(1, 1, At, B1); PG8_BAR;
            PG8_LDB(B0, 1, 0); PG8_SCHED; PG8_LDA(At, 1, 0); PG8_STAGE(PG8_SA(0, 1), a2 + hstep, voffA);
            PG8_WAIT_L(8); PG8_BAR; PG8_WAIT_L(0); PG8_MMA(0, 0, At, B0); PG8_BAR; PG8_SCHED;
            PG8_LDB(B1, 1, 1); PG8_STAGE(PG8_SB(1, 0), b3, voffB);
            PG8_BAR; PG8_WAIT_L(0); PG8_MMA(0, 1, At, B1); PG8_BAR;
            PG8_LDA(At, 1, 1); PG8_STAGE(PG8_SA(1, 0), a3, voffA);
            PG8_BAR; PG8_WAIT_L(0); PG8_MMA(1, 0, At, B0); PG8_BAR; PG8_SCHED;
            PG8_STAGE(PG8_SB(1, 1), b3 + hstep, voffB);
            PG8_WAIT_V(6); PG8_BAR; PG8_MMA(1, 1, At, B1); PG8_BAR;
        }
        PG8_STAMP();
        if constexpr (!Epi::AFTER_DRAIN) { E(acc, cur, wr, wc, fr, fq, rqv); S.done(cur); }
        PG8_STAMP();
        if (!has_next) break;
#pragma unroll
        for (int a = 0; a < 2; ++a)
#pragma unroll
            for (int b = 0; b < 2; ++b)
#pragma unroll
                for (int m = 0; m < 4; ++m)
#pragma unroll
                    for (int n = 0; n < 2; ++n) acc[a][b][m][n] = (f32x4){0.f, 0.f, 0.f, 0.f};
        cur = nxt; cA = nA; cB = nB; ++ui;
    }
    PG8_WAIT_V(0);
    if (wr == 0) PG8_BAR;
    PG8_BAR;
    if constexpr (Epi::AFTER_DRAIN) { E.fused(acc, cur, wr, wc, fr, fq, lds, wid, lane); S.done(cur); }
    PG8_STAMP();
    if (STAMP && wid == 0) { stamps[lane] = lane < nts ? (((unsigned long long)(unsigned)ts_hi << 32) | (unsigned)ts_lo) : 0ull;
        if (lane == 62) stamps[62] = rt_entry; if (lane == 63) stamps[63] = (unsigned long long)wall_clock64(); }
#undef PG8_STAMP
#undef PG8_SA
#undef PG8_SB
#undef PG8_STAGE
#undef PG8_LDA
#undef PG8_LDB
#undef PG8_MMA
#undef PG8_WAIT_V
#undef PG8_WAIT_L
#undef PG8_BAR
#undef PG8_SCHED
}
}
#define LAS __attribute__((address_space(3)))
using pg8::bf16_t; using pg8::bf16x8; using pg8::f32x4; using pg8::u32x4;
typedef float f32x16 __attribute__((ext_vector_type(16)));
typedef float f32x2v __attribute__((ext_vector_type(2)));
typedef __bf16 bf16x2v __attribute__((ext_vector_type(2)));
typedef unsigned u32x2 __attribute__((ext_vector_type(2)));
#define DI __device__ __forceinline__
#define MFMA32(a, b, c) __builtin_amdgcn_mfma_f32_32x32x16_bf16((a), (b), (c), 0, 0, 0)

constexpr int D = 1024, NTP = 16384, NTS = 512, NT = NTP + NTS;
constexpr int NPROJ = 3584, INDIM = 3592, DFF = 4096, PLE = 256;
constexpr float EPS = 1e-6f;
constexpr int NTHREADS = 512;
constexpr int LDS_BYTES = 149008 + 256;
constexpr size_t WS_WIN = 0;
constexpr size_t WS_WOUT = WS_WIN + (size_t)NPROJ * D * 2;
constexpr size_t WS_WUP = WS_WOUT + (size_t)D * D * 2;
constexpr size_t WS_WDN = WS_WUP + (size_t)DFF * D * 2;
constexpr size_t WS_WG = WS_WDN + (size_t)D * DFF * 2;
constexpr size_t WS_WP = WS_WG + (size_t)D * D * 2;
constexpr size_t WS_CTL = WS_WP + (size_t)D * PLE * 2;
constexpr size_t CTL_RS0 = 0, CTL_SS1 = NT, CTL_SS2 = 2 * NT, CTL_SS3 = 3 * NT, CTL_LA = 4 * NT, CTL_BETA = 8 * NT, CTL_GL = 12 * NT, CTL_FLOATS = 12 * NT + 1024;
constexpr size_t WS_PB = WS_CTL + ((CTL_FLOATS * 4 + 4095) / 4096) * 4096;
constexpr size_t WS_A = WS_PB + (size_t)NT * PLE * 2;
constexpr size_t WS_B = WS_A + (size_t)NT * D * 2;
constexpr size_t WS_C = WS_B + (size_t)NT * DFF * 2;
constexpr size_t WS_BAR = WS_C + (size_t)NT * D * 2;
constexpr size_t WS_FLAGS = WS_BAR + 16384;
constexpr size_t WS_PCNT = WS_BAR + 20480;
constexpr size_t WS_PPS = WS_BAR + 32768;
constexpr size_t WS_END = WS_PPS + (size_t)NTS * D * 2;
constexpr size_t OFF_Y = 0, OFF_GCP = 17301504, OFF_GP = 17338368, OFF_SCP = 17862656, OFF_GCS = 17870848, OFF_GS = 18460672, OFF_SCS = 26849280;

struct Ctx {
    const float* x_prompt; const float* x_sample; const float* state_gdn_conv; const float* state_gdn; const float* state_sc_conv; const float* p_prompt; const float* p_sample;
    const float* norm_mix; const float* w_in; const float* w_conv_qkv; const float* a_log; const float* dt_bias; const float* w_gdn_norm; const float* w_conv_sc; const float* w_out;
    const float* norm_mlp; const float* w_up; const float* w_down; const float* norm_ple; const float* w_ple_gate; const float* w_ple_proj; const float* norm_f;
    float* out; unsigned char* ws; int ph_lo, ph_hi;
};

DI unsigned pk2(float lo, float hi) { f32x2v v = {lo, hi}; return __builtin_bit_cast(unsigned, __builtin_convertvector(v, bf16x2v)); }
DI bf16_t f2bf(float f) { return (bf16_t)(pk2(f, 0.f) & 0xffffu); }
DI float bf2f(bf16_t b) { return __uint_as_float((unsigned)b << 16); }
DI float bflo(unsigned u) { return __uint_as_float(u << 16); }
DI float bfhi(unsigned u) { return __uint_as_float(u & 0xffff0000u); }
DI void unpack8(const u32x4 v, float* f) { f[0] = bflo(v.x); f[1] = bfhi(v.x); f[2] = bflo(v.y); f[3] = bfhi(v.y); f[4] = bflo(v.z); f[5] = bfhi(v.z); f[6] = bflo(v.w); f[7] = bfhi(v.w); }
DI u32x4 pack8(const float* f) { u32x4 w; w.x = pk2(f[0], f[1]); w.y = pk2(f[2], f[3]); w.z = pk2(f[4], f[5]); w.w = pk2(f[6], f[7]); return w; }
DI void st16_wt(void* ptr, const u32x4 v) { asm volatile("global_store_dwordx4 %0, %1, off sc0 sc1\n\ts_nop 2" :: "v"(ptr), "v"(v) : "memory"); }
DI int crow(int reg, int h) { return (reg & 3) + 8 * (reg >> 2) + 4 * h; }
DI int swap23(int p) { return (p & ~12) | ((p & 4) << 1) | ((p & 8) >> 1); }
DI bf16x8 pack_step(const f32x16& x, int s) {
    u32x4 p; p.x = pk2(x[8 * s], x[8 * s + 1]); p.y = pk2(x[8 * s + 2], x[8 * s + 3]); p.z = pk2(x[8 * s + 4], x[8 * s + 5]); p.w = pk2(x[8 * s + 6], x[8 * s + 7]);
    return __builtin_bit_cast(bf16x8, p);
}
DI float sigmoidf_(float x) { return __builtin_amdgcn_rcpf(1.0f + __expf(-x)); }
DI float siluf_(float x) { return x * __builtin_amdgcn_rcpf(1.0f + __expf(-x)); }

struct EpiProj {
    static constexpr bool PERM = true, AFTER_DRAIN = false;
    bf16_t* O; int ldc; const float* rs; int wt = 0;
    DI void pre(const pg8::Unit& u, int wr, int fr, float (&rq)[8]) const { const int row0 = u.pm * 256 + wr * 64 + fr;
#pragma unroll
        for (int g = 0; g < 8; ++g) rq[g] = rs ? rs[row0 + (g >> 2) * 128 + (g & 3) * 16] : 1.0f; }
    DI void operator()(const f32x4 (&acc)[2][2][4][2], const pg8::Unit& u, int wr, int wc, int fr, int fq, const float (&rq)[8]) const {
        const int row0 = u.pm * 256 + wr * 64 + fr, col0 = u.pn * 256 + wc * 32 + 8 * fq;
#pragma unroll
        for (int ai = 0; ai < 2; ++ai)
#pragma unroll
            for (int m = 0; m < 4; ++m) { const int row = row0 + ai * 128 + m * 16; const float r = rq[ai * 4 + m]; bf16_t* rowp = O + (size_t)row * ldc + col0;
#pragma unroll
                for (int bj = 0; bj < 2; ++bj) { const f32x4 v0 = acc[ai][bj][m][0] * r, v1 = acc[ai][bj][m][1] * r;
                    u32x4 w; w.x = pk2(v0[0], v0[1]); w.y = pk2(v0[2], v0[3]); w.z = pk2(v1[0], v1[1]); w.w = pk2(v1[2], v1[3]);
                    if (wt) st16_wt(rowp + bj * 128, w); else *(u32x4*)(rowp + bj * 128) = w; } }
    }
};
struct EpiUp {
    static constexpr bool PERM = true, AFTER_DRAIN = false;
    bf16_t* O; const float* ss; int wt = 0;
    DI void pre(const pg8::Unit& u, int wr, int fr, float (&rq)[8]) const { const int row0 = u.pm * 256 + wr * 64 + fr;
#pragma unroll
        for (int g = 0; g < 8; ++g) rq[g] = ss[row0 + (g >> 2) * 128 + (g & 3) * 16]; }
    DI void operator()(const f32x4 (&acc)[2][2][4][2], const pg8::Unit& u, int wr, int wc, int fr, int fq, const float (&rq)[8]) const {
        const int row0 = u.pm * 256 + wr * 64 + fr, col0 = u.pn * 256 + wc * 32 + 8 * fq;
#pragma unroll
        for (int ai = 0; ai < 2; ++ai)
#pragma unroll
            for (int m = 0; m < 4; ++m) { const int row = row0 + ai * 128 + m * 16; const float r = rsqrtf(rq[ai * 4 + m] * (1.0f / 1024.0f) + EPS); bf16_t* rowp = O + (size_t)row * DFF + col0;
#pragma unroll
                for (int bj = 0; bj < 2; ++bj) { f32x4 v0 = acc[ai][bj][m][0] * r, v1 = acc[ai][bj][m][1] * r;
#pragma unroll
                    for (int j = 0; j < 4; ++j) { v0[j] = fmaxf(v0[j], 0.f); v0[j] *= v0[j]; v1[j] = fmaxf(v1[j], 0.f); v1[j] *= v1[j]; }
                    u32x4 w; w.x = pk2(v0[0], v0[1]); w.y = pk2(v0[2], v0[3]); w.z = pk2(v1[0], v1[1]); w.w = pk2(v1[2], v1[3]);
                    if (wt) st16_wt(rowp + bj * 128, w); else *(u32x4*)(rowp + bj * 128) = w; } }
    }
};
template <int MODE> struct EpiRes {
    static constexpr bool PERM = true, AFTER_DRAIN = false;
    const float* xp; const float* xs; bf16_t* XB; bf16_t* XO; float* ssn; const float* ssp; const bf16_t* PP; int wt = 0;
    DI void loadbase(int row, int col0, u32x4 (&b)[4]) const {
        const size_t off = (size_t)row * D + col0;
        if (MODE == 0) { const float* bp = (row < NTP ? xp + off : xs + (off - (size_t)NTP * D));
            b[0] = *(const u32x4*)bp; b[1] = *(const u32x4*)(bp + 4); b[2] = *(const u32x4*)(bp + 128); b[3] = *(const u32x4*)(bp + 132); }
        else { b[0] = *(const u32x4*)(XB + off); b[2] = *(const u32x4*)(XB + off + 128);
            if (MODE == 2) { b[1] = *(const u32x4*)(PP + off); b[3] = *(const u32x4*)(PP + off + 128); } else { b[1] = b[0]; b[3] = b[2]; } }
    }
    DI void pre(const pg8::Unit&, int, int, float (&rqx)[8]) const {
#pragma unroll
        for (int g = 0; g < 8; ++g) rqx[g] = 0.f; }
    DI void operator()(const f32x4 (&acc)[2][2][4][2], const pg8::Unit& u, int wr, int wc, int fr, int fq, const float (&)[8]) const {
        const int row0 = u.pm * 256 + wr * 64 + fr, col0 = u.pn * 256 + wc * 32 + 8 * fq;
        float rq[8];
        if (MODE == 2) {
#pragma unroll
            for (int g = 0; g < 8; ++g) rq[g] = ssp[row0 + (g >> 2) * 128 + (g & 3) * 16]; }
        u32x4 nb[4]; loadbase(row0, col0, nb);
#pragma unroll
        for (int g = 0; g < 8; ++g) { const int ai = g >> 2, m = g & 3; const int row = row0 + ai * 128 + m * 16; const size_t off = (size_t)row * D + col0;
            u32x4 cb[4];
#pragma unroll
            for (int q = 0; q < 4; ++q) cb[q] = nb[q];
            if (g < 7) loadbase(row0 + ((g + 1) >> 2) * 128 + ((g + 1) & 3) * 16, col0, nb);
            float r = 1.f; if (MODE == 2) r = rsqrtf(rq[g] * (1.0f / 1024.0f) + EPS);
            float sq = 0.f;
#pragma unroll
            for (int bj = 0; bj < 2; ++bj) { float v[8];
#pragma unroll
                for (int j = 0; j < 4; ++j) { v[j] = acc[ai][bj][m][0][j]; v[4 + j] = acc[ai][bj][m][1][j]; }
                if (MODE == 2) { float pf[8]; unpack8(cb[2 * bj + 1], pf);
#pragma unroll
                    for (int j = 0; j < 8; ++j) v[j] = sigmoidf_(v[j] * r) * pf[j]; }
                if (MODE == 0) { const f32x4 b0 = __builtin_bit_cast(f32x4, cb[2 * bj]), b1 = __builtin_bit_cast(f32x4, cb[2 * bj + 1]);
#pragma unroll
                    for (int j = 0; j < 4; ++j) { v[j] += b0[j]; v[4 + j] += b1[j]; } }
                else { float bf[8]; unpack8(cb[2 * bj], bf);
#pragma unroll
                    for (int j = 0; j < 8; ++j) v[j] += bf[j]; }
                if (wt) st16_wt((MODE == 2 ? XO : XB) + off + bj * 128, pack8(v)); else *(u32x4*)((MODE == 2 ? XO : XB) + off + bj * 128) = pack8(v);
#pragma unroll
                for (int j = 0; j < 8; ++j) sq += v[j] * v[j]; }
            sq += __shfl_xor(sq, 16); sq += __shfl_xor(sq, 32);
            if (fq == 0) atomicAdd(ssn + row, sq); }
    }
};
struct SubOrder {
    int pm0, nM, nN, G, c;
    DI bool next(int i, pg8::Unit& u) const { const int L = i * G + c; if (c < 0 || L >= nM * nN) return false; u.pm = pm0 + L % nM; u.pn = L / nM; return true; }
    DI void a_ready(const pg8::Unit&) const {}
    DI void done(const pg8::Unit&) const {}
};
constexpr size_t SLAB_OFF = 123000064;
constexpr size_t SLAB_FLOATS = (size_t)NTS * D;
struct EpiSplitK {
    static constexpr bool PERM = true, AFTER_DRAIN = true;
    DI void pre(const pg8::Unit&, int, int, float (&)[8]) const {}
    float* SLAB; int kq; bf16_t* XB; float* ssn; unsigned* cnt;
    DI void fused(f32x4 (&acc)[2][2][4][2], const pg8::Unit& u, int wr, int wc, int fr, int fq, LAS unsigned char* lds, int wid, int lane) const {
        const int row0 = u.pm * 256 + wr * 64 + fr, col0 = u.pn * 256 + wc * 32 + 8 * fq;
        float* mine = SLAB + (size_t)kq * SLAB_FLOATS - (size_t)NTP * D;
#pragma unroll
        for (int ai = 0; ai < 2; ++ai)
#pragma unroll
            for (int m = 0; m < 4; ++m) { float* rowp = mine + (size_t)(row0 + ai * 128 + m * 16) * D + col0;
#pragma unroll
                for (int bj = 0; bj < 2; ++bj) { st16_wt(rowp + bj * 128, __builtin_bit_cast(u32x4, acc[ai][bj][m][0])); st16_wt(rowp + bj * 128 + 4, __builtin_bit_cast(u32x4, acc[ai][bj][m][1])); } }
        asm volatile("s_waitcnt vmcnt(0)" ::: "memory");
        __syncthreads();
        volatile LAS unsigned* flag = (volatile LAS unsigned*)lds;
        if (wid == 0 && lane == 0) { const unsigned t = __hip_atomic_fetch_add(cnt + ((u.pm - 64) * 4 + u.pn) * 32, 1u, __ATOMIC_RELAXED, __HIP_MEMORY_SCOPE_AGENT);
            __builtin_amdgcn_fence(__ATOMIC_ACQUIRE, "agent"); asm volatile("s_waitcnt vmcnt(0)" ::: "memory"); flag[0] = (t == 3u) ? 1u : 0u; }
        __syncthreads();
        if (flag[0] != 0u) {
#pragma unroll
            for (int ai = 0; ai < 2; ++ai)
#pragma unroll
                for (int m = 0; m < 4; ++m) { const int row = row0 + ai * 128 + m * 16; const size_t off = (size_t)row * D + col0; float sq = 0.f;
#pragma unroll
                    for (int bj = 0; bj < 2; ++bj) { float v[8]; unpack8(*(const u32x4*)(XB + off + bj * 128), v);
#pragma unroll
                        for (int q = 0; q < 4; ++q) { const float* sp = SLAB + (size_t)q * SLAB_FLOATS + (off - (size_t)NTP * D) + bj * 128; const f32x4 a0 = *(const f32x4*)sp, a1 = *(const f32x4*)(sp + 4);
#pragma unroll
                            for (int j = 0; j < 4; ++j) { v[j] += a0[j]; v[4 + j] += a1[j]; } }
                        st16_wt(XB + off + bj * 128, pack8(v));
#pragma unroll
                        for (int j = 0; j < 8; ++j) sq += v[j] * v[j]; }
                    sq += __shfl_xor(sq, 16); sq += __shfl_xor(sq, 32);
                    if (fq == 0) atomicAdd(ssn + row, sq); }
        }
    }
};
struct EpiFinal {
    static constexpr bool PERM = true, AFTER_DRAIN = true;
    DI void pre(const pg8::Unit&, int, int, float (&)[8]) const {}
    const bf16_t* XB; const bf16_t* PP; const float* ssp; float* ssn; unsigned* cnt; const float* normf; float* Y;
    DI void fused(f32x4 (&acc)[2][2][4][2], const pg8::Unit& u, int wr, int wc, int fr, int fq, LAS unsigned char* lds, int wid, int lane) const {
        const int row0 = u.pm * 256 + wr * 64 + fr, col0 = u.pn * 256 + wc * 32 + 8 * fq;
        float rq[8];
#pragma unroll
        for (int g = 0; g < 8; ++g) rq[g] = ssp[row0 + (g >> 2) * 128 + (g & 3) * 16];
        u32x4 nb[4];
        { const size_t off = (size_t)row0 * D + col0; nb[0] = *(const u32x4*)(PP + off); nb[1] = *(const u32x4*)(XB + off); nb[2] = *(const u32x4*)(PP + off + 128); nb[3] = *(const u32x4*)(XB + off + 128); }
#pragma unroll
        for (int g = 0; g < 8; ++g) { const int ai = g >> 2, m = g & 3; const int row = row0 + ai * 128 + m * 16;
            u32x4 cb[4];
#pragma unroll
            for (int q = 0; q < 4; ++q) cb[q] = nb[q];
            if (g < 7) { const size_t off = (size_t)(row0 + ((g + 1) >> 2) * 128 + ((g + 1) & 3) * 16) * D + col0;
                nb[0] = *(const u32x4*)(PP + off); nb[1] = *(const u32x4*)(XB + off); nb[2] = *(const u32x4*)(PP + off + 128); nb[3] = *(const u32x4*)(XB + off + 128); }
            const float r = rsqrtf(rq[g] * (1.0f / 1024.0f) + EPS); float sq = 0.f;
#pragma unroll
            for (int bj = 0; bj < 2; ++bj) { float pf[8], bf[8]; unpack8(cb[2 * bj], pf); unpack8(cb[2 * bj + 1], bf);
#pragma unroll
                for (int j = 0; j < 4; ++j) { const float a = sigmoidf_(acc[ai][bj][m][0][j] * r) * pf[j] + bf[j], b = sigmoidf_(acc[ai][bj][m][1][j] * r) * pf[4 + j] + bf[4 + j];
                    acc[ai][bj][m][0][j] = a; acc[ai][bj][m][1][j] = b; sq += a * a + b * b; } }
            sq += __shfl_xor(sq, 16); sq += __shfl_xor(sq, 32);
            if (fq == 0) atomicAdd(ssn + row, sq); }
        asm volatile("s_waitcnt vmcnt(0)" ::: "memory");
        __syncthreads();
        if (mk_tid() == 0) { unsigned* cw = cnt + u.pm * 32; (void)__hip_atomic_fetch_add(cw, 1u, __ATOMIC_RELAXED, __HIP_MEMORY_SCOPE_AGENT);
            unsigned sp = 0u; while (__hip_atomic_load(cw, __ATOMIC_RELAXED, __HIP_MEMORY_SCOPE_AGENT) < 4u) { __builtin_amdgcn_s_sleep(1); if (++sp > (1u << 22)) break; }
            __builtin_amdgcn_fence(__ATOMIC_ACQUIRE, "agent"); asm volatile("s_waitcnt vmcnt(0)" ::: "memory"); }
        __syncthreads();
        float sq8[8]; f32x4 wv[2][2];
#pragma unroll
        for (int g = 0; g < 8; ++g) sq8[g] = __hip_atomic_load(ssn + row0 + (g >> 2) * 128 + (g & 3) * 16, __ATOMIC_RELAXED, __HIP_MEMORY_SCOPE_AGENT);
#pragma unroll
        for (int bj = 0; bj < 2; ++bj) { wv[bj][0] = *(const f32x4*)(normf + col0 + bj * 128); wv[bj][1] = *(const f32x4*)(normf + col0 + bj * 128 + 4); }
#pragma unroll
        for (int ai = 0; ai < 2; ++ai)
#pragma unroll
            for (int m = 0; m < 4; ++m) { const int row = row0 + ai * 128 + m * 16; const size_t off = (size_t)row * D + col0;
                const float rs = rsqrtf(sq8[ai * 4 + m] * (1.0f / 1024.0f) + EPS);
#pragma unroll
                for (int bj = 0; bj < 2; ++bj) { *(f32x4*)(Y + off + bj * 128) = acc[ai][bj][m][0] * rs * wv[bj][0]; *(f32x4*)(Y + off + bj * 128 + 4) = acc[ai][bj][m][1] * rs * wv[bj][1]; } }
    }
};
#define XB_TMO      128
#define XB_XCNT(j)  (256  + 64 * (j))
#define XB_XSUB(j)  (1280 + 64 * (j))
#define XB_XGEN(j)  (2304 + 64 * (j))
#define XB_TOP      3328
#define XB_TOPGEN   3392
#define XCD_BAR_WORDS 3456
#define XB_SPIN_CAP (1u << 18)

__device__ __forceinline__ unsigned xb_ld(unsigned* p)              { return __hip_atomic_load(p, __ATOMIC_RELAXED, __HIP_MEMORY_SCOPE_AGENT); }
__device__ __forceinline__ unsigned xb_add(unsigned* p, unsigned v) { return __hip_atomic_fetch_add(p, v, __ATOMIC_RELAXED, __HIP_MEMORY_SCOPE_AGENT); }
__device__ __forceinline__ unsigned xb_xcc_id() { return (unsigned)__builtin_amdgcn_s_getreg((3 << 11) | 20) & 0xFu; }
#define XB_SPIN(cond, bar) do { unsigned _sp = 0; while (cond) { __builtin_amdgcn_s_sleep(1); \
    if ((++_sp & 255u) == 0u) { if (xb_ld(&(bar)[XB_TMO])) break; if (_sp > XB_SPIN_CAP) { atomicAdd(&(bar)[XB_TMO], 1u); break; } } } } while (0)

struct XcdBarrier {
    unsigned* bar; unsigned x;
    volatile LAS unsigned* st;
};

__device__ __forceinline__ XcdBarrier xcd_barrier_post(unsigned* bar, volatile LAS unsigned* st) {
    XcdBarrier b; b.bar = bar; b.x = xb_xcc_id(); b.st = st;
    if (mk_tid() == 0) (void)xb_add(&bar[XB_XCNT(b.x)], 1u);
    return b;
}
__device__ __forceinline__ void xcd_barrier_complete(unsigned* bar, unsigned x, unsigned& nloc, unsigned& nx) {
    const unsigned G = gridDim.x * gridDim.y * gridDim.z;
    unsigned sum, cnt, mine, sp = 0u;
    for (;;) {
        sum = 0u; cnt = 0u; mine = 0u;
#pragma unroll
        for (unsigned j = 0; j < 16; ++j) { const unsigned c = xb_ld(&bar[XB_XCNT(j)]); sum += c; cnt += (c > 0u) ? 1u : 0u; mine = (j == x) ? c : mine; }
        if (sum == G) break;
        __builtin_amdgcn_s_sleep(1);
        if ((++sp & 255u) == 0u) { if (xb_ld(&bar[XB_TMO])) break; if (sp > XB_SPIN_CAP) { atomicAdd(&bar[XB_TMO], 1u); break; } }
    }
    nloc = mine > 0u ? mine : 1u; nx = cnt > 0u ? cnt : 1u;
}

__device__ __forceinline__ void xcd_barrier(const XcdBarrier& b) {
    asm volatile("s_waitcnt vmcnt(0)" ::: "memory");
    __syncthreads();
    if (mk_tid() == 0) {
        unsigned* bar = b.bar;
        __builtin_amdgcn_s_waitcnt(0);
        unsigned nloc = b.st[0], nx = b.st[1];
        if (nloc == 0u) { xcd_barrier_complete(bar, b.x, nloc, nx); b.st[0] = nloc; b.st[1] = nx; }
        const unsigned old = xb_add(&bar[XB_XSUB(b.x)], 1u);
        const unsigned gen = old / nloc;
        if (old + 1u == (gen + 1u) * nloc) {
            __builtin_amdgcn_fence(__ATOMIC_RELEASE, "agent");
            asm volatile("s_waitcnt vmcnt(0)" ::: "memory");
            const unsigned og = xb_add(&bar[XB_TOP], 1u);
            const unsigned tg = og / nx;
            if (og + 1u == (tg + 1u) * nx) xb_add(&bar[XB_TOPGEN], 1u);
            else XB_SPIN(xb_ld(&bar[XB_TOPGEN]) == tg, bar);
            __builtin_amdgcn_fence(__ATOMIC_ACQUIRE, "agent");
            xb_add(&bar[XB_XGEN(b.x)], 1u);
            asm volatile("s_waitcnt vmcnt(0)" ::: "memory");
        } else {
            XB_SPIN(xb_ld(&bar[XB_XGEN(b.x)]) == gen, bar);
            __builtin_amdgcn_fence(__ATOMIC_ACQUIRE, "agent");
            asm volatile("s_waitcnt vmcnt(0)" ::: "memory");
        }
    }
    __syncthreads();
}
struct TileDesc { const float* W; const float* nrm; bf16_t* Wt; int ldw, K, k0, n0src, n0dst; };
DI TileDesc p0_tile(const Ctx& c, unsigned char* ws, int t) {
    TileDesc d;
    if (t < 896) { const int kt = t / 56, nt = t % 56, n0 = nt * 64; d = TileDesc{c.w_in, c.norm_mix, (bf16_t*)(ws + WS_WIN), INDIM, D, kt * 64, n0 < 1536 ? n0 : n0 + 8, n0}; return d; }
    t -= 896;
    if (t < 256) { d = TileDesc{c.w_out, nullptr, (bf16_t*)(ws + WS_WOUT), D, D, (t / 16) * 64, (t % 16) * 64, (t % 16) * 64}; return d; }
    t -= 256;
    if (t < 1024) { d = TileDesc{c.w_up, c.norm_mlp, (bf16_t*)(ws + WS_WUP), DFF, D, (t / 64) * 64, (t % 64) * 64, (t % 64) * 64}; return d; }
    t -= 1024;
    if (t < 1024) { d = TileDesc{c.w_down, nullptr, (bf16_t*)(ws + WS_WDN), D, DFF, (t / 16) * 64, (t % 16) * 64, (t % 16) * 64}; return d; }
    t -= 1024;
    if (t < 256) { d = TileDesc{c.w_ple_gate, c.norm_ple, (bf16_t*)(ws + WS_WG), D, D, (t / 16) * 64, (t % 16) * 64, (t % 16) * 64}; return d; }
    t -= 256;
    d = TileDesc{c.w_ple_proj, nullptr, (bf16_t*)(ws + WS_WP), D, PLE, (t / 16) * 64, (t % 16) * 64, (t % 16) * 64}; return d;
}
DI void tile_load(const TileDesc& d, float (&v)[8]) {
    const int tid = mk_tid();
#pragma unroll
    for (int i = 0; i < 8; ++i) { const int kk = i * 8 + (tid >> 6), nn = tid & 63; float x = d.W[(size_t)(d.k0 + kk) * d.ldw + d.n0src + nn]; if (d.nrm) x *= d.nrm[d.k0 + kk]; v[i] = x; }
}
DI void tile_store(const TileDesc& d, const float (&v)[8], LAS float* tile) {
    const int tid = mk_tid();
#pragma unroll
    for (int i = 0; i < 8; ++i) { const int kk = i * 8 + (tid >> 6), nn = tid & 63; tile[kk * 65 + nn] = v[i]; }
    __syncthreads();
    { const int nn = tid >> 3, kq = tid & 7; float f[8];
#pragma unroll
      for (int e = 0; e < 8; ++e) f[e] = tile[(kq * 8 + e) * 65 + nn];
      *(u32x4*)(d.Wt + (size_t)(d.n0dst + nn) * d.K + d.k0 + kq * 8) = pack8(f); }
    __syncthreads();
}
constexpr int P0_TILES = 2520;
DI void tiles_range(const Ctx& c, unsigned char* ws, LAS float* tile, int first, int stride, int hi) {
    int tl = first; float va[8], vb[8];
    if (tl < hi) { TileDesc d = p0_tile(c, ws, tl); tile_load(d, va);
        for (;;) {
            const int tn = tl + stride; TileDesc dn = d;
            if (tn < hi) { dn = p0_tile(c, ws, tn); tile_load(dn, vb); }
            tile_store(d, va, tile);
            if (tn >= hi) break;
#pragma unroll
            for (int i = 0; i < 8; ++i) va[i] = vb[i];
            d = dn; tl = tn;
        } }
}
DI void p0_phase(const Ctx& c, LAS unsigned char* lds) {
    const int tid = mk_tid(), lane = tid & 63, wid = tid >> 6;
    unsigned char* ws = c.ws;
    float* ctl = (float*)(ws + WS_CTL);
    bf16_t* XB = (bf16_t*)(ws + WS_A); bf16_t* PB = (bf16_t*)(ws + WS_PB);
    LAS float* wab = (LAS float*)lds;
    for (int i = tid; i < 1024 * 8; i += NTHREADS) { const int k = i >> 3, j = i & 7; wab[i] = c.w_in[(size_t)k * INDIM + 1536 + j] * c.norm_mix[k]; }
    __syncthreads();
    float xn[16]; f32x4 x4n[4], p4n;
#pragma unroll
    for (int i = 0; i < 4; ++i) x4n[i] = (f32x4){0.f, 0.f, 0.f, 0.f};
    p4n = (f32x4){0.f, 0.f, 0.f, 0.f};
    { const int row = blockIdx.x * 8 + wid; if (row < NT) { const float* xr = row < NTP ? c.x_prompt + (size_t)row * D : c.x_sample + (size_t)(row - NTP) * D;
        const float* pr0 = row < NTP ? c.p_prompt + (size_t)row * PLE : c.p_sample + (size_t)(row - NTP) * PLE;
#pragma unroll
        for (int i = 0; i < 16; ++i) xn[i] = xr[i * 64 + lane];
#pragma unroll
        for (int i = 0; i < 4; ++i) x4n[i] = *(const f32x4*)(xr + i * 256 + lane * 4);
        p4n = *(const f32x4*)(pr0 + lane * 4); } }
    for (int row = blockIdx.x * 8 + wid; row < NT; row += gridDim.x * 8) {
        const float* xr = row < NTP ? c.x_prompt + (size_t)row * D : c.x_sample + (size_t)(row - NTP) * D;
        const float* pr = row < NTP ? c.p_prompt + (size_t)row * PLE : c.p_sample + (size_t)(row - NTP) * PLE;
        float xc[16]; f32x4 x4c[4]; const f32x4 p4c = p4n;
#pragma unroll
        for (int i = 0; i < 16; ++i) xc[i] = xn[i];
#pragma unroll
        for (int i = 0; i < 4; ++i) x4c[i] = x4n[i];
        { const int rown = row + gridDim.x * 8; if (rown < NT) { const float* xq = rown < NTP ? c.x_prompt + (size_t)rown * D : c.x_sample + (size_t)(rown - NTP) * D;
            const float* pq = rown < NTP ? c.p_prompt + (size_t)rown * PLE : c.p_sample + (size_t)(rown - NTP) * PLE;
#pragma unroll
            for (int i = 0; i < 4; ++i) x4n[i] = *(const f32x4*)(xq + i * 256 + lane * 4);
            p4n = *(const f32x4*)(pq + lane * 4);
#pragma unroll
            for (int i = 0; i < 16; ++i) xn[i] = xq[i * 64 + lane]; } }
        float ss = 0.f, dot[8];
#pragma unroll
        for (int j = 0; j < 8; ++j) dot[j] = 0.f;
#pragma unroll
        for (int i = 0; i < 16; ++i) { const int k = i * 64 + lane; const float xv = xc[i]; ss += xv * xv;
            const f32x4 w0 = *(const LAS f32x4*)(wab + k * 8), w1 = *(const LAS f32x4*)(wab + k * 8 + 4);
            dot[0] += xv * w0[0]; dot[1] += xv * w0[1]; dot[2] += xv * w0[2]; dot[3] += xv * w0[3]; dot[4] += xv * w1[0]; dot[5] += xv * w1[1]; dot[6] += xv * w1[2]; dot[7] += xv * w1[3]; }
#pragma unroll
        for (int o = 32; o >= 1; o >>= 1) { ss += __shfl_xor(ss, o);
#pragma unroll
            for (int j = 0; j < 8; ++j) dot[j] += __shfl_xor(dot[j], o); }
        const float rs = rsqrtf(ss * (1.0f / 1024.0f) + EPS);
#pragma unroll
        for (int i = 0; i < 4; ++i) { const int k0 = i * 256 + lane * 4; const f32x4 v = x4c[i]; u32x2 w; w.x = pk2(v[0], v[1]); w.y = pk2(v[2], v[3]); *(u32x2*)(XB + (size_t)row * D + k0) = w; }
        { const f32x4 v = p4c; u32x2 w; w.x = pk2(v[0], v[1]); w.y = pk2(v[2], v[3]); *(u32x2*)(PB + (size_t)row * PLE + lane * 4) = w; }
        if (lane == 0) { ctl[CTL_RS0 + row] = rs; ctl[CTL_SS1 + row] = 0.f; ctl[CTL_SS2 + row] = 0.f; ctl[CTL_SS3 + row] = 0.f; }
        if (lane < 4) { const float da = lane == 0 ? dot[0] : lane == 1 ? dot[1] : lane == 2 ? dot[2] : dot[3]; const float db = lane == 0 ? dot[4] : lane == 1 ? dot[5] : lane == 2 ? dot[6] : dot[7];
            const float xa = da * rs + c.dt_bias[lane]; const float sp = xa > 20.f ? xa : log1pf(__expf(xa));
            ctl[CTL_LA + (size_t)row * 4 + lane] = -__expf(c.a_log[lane]) * sp; ctl[CTL_BETA + (size_t)row * 4 + lane] = sigmoidf_(db * rs); }
    }
    __syncthreads();
    tiles_range(c, ws, (LAS float*)lds, (int)blockIdx.x, (int)gridDim.x, 896);
}

constexpr int L_QH = 0, L_KH = 17408, L_RT = 34816, L_AM = 71680, L_TB = 89088, L_G = 98304, L_WC = 98816, L_SSP = 104960;
DI void prep_chunk(const Ctx& c, LAS unsigned char* lds, int ch) {
    int tid = mk_tid(); asm volatile("" : "+v"(tid));
    const int lane = tid & 63, wid = __builtin_amdgcn_readfirstlane(tid >> 6);
    const int h = ch & 3, n = (ch >> 2) & 31, b = ch >> 7;
    const int row0 = b * 2048 + n * 64;
    float* ctl = (float*)(c.ws + WS_CTL);
    const bf16_t* PROJ = (const bf16_t*)(c.ws + WS_B);
    bf16_t* QP = (bf16_t*)c.out + (size_t)ch * 8192; bf16_t* WP = (bf16_t*)c.out + (size_t)(1024 + ch) * 8192; bf16_t* KTP = (bf16_t*)c.out + (size_t)(2048 + ch) * 8192;
    bf16_t* UT = (bf16_t*)(c.ws + WS_C) + (size_t)ch * 8192; bf16_t* QKP = (bf16_t*)(c.ws + WS_C) + (size_t)1024 * 8192 + (size_t)ch * 4096;
    LAS float* G = (LAS float*)(lds + L_G); LAS float* BT = G + 64;
    LAS float* WC = (LAS float*)(lds + L_WC);
    LAS float* SSP = (LAS float*)(lds + L_SSP);
    for (int i = tid; i < 1536; i += NTHREADS) { const int ten = i >> 9, jj = (i >> 7) & 3, cc = i & 127; WC[i] = c.w_conv_qkv[jj * 1536 + ten * 512 + h * 128 + cc]; }
    if (wid == 0) {
        float la = ctl[CTL_LA + (size_t)(row0 + lane) * 4 + h];
#pragma unroll
        for (int o = 1; o < 64; o <<= 1) { const float t = __int_as_float(__builtin_amdgcn_ds_bpermute(((lane - o) & 63) * 4, __float_as_int(la))); if (lane >= o) la += t; }
        G[lane] = la; BT[lane] = ctl[CTL_BETA + (size_t)(row0 + lane) * 4 + h];
        if (lane == 63) __hip_atomic_store(ctl + CTL_GL + ch, la, __ATOMIC_RELAXED, __HIP_MEMORY_SCOPE_AGENT);
    }
    {
        const int tok = lane, cg8 = wid;
        const int t_abs = n * 64 + tok;
        u32x4 xr[3][4][2];
#pragma unroll
        for (int ten = 0; ten < 3; ++ten)
#pragma unroll
            for (int j = 0; j < 4; ++j) { const int tt = t_abs - 3 + j;
                if (tt >= 0) { const bf16_t* src = PROJ + (size_t)(b * 2048 + tt) * NPROJ + ten * 512 + h * 128 + cg8 * 16; xr[ten][j][0] = *(const u32x4*)src; xr[ten][j][1] = *(const u32x4*)(src + 8); }
                else { xr[ten][j][0] = (u32x4){0u, 0u, 0u, 0u}; xr[ten][j][1] = (u32x4){0u, 0u, 0u, 0u}; } }
        __syncthreads();
        const float g = G[tok], bt = BT[tok];
        const float eg = __expf(g);
        float a[3][16];
#pragma unroll
        for (int ten = 0; ten < 3; ++ten) {
#pragma unroll
            for (int e = 0; e < 16; ++e) a[ten][e] = 0.f;
#pragma unroll
            for (int j = 0; j < 4; ++j) { float x[16]; unpack8(xr[ten][j][0], x); unpack8(xr[ten][j][1], x + 8);
                const LAS float* wj = WC + (ten * 4 + j) * 128 + cg8 * 16;
#pragma unroll
                for (int q = 0; q < 4; ++q) { const f32x4 w = *(const LAS f32x4*)(wj + 4 * q); a[ten][4 * q] += x[4 * q] * w[0]; a[ten][4 * q + 1] += x[4 * q + 1] * w[1]; a[ten][4 * q + 2] += x[4 * q + 2] * w[2]; a[ten][4 * q + 3] += x[4 * q + 3] * w[3]; } }
#pragma unroll
            for (int e = 0; e < 16; ++e) a[ten][e] = siluf_(a[ten][e]);
        }
        { float sq = 0.f, sk = 0.f;
#pragma unroll
          for (int e = 0; e < 16; ++e) { sq += a[0][e] * a[0][e]; sk += a[1][e] * a[1][e]; }
          SSP[cg8 * 64 + tok] = sq; SSP[512 + cg8 * 64 + tok] = sk; }
        __syncthreads();
        { float sq = 0.f, sk = 0.f;
#pragma unroll
          for (int w = 0; w < 8; ++w) { sq += SSP[w * 64 + tok]; sk += SSP[512 + w * 64 + tok]; }
          const float scq = rsqrtf(sq + EPS) * 0.08838834764831845f, sck = rsqrtf(sk + EPS);
#pragma unroll
          for (int e = 0; e < 16; ++e) { a[0][e] *= scq; a[1][e] *= sck; } }
        {
            LAS unsigned char* q = lds + L_QH + tok * 272 + cg8 * 32;
            *(LAS u32x4*)q = pack8(a[0]); *(LAS u32x4*)(q + 16) = pack8(a[0] + 8);
            float p[16];
#pragma unroll
            for (int e = 0; e < 16; ++e) p[swap23(e)] = a[0][e] * eg;
            bf16_t* dst = QP + tok * 128 + cg8 * 16; st16_wt(dst, pack8(p)); st16_wt(dst + 8, pack8(p + 8));
        }
        {
            LAS unsigned char* q = lds + L_KH + tok * 272 + cg8 * 32;
            *(LAS u32x4*)q = pack8(a[1]); *(LAS u32x4*)(q + 16) = pack8(a[1] + 8);
            const float f = bt * eg;
#pragma unroll
            for (int e = 0; e < 16; ++e) *(LAS bf16_t*)(lds + L_RT + (128 + cg8 * 16 + e) * 144 + tok * 2) = f2bf(a[1][e] * f);
        }
#pragma unroll
        for (int e = 0; e < 16; ++e) *(LAS bf16_t*)(lds + L_RT + (cg8 * 16 + e) * 144 + tok * 2) = f2bf(a[2][e] * bt);
    }
    __syncthreads();
    {
        int r = lane & 31, hh = lane >> 5; asm volatile("" : "+v"(r), "+v"(hh));
        const int blk = wid & 3, I = (blk == 1 || blk == 2) ? 1 : 0, J = (blk == 2 || blk == 3) ? 1 : 0; const bool isq = wid >= 4;
        f32x16 x;
#pragma unroll
        for (int i = 0; i < 16; ++i) x[i] = 0.f;
        if (blk != 3) {
            LAS unsigned char* Ab = lds + (isq ? L_QH : L_KH) + (32 * I + r) * 272 + hh * 16; LAS unsigned char* Bb = lds + L_KH + (32 * J + r) * 272 + hh * 16;
#pragma unroll
            for (int s = 0; s < 8; ++s) { const bf16x8 av = *(LAS bf16x8*)(Ab + s * 32), bv = *(LAS bf16x8*)(Bb + s * 32); x = isq ? MFMA32(bv, av, x) : MFMA32(av, bv, x); }
        }
        if (!isq) {
            const int jj = 32 * J + r; const float gj = G[jj];
            if (blk != 3) {
#pragma unroll
                for (int i = 0; i < 16; ++i) { const int ii = 32 * I + crow(i, hh); const float d = __expf(fminf(G[ii] - gj, 0.f)); ((LAS float*)(lds + L_AM))[ii * 68 + jj] = (ii > jj) ? BT[ii] * x[i] * d : 0.f; } }
        } else {
            const int ii = 32 * I + r; const float gi = G[ii]; float f[16];
#pragma unroll
            for (int i = 0; i < 16; ++i) { const int jj = 32 * J + crow(i, hh); const float d = __expf(fminf(gi - G[jj], 0.f)); f[i] = (ii >= jj && blk != 3) ? x[i] * d : 0.f; }
            bf16_t* dst = QKP + ii * 64 + 32 * J; st16_wt(dst + 8 * hh, pack8(f)); st16_wt(dst + 16 + 8 * hh, pack8(f + 8));
        }
    }
    {
        const int dk = tid & 127, tq = tid >> 7; const float glast = G[63]; float f[16];
#pragma unroll
        for (int t = 0; t < 16; ++t) { const int tk = 16 * tq + t; f[swap23(t)] = bf2f(*(LAS bf16_t*)(lds + L_KH + tk * 272 + dk * 2)) * __expf(glast - G[tk]); }
        bf16_t* dst = KTP + dk * 64 + 16 * tq; st16_wt(dst, pack8(f)); st16_wt(dst + 8, pack8(f + 8));
    }
    __syncthreads();
#ifndef NOINV
    if (wid == 0) {
        f32x2v t2[32]; f32x4 ab[2][16]; float lanef = (float)lane; asm volatile("" : "+v"(lanef));
        int zoff; asm volatile("v_mov_b32 %0, 0" : "=v"(zoff));
        LAS float* AM = (LAS float*)(lds + L_AM) + zoff;
        t2[0].x = fmaxf(1.0f - fabsf(lanef), 0.f); t2[0].y = 0.f;
        ab[1][0] = *(LAS f32x4*)(AM + 68);
#pragma unroll
        for (int i = 1; i < 64; ++i) {
            if (i + 1 < 64) {
#pragma unroll
                for (int q = 0; q < (i + 4) / 4; ++q) ab[(i + 1) & 1][q] = *(LAS f32x4*)(AM + (i + 1) * 68 + 4 * q); }
            __builtin_amdgcn_sched_barrier(0);
            f32x2v acc2 = {fmaxf(1.0f - fabsf(lanef - (float)i), 0.f), 0.f};
#pragma unroll
            for (int q = 0; q < (i + 3) / 4; ++q) { const f32x4 av = ab[i & 1][q]; const int j = 4 * q;
                if (j + 1 < i) acc2 -= (f32x2v){av[0], av[1]} * t2[j / 2]; else acc2.x -= av[0] * t2[j / 2].x;
                if (j + 3 < i) acc2 -= (f32x2v){av[2], av[3]} * t2[j / 2 + 1]; else if (j + 2 < i) acc2.x -= av[2] * t2[j / 2 + 1].x; }
            const float ti = acc2.x + acc2.y;
            if (i & 1) t2[i / 2].y = ti; else { t2[i / 2].x = ti; t2[i / 2].y = 0.f; }
            __builtin_amdgcn_sched_barrier(0);
        }
#pragma unroll
        for (int i = 0; i < 32; ++i) { *(LAS bf16_t*)(lds + L_TB + (2 * i) * 144 + lane * 2) = f2bf(t2[i].x); *(LAS bf16_t*)(lds + L_TB + (2 * i + 1) * 144 + lane * 2) = f2bf(t2[i].y); }
    }
#endif
    __syncthreads();
    {
        int r = lane & 31, hh = lane >> 5; asm volatile("" : "+v"(r), "+v"(hh));
#pragma unroll
        for (int tb = 0; tb < 2; ++tb) {
            f32x16 x;
#pragma unroll
            for (int i = 0; i < 16; ++i) x[i] = 0.f;
#pragma unroll
            for (int s = 0; s < 4; ++s) if (s < 2 || tb == 1) {
                const bf16x8 tf = *(LAS bf16x8*)(lds + L_TB + (32 * tb + r) * 144 + (16 * s + 8 * hh) * 2), rf = *(LAS bf16x8*)(lds + L_RT + (32 * wid + r) * 144 + (16 * s + 8 * hh) * 2);
                x = (wid < 4) ? MFMA32(tf, rf, x) : MFMA32(rf, tf, x); }
            float f[16];
#pragma unroll
            for (int i = 0; i < 16; ++i) f[i] = x[i];
            bf16_t* dst = (wid < 4) ? UT + (32 * wid + r) * 64 + 32 * tb : WP + (32 * tb + r) * 128 + 32 * (wid - 4);
            st16_wt(dst + 8 * hh, pack8(f)); st16_wt(dst + 16 + 8 * hh, pack8(f + 8));
        }
    }
    asm volatile("s_waitcnt vmcnt(0)" ::: "memory");
    __syncthreads();
    if (tid == 0) __hip_atomic_store((unsigned*)(c.ws + WS_FLAGS) + ch, 1u, __ATOMIC_RELAXED, __HIP_MEMORY_SCOPE_AGENT);
}

DI void sample_gdn2(const Ctx& c, LAS unsigned char* lds, int pair) {
    const int tid = mk_tid(), lane = tid & 63, half = tid >> 8, ht = tid & 255, hw = (tid >> 6) & 3;
    const int item = pair * 2 + half, b = item >> 2, h = item & 3;
    float* ctl = (float*)(c.ws + WS_CTL);
    const bf16_t* PROJ = (const bf16_t*)(c.ws + WS_B); bf16_t* OY = (bf16_t*)(c.ws + WS_A);
    LAS float* vals = (LAS float*)lds + half * 3072;
    LAS float* red = vals + 1536;
    LAS float* red2 = red + 256;
    LAS float* os = red2 + 256;
    const int row0 = NTP + b * 4;
    for (int i = ht; i < 1536; i += 256) { const int ten = i >> 9, tok = (i >> 7) & 3, ch = i & 127; const int col = ten * 512 + h * 128 + ch; float a = 0.f;
#pragma unroll
        for (int j = 0; j < 4; ++j) { const int idx = tok + j; const float xv = idx < 3 ? c.state_gdn_conv[((size_t)b * 3 + idx) * 1536 + col] : bf2f(PROJ[(size_t)(row0 + idx - 3) * NPROJ + col]); a += xv * c.w_conv_qkv[j * 1536 + col]; }
        vals[i] = siluf_(a); }
    __syncthreads();
#pragma unroll
    for (int rep = 0; rep < 2; ++rep) { const int pr = hw * 2 + rep, ten = pr >> 2, tok = pr & 3; LAS float* v = vals + ten * 512 + tok * 128; const float a0 = v[lane], a1 = v[lane + 64]; float ss = a0 * a0 + a1 * a1;
#pragma unroll
        for (int o = 32; o >= 1; o >>= 1) ss += __shfl_xor(ss, o);
        const float sc = rsqrtf(ss + EPS) * (ten == 0 ? 0.08838834764831845f : 1.0f); v[lane] = a0 * sc; v[lane + 64] = a1 * sc; }
    __syncthreads();
    const int e = ht & 127, part = ht >> 7;
    float s[64];
    const float* S0 = c.state_gdn + ((size_t)item * 128 + part * 64) * 128 + e;
#pragma unroll
    for (int i = 0; i < 64; ++i) s[i] = S0[(size_t)i * 128];
#pragma unroll 1
    for (int t = 0; t < 4; ++t) {
        const float a = __expf(ctl[CTL_LA + (size_t)(row0 + t) * 4 + h]), bt = ctl[CTL_BETA + (size_t)(row0 + t) * 4 + h];
        LAS float* qv = vals + t * 128 + part * 64; LAS float* kv = vals + 512 + t * 128 + part * 64;
        float p = 0.f;
#pragma unroll
        for (int i = 0; i < 64; ++i) { s[i] *= a; p += s[i] * kv[i]; }
        red[part * 128 + e] = p;
        __syncthreads();
        const float rr = bt * (vals[1024 + t * 128 + e] - (red[e] + red[128 + e]));
        float po = 0.f;
#pragma unroll
        for (int i = 0; i < 64; ++i) { s[i] += kv[i] * rr; po += s[i] * qv[i]; }
        red2[part * 128 + e] = po;
        __syncthreads();
        if (part == 0) os[t * 128 + e] = red2[e] + red2[128 + e];
    }
    float* Sout = c.out + OFF_GS + ((size_t)item * 128 + part * 64) * 128 + e;
#pragma unroll
    for (int i = 0; i < 64; ++i) Sout[(size_t)i * 128] = s[i];
    __syncthreads();
#pragma unroll
    for (int rep = 0; rep < 2; ++rep) { const int tok = part * 2 + rep; float ss = 0.f;
        for (int i = 0; i < 128; ++i) { const float v = os[tok * 128 + i]; ss += v * v; }
        const float rs = rsqrtf(ss * (1.0f / 128.0f) + EPS); const int row = row0 + tok;
        const float z = bf2f(PROJ[(size_t)row * NPROJ + 1536 + h * 128 + e]);
        OY[(size_t)row * D + h * 128 + e] = f2bf(os[tok * 128 + e] * rs * c.w_gdn_norm[e] * siluf_(z)); }
    __syncthreads();
}

DI void shortconv_items(const Ctx& c, int item_lo, int item_hi, int bfirst, int bcount) {
    const int tid = mk_tid();
    const bf16_t* PROJ = (const bf16_t*)(c.ws + WS_B); bf16_t* OY = (bf16_t*)(c.ws + WS_A);
    for (int item = item_lo + bfirst * NTHREADS + tid; item < item_hi; item += bcount * NTHREADS) {
        const int row = item >> 6, c8 = (item & 63) * 8;
        const bool prm = row < NTP; const int sb = prm ? (row >> 11) : ((row - NTP) >> 2); const int t = prm ? (row & 2047) : ((row - NTP) & 3); const int T = prm ? 2048 : 4;
        float bv[8]; unpack8(*(const u32x4*)(PROJ + (size_t)row * NPROJ + 2048 + c8), bv);
        float acc[8], cur[8];
#pragma unroll
        for (int e = 0; e < 8; ++e) { acc[e] = 0.f; cur[e] = 0.f; }
#pragma unroll
        for (int d = 0; d < 3; ++d) { const int tt = t - 2 + d; float sc[8];
            if (tt >= 0) { float cv[8], hv[8]; const bf16_t* src = PROJ + (size_t)(row - (2 - d)) * NPROJ + c8; unpack8(*(const u32x4*)(src + 2560), cv); unpack8(*(const u32x4*)(src + 3072), hv);
#pragma unroll
                for (int e = 0; e < 8; ++e) sc[e] = cv[e] * hv[e]; }
            else if (!prm) { const float* sp = c.state_sc_conv + ((size_t)sb * 2 + (2 + tt)) * 512 + c8; const f32x4 s0 = *(const f32x4*)sp, s1 = *(const f32x4*)(sp + 4);
#pragma unroll
                for (int e = 0; e < 4; ++e) { sc[e] = s0[e]; sc[4 + e] = s1[e]; } }
            else {
#pragma unroll
                for (int e = 0; e < 8; ++e) sc[e] = 0.f; }
            const float* wp = c.w_conv_sc + d * 512 + c8; const f32x4 w0 = *(const f32x4*)wp, w1 = *(const f32x4*)(wp + 4);
#pragma unroll
            for (int e = 0; e < 4; ++e) { acc[e] += sc[e] * w0[e]; acc[4 + e] += sc[4 + e] * w1[e]; }
            if (d == 2) {
#pragma unroll
                for (int e = 0; e < 8; ++e) cur[e] = sc[e]; } }
#pragma unroll
        for (int e = 0; e < 8; ++e) acc[e] *= bv[e];
        *(u32x4*)(OY + (size_t)row * D + 512 + c8) = pack8(acc);
        if (t >= T - 2) { float* dst = (prm ? c.out + OFF_SCP : c.out + OFF_SCS) + ((size_t)sb * 2 + (t - (T - 2))) * 512 + c8;
            *(f32x4*)dst = (f32x4){cur[0], cur[1], cur[2], cur[3]}; *(f32x4*)(dst + 4) = (f32x4){cur[4], cur[5], cur[6], cur[7]}; }
    }
}
DI void conv_state_copies(const Ctx& c, int bfirst, int bcount) {
    const int tid = mk_tid();
    const bf16_t* PROJ = (const bf16_t*)(c.ws + WS_B);
    for (int idx = bfirst * NTHREADS + tid; idx < 136 * 4608; idx += bcount * NTHREADS) {
        const int seq = idx / 4608, rem = idx % 4608, j = rem / 1536, col = rem % 1536;
        if (seq < 8) c.out[OFF_GCP + idx] = bf2f(PROJ[(size_t)(seq * 2048 + 2045 + j) * NPROJ + col]);
        else c.out[OFF_GCS + (idx - 8 * 4608)] = bf2f(PROJ[(size_t)(NTP + (seq - 8) * 4 + 1 + j) * NPROJ + col]);
    }
}

constexpr int P3_BUF = 57344, P3_OB = 114688, L_XST = 148480, P3_WN = 148496;
DI void scan_seq(const Ctx& c, LAS unsigned char* lds, int bh) {
    const int tid = mk_tid(), lane = tid & 63, wid = tid >> 6, r = lane & 31, hh = lane >> 5;
    const int b = bh >> 2, h = bh & 3;
    const bool loader = wid >= 4; const int lt = tid & 255;
    const float* ctl = (const float*)(c.ws + WS_CTL);
    const bf16_t* PROJ = (const bf16_t*)(c.ws + WS_B); bf16_t* OY = (bf16_t*)(c.ws + WS_A);
    LAS float* OB = (LAS float*)(lds + P3_OB);
    const int ch0 = b * 128 + h;
    const u32x4* gQ = (const u32x4*)((const bf16_t*)c.out) ; const u32x4* gW = gQ + (size_t)1024 * 1024; const u32x4* gKT = gQ + (size_t)2048 * 1024;
    const u32x4* gQK = (const u32x4*)((const bf16_t*)(c.ws + WS_C) + (size_t)1024 * 8192);
    const bf16_t* gUT = (const bf16_t*)(c.ws + WS_C);
    f32x16 S[4];
#pragma unroll
    for (int kt = 0; kt < 4; ++kt)
#pragma unroll
        for (int i = 0; i < 16; ++i) S[kt][i] = 0.f;
    const int e0 = 32 * (wid & 3);
    u32x4 zr[4]; u32x4 un[4]; float decn = 1.f;
#define P3_DMA(gp, ldsp) __builtin_amdgcn_global_load_lds((const unsigned*)(gp), (LAS unsigned*)(ldsp), 16, 0, 0)
    const int lw = (wid & 3) * 1024;
    int srcA[4], srcB[4];
#pragma unroll
    for (int i = 0; i < 4; ++i) { const int q = lt + 256 * i; const int rowA = q >> 4, rowB = q >> 3; srcA[i] = rowA * 16 + ((q & 15) ^ (rowA & 15)); srcB[i] = rowB * 8 + ((q & 7) ^ ((rowB >> 1) & 7)); }
    const int gtok = lt >> 2, gpart = lt & 3;
    if (tid < 128) ((LAS float*)(lds + P3_WN))[tid] = c.w_gdn_norm[tid];
    unsigned* const flags = (unsigned*)(c.ws + WS_FLAGS);
#define P3_WAIT(chx) do { unsigned sp_ = 0u; while (__hip_atomic_load(flags + (chx), __ATOMIC_RELAXED, __HIP_MEMORY_SCOPE_AGENT) == 0u) { __builtin_amdgcn_s_sleep(2); if (++sp_ > (1u << 22)) break; } __builtin_amdgcn_fence(__ATOMIC_ACQUIRE, "agent"); } while (0)
    P3_WAIT(ch0);
    if (loader) {
        const size_t t0 = (size_t)ch0 * 1024;
#pragma unroll
        for (int i = 0; i < 4; ++i) { P3_DMA(gW + t0 + srcA[i], lds + lw + 4096 * i); P3_DMA(gQ + t0 + srcA[i], lds + 16384 + lw + 4096 * i); P3_DMA(gKT + t0 + srcB[i], lds + 32768 + lw + 4096 * i); }
#pragma unroll
        for (int i = 0; i < 2; ++i) P3_DMA(gQK + (size_t)ch0 * 512 + srcB[i], lds + 49152 + lw + 4096 * i);
        asm volatile("s_waitcnt vmcnt(0)" ::: "memory");
    } else {
        const bf16_t* up = gUT + (size_t)ch0 * 8192 + (e0 + r) * 64 + 8 * hh;
        un[0] = *(const u32x4*)up; un[1] = *(const u32x4*)(up + 16); un[2] = *(const u32x4*)(up + 32); un[3] = *(const u32x4*)(up + 48);
        decn = __expf(__hip_atomic_load(ctl + CTL_GL + ch0, __ATOMIC_RELAXED, __HIP_MEMORY_SCOPE_AGENT));
    }
    const int rw = r & 15, rk = (r >> 1) & 7;
    if (loader) {
#pragma unroll 1
        for (int n = 0; n <= 32; ++n) {
            __syncthreads();
            if (n < 31) { P3_WAIT(ch0 + 4 * (n + 1)); const size_t t1 = (size_t)(ch0 + 4 * (n + 1)) * 1024; LAS unsigned char* Bn = lds + ((n + 1) & 1) * P3_BUF;
#pragma unroll
                for (int i = 0; i < 4; ++i) { P3_DMA(gW + t1 + srcA[i], Bn + lw + 4096 * i); P3_DMA(gQ + t1 + srcA[i], Bn + 16384 + lw + 4096 * i); P3_DMA(gKT + t1 + srcB[i], Bn + 32768 + lw + 4096 * i); }
#pragma unroll
                for (int i = 0; i < 2; ++i) P3_DMA(gQK + (size_t)(ch0 + 4 * (n + 1)) * 512 + srcB[i], Bn + 49152 + lw + 4096 * i); }
            if (n >= 1) {
                const int row = b * 2048 + (n - 1) * 64 + gtok; LAS float* op = OB + gtok * 132 + gpart * 32;
                float o[32]; float ss = 0.f;
#pragma unroll
                for (int q = 0; q < 8; ++q) { const f32x4 v = *(LAS f32x4*)(op + 4 * q); o[4 * q] = v[0]; o[4 * q + 1] = v[1]; o[4 * q + 2] = v[2]; o[4 * q + 3] = v[3]; ss += (v[0] * v[0] + v[1] * v[1]) + (v[2] * v[2] + v[3] * v[3]); }
                ss += __shfl_xor(ss, 1); ss += __shfl_xor(ss, 2);
                const float rs = rsqrtf(ss * (1.0f / 128.0f) + EPS);
                float z[32]; unpack8(zr[0], z); unpack8(zr[1], z + 8); unpack8(zr[2], z + 16); unpack8(zr[3], z + 24);
#pragma unroll
                for (int e = 0; e < 32; ++e) o[e] = o[e] * rs * ((LAS float*)(lds + P3_WN))[gpart * 32 + e] * siluf_(z[e]);
                bf16_t* dst = OY + (size_t)row * D + h * 128 + gpart * 32;
                *(u32x4*)dst = pack8(o); *(u32x4*)(dst + 8) = pack8(o + 8); *(u32x4*)(dst + 16) = pack8(o + 16); *(u32x4*)(dst + 24) = pack8(o + 24);
            }
            __syncthreads();
            asm volatile("s_waitcnt vmcnt(0)" ::: "memory");
            if (n < 32) { const bf16_t* zp = PROJ + (size_t)(b * 2048 + n * 64 + gtok) * NPROJ + 1536 + h * 128 + gpart * 32;
                zr[0] = *(const u32x4*)zp; zr[1] = *(const u32x4*)(zp + 8); zr[2] = *(const u32x4*)(zp + 16); zr[3] = *(const u32x4*)(zp + 24); }
        }
    } else {
#pragma unroll 1
        for (int n = 0; n <= 32; ++n) {
            __syncthreads();
            LAS unsigned char* B = lds + (n & 1) * P3_BUF;
            f32x16 O[2];
            if (n < 32) {
                const f32x16 zero16 = {0.f, 0.f, 0.f, 0.f, 0.f, 0.f, 0.f, 0.f, 0.f, 0.f, 0.f, 0.f, 0.f, 0.f, 0.f, 0.f};
                f32x16 P[2]; P[0] = zero16; P[1] = zero16; O[0] = zero16; O[1] = zero16;
#pragma unroll
                for (int kt = 0; kt < 4; ++kt)
#pragma unroll
                    for (int s = 0; s < 2; ++s) { const bf16x8 sb = pack_step(S[kt], s);
#pragma unroll
                        for (int mi = 0; mi < 2; ++mi) { const int off = ((32 * mi + r) * 16 + ((4 * kt + 2 * s + hh) ^ rw)) * 16;
                            P[mi] = MFMA32(*(LAS bf16x8*)(B + off), sb, P[mi]); O[mi] = MFMA32(*(LAS bf16x8*)(B + 16384 + off), sb, O[mi]); } }
                bf16x8 vb[2][2];
#pragma unroll
                for (int tb = 0; tb < 2; ++tb) { float u[16]; unpack8(un[2 * tb], u); unpack8(un[2 * tb + 1], u + 8);
                    f32x16 vn;
#pragma unroll
                    for (int i = 0; i < 16; ++i) vn[i] = u[i] - P[tb][i];
                    vb[tb][0] = pack_step(vn, 0); vb[tb][1] = pack_step(vn, 1); }
                const float dec = decn;
                if (n < 31) { P3_WAIT(ch0 + 4 * (n + 1)); const bf16_t* up = gUT + (size_t)(ch0 + 4 * (n + 1)) * 8192 + (e0 + r) * 64 + 8 * hh;
                    un[0] = *(const u32x4*)up; un[1] = *(const u32x4*)(up + 16); un[2] = *(const u32x4*)(up + 32); un[3] = *(const u32x4*)(up + 48);
                    decn = __expf(__hip_atomic_load(ctl + CTL_GL + ch0 + 4 * (n + 1), __ATOMIC_RELAXED, __HIP_MEMORY_SCOPE_AGENT)); }
#pragma unroll
                for (int mi = 0; mi < 2; ++mi)
#pragma unroll
                    for (int tb = 0; tb <= mi; ++tb)
#pragma unroll
                        for (int s = 0; s < 2; ++s) O[mi] = MFMA32(*(LAS bf16x8*)(B + 49152 + ((32 * mi + r) * 8 + ((4 * tb + 2 * s + hh) ^ rk)) * 16), vb[tb][s], O[mi]);
#pragma unroll
                for (int kt = 0; kt < 4; ++kt) { S[kt] *= dec;
#pragma unroll
                    for (int tb = 0; tb < 2; ++tb)
#pragma unroll
                        for (int s = 0; s < 2; ++s) S[kt] = MFMA32(*(LAS bf16x8*)(B + 32768 + ((32 * kt + r) * 8 + ((4 * tb + 2 * s + hh) ^ rk)) * 16), vb[tb][s], S[kt]); }
            }
            __syncthreads();
            if (n < 32) {
#pragma unroll
                for (int mi = 0; mi < 2; ++mi)
#pragma unroll
                    for (int i = 0; i < 16; ++i) OB[(32 * mi + crow(i, hh)) * 132 + e0 + r] = O[mi][i];
            }
        }
    }
    if (!loader) { float* So = c.out + OFF_GP + (size_t)bh * 16384;
#pragma unroll
        for (int kt = 0; kt < 4; ++kt)
#pragma unroll
            for (int i = 0; i < 16; ++i) So[(32 * kt + crow(i, hh)) * 128 + e0 + r] = S[kt][i]; }
    __syncthreads();
}

DI void sub_barrier(unsigned* cnt, unsigned target, bool release = true) {
    asm volatile("s_waitcnt vmcnt(0)" ::: "memory");
    __syncthreads();
    if (mk_tid() == 0) {
        if (release) { __builtin_amdgcn_fence(__ATOMIC_RELEASE, "agent"); asm volatile("s_waitcnt vmcnt(0)" ::: "memory"); }
        (void)xb_add(cnt, 1u);
        unsigned sp = 0u; while (xb_ld(cnt) < target) { __builtin_amdgcn_s_sleep(1); if (++sp > (1u << 22)) break; }
        __builtin_amdgcn_fence(__ATOMIC_ACQUIRE, "agent");
        asm volatile("s_waitcnt vmcnt(0)" ::: "memory");
    }
    __syncthreads();
}

__global__ void __launch_bounds__(NTHREADS, 2) mega(Ctx c) {
    extern __shared__ __attribute__((aligned(16))) unsigned char shm[];
    LAS unsigned char* lds = (LAS unsigned char*)shm;
    { const unsigned t0 = threadIdx.x; if ((t0 & 63u) == 0u) ((LAS unsigned*)(lds + L_WTAB))[mk_slot()] = t0 >> 6; }
    __syncthreads();
    unsigned char* ws = c.ws; float* ctl = (float*)(ws + WS_CTL);
    const int lo = c.ph_lo, hi = c.ph_hi;
    if (hi > 1000) cg::this_grid().sync();
    volatile LAS unsigned* xst = (volatile LAS unsigned*)(lds + L_XST);
    if (mk_tid() < 4) xst[mk_tid()] = 0u;
    __syncthreads();
    XcdBarrier bar = xcd_barrier_post((unsigned*)(ws + WS_BAR), xst);
#ifdef ONLY
#define IN(k) ((k) == ONLY)
#else
#define IN(k) (lo <= (k) && (k) < hi)
#endif
#define SEAM(k) do { if (IN(k) && IN((k) + 1)) xcd_barrier(bar); } while (0)
    if (IN(0)) p0_phase(c, lds);
    SEAM(0);
    if (IN(1)) { pg8::Gemm g{(const bf16_t*)(ws + WS_A), (const bf16_t*)(ws + WS_WIN), NT, NPROJ, D, 0}; pg8::StaticOrder S; S.init(NT, NPROJ, gridDim.x, blockIdx.x);
        EpiProj E{(bf16_t*)(ws + WS_B), NPROJ, ctl + CTL_RS0}; pg8::gemm_phase<EpiProj, pg8::StaticOrder, false>(lds, g, S, E, nullptr);
        { const int G = (int)gridDim.x, rem = ((NT / 256) * (NPROJ / 256)) % G;
          if (rem > 0) { if ((int)blockIdx.x >= rem) tiles_range(c, ws, (LAS float*)lds, P0_TILES + ((int)blockIdx.x - rem), G - rem, 3520); }
          else tiles_range(c, ws, (LAS float*)lds, P0_TILES + (int)blockIdx.x, G, 3520); } }
    SEAM(1);
    if (IN(3)) {
        unsigned* const chw = (unsigned*)(ws + WS_BAR) + 96;
        if (blockIdx.x < 32 || blockIdx.x >= 64) {
            const int q = blockIdx.x < 32 ? (int)blockIdx.x : (int)blockIdx.x - 32, nq = (int)gridDim.x - 32;
            tiles_range(c, ws, (LAS float*)lds, 896 + q, nq, P0_TILES);
            for (int it = q; it < 256; it += nq) sample_gdn2(c, lds, it);
            shortconv_items(c, NTP * 64, NT * 64, q, nq);
            asm volatile("s_waitcnt vmcnt(0)" ::: "memory");
            __syncthreads();
            if (mk_tid() == 0) { __builtin_amdgcn_fence(__ATOMIC_RELEASE, "agent"); asm volatile("s_waitcnt vmcnt(0)" ::: "memory"); (void)xb_add(chw, 1u); }
        }
        if (blockIdx.x < 32) { scan_seq(c, lds, blockIdx.x); const int nq = (int)gridDim.x - 32, q = nq - 32 + (int)blockIdx.x; shortconv_items(c, 0, NTP * 64, q, nq); conv_state_copies(c, q, nq); }
        else if (blockIdx.x < 64) {
            if (mk_tid() == 0) { unsigned sp = 0u; while (xb_ld(chw) < gridDim.x - 32u) { __builtin_amdgcn_s_sleep(2); if (++sp > (1u << 22)) break; } __builtin_amdgcn_fence(__ATOMIC_ACQUIRE, "agent"); asm volatile("s_waitcnt vmcnt(0)" ::: "memory"); }
            __syncthreads();
            const int j = blockIdx.x - 32; unsigned* sc = (unsigned*)(ws + WS_BAR) + 64;
            { pg8::Gemm g{(const bf16_t*)(ws + WS_A), (const bf16_t*)(ws + WS_WOUT), NT, D, D, 0}; SubOrder S{64, 2, 4, 8, j < 8 ? j : -1};
              EpiRes<0> E{c.x_prompt, c.x_sample, (bf16_t*)(ws + WS_C), nullptr, ctl + CTL_SS1, nullptr, nullptr, 1}; pg8::gemm_phase<EpiRes<0>, SubOrder, false>(lds, g, S, E, nullptr); }
            { pg8::Gemm g{(const bf16_t*)(ws + WS_PB), (const bf16_t*)(ws + WS_WP), NT, D, PLE, 0}; SubOrder S{64, 2, 4, 8, (j >= 8 && j < 16) ? j - 8 : -1};
              EpiProj E{(bf16_t*)(ws + WS_PPS) - (size_t)NTP * D, D, nullptr, 1}; pg8::gemm_phase<EpiProj, SubOrder, false>(lds, g, S, E, nullptr); }
            sub_barrier(sc, 32u, false);
            { pg8::Gemm g{(const bf16_t*)(ws + WS_C), (const bf16_t*)(ws + WS_WUP), NT, DFF, D, 0}; SubOrder S{64, 2, 16, 32, j};
              EpiUp E{(bf16_t*)(ws + WS_B), ctl + CTL_SS1, 1}; pg8::gemm_phase<EpiUp, SubOrder, false>(lds, g, S, E, nullptr); }
            sub_barrier(sc, 64u, false);
            { const int kq = j >> 3; pg8::Gemm g{(const bf16_t*)(ws + WS_B) + kq * 1024, (const bf16_t*)(ws + WS_WDN) + kq * 1024, NT, D, 1024, DFF}; SubOrder S{64, 2, 4, 8, j & 7};
              EpiSplitK E{(float*)(ws + WS_B + SLAB_OFF), kq, (bf16_t*)(ws + WS_C), ctl + CTL_SS2, (unsigned*)(ws + WS_PCNT) + 66 * 32}; pg8::gemm_phase<EpiSplitK, SubOrder, false>(lds, g, S, E, nullptr); }
            sub_barrier(sc, 96u, false);
            { pg8::Gemm g{(const bf16_t*)(ws + WS_C), (const bf16_t*)(ws + WS_WG), NT, D, D, 0}; SubOrder S{64, 2, 4, 8, j < 8 ? j : -1};
              EpiFinal E{(const bf16_t*)(ws + WS_C), (const bf16_t*)(ws + WS_PPS) - (size_t)NTP * D, ctl + CTL_SS2, ctl + CTL_SS3, (unsigned*)(ws + WS_PCNT), c.norm_f, c.out}; pg8::gemm_phase<EpiFinal, SubOrder, false>(lds, g, S, E, nullptr); }
        }
        else { const int q = (int)blockIdx.x - 64, nq = (int)gridDim.x - 64;
            for (int i = q; i < 1024; i += nq) { const int n = i >> 5, bh = i & 31; prep_chunk(c, lds, ((bh >> 2) * 32 + n) * 4 + (bh & 3)); }
            shortconv_items(c, 0, NTP * 64, q, nq + 32);
            conv_state_copies(c, q, nq + 32); }
    }
    SEAM(3);
    if (IN(4)) { pg8::Gemm g{(const bf16_t*)(ws + WS_A), (const bf16_t*)(ws + WS_WOUT), NT, D, D, 0}; pg8::StaticOrder S; S.init(NTP, D, gridDim.x, blockIdx.x);
        EpiRes<0> E{c.x_prompt, c.x_sample, (bf16_t*)(ws + WS_C), nullptr, ctl + CTL_SS1, nullptr, nullptr}; pg8::gemm_phase<EpiRes<0>, pg8::StaticOrder, false>(lds, g, S, E, nullptr); }
    SEAM(4);
    if (IN(5)) { pg8::Gemm g{(const bf16_t*)(ws + WS_C), (const bf16_t*)(ws + WS_WUP), NT, DFF, D, 0}; pg8::StaticOrder S; S.init(NTP, DFF, gridDim.x, blockIdx.x);
        EpiUp E{(bf16_t*)(ws + WS_B), ctl + CTL_SS1}; pg8::gemm_phase<EpiUp, pg8::StaticOrder, false>(lds, g, S, E, nullptr); }
    SEAM(5);
    if (IN(6)) {
        { pg8::Gemm g{(const bf16_t*)(ws + WS_B), (const bf16_t*)(ws + WS_WDN), NT, D, DFF, 0}; pg8::StaticOrder S; S.init(NTP, D, gridDim.x, blockIdx.x);
          EpiRes<1> E{nullptr, nullptr, (bf16_t*)(ws + WS_C), nullptr, ctl + CTL_SS2, nullptr, nullptr}; pg8::gemm_phase<EpiRes<1>, pg8::StaticOrder, false>(lds, g, S, E, nullptr); }
        { pg8::Gemm g{(const bf16_t*)(ws + WS_PB), (const bf16_t*)(ws + WS_WP), NT, D, PLE, 0}; pg8::StaticOrder S; S.init(NTP, D, gridDim.x, blockIdx.x);
          EpiProj E{(bf16_t*)(ws + WS_A), D, nullptr}; pg8::gemm_phase<EpiProj, pg8::StaticOrder, false>(lds, g, S, E, nullptr); }
    }
    SEAM(6);
    if (IN(7)) { pg8::Gemm g{(const bf16_t*)(ws + WS_C), (const bf16_t*)(ws + WS_WG), NT, D, D, 0}; pg8::StaticOrder S; S.init(NTP, D, gridDim.x, blockIdx.x);
        EpiFinal E{(const bf16_t*)(ws + WS_C), (const bf16_t*)(ws + WS_A), ctl + CTL_SS2, ctl + CTL_SS3, (unsigned*)(ws + WS_PCNT), c.norm_f, c.out}; pg8::gemm_phase<EpiFinal, pg8::StaticOrder, false>(lds, g, S, E, nullptr); }
#undef IN
#undef SEAM
}

#ifndef N_LAUNCH_MODE
#define N_LAUNCH_MODE 1
#endif
extern "C" void kernel_launch(void* const* d_in, const int* in_sizes, int n_in, void* d_out, int out_size, void* d_ws, size_t ws_size, hipStream_t stream) {
    static int grid = 0;
    if (grid == 0) {
        int dev = 0, cus = 0, per_cu = 0;
        if (ws_size < WS_END) { fprintf(stderr, "kernel_launch: workspace too small: %zu < %zu\n", ws_size, (size_t)WS_END); grid = -1; return; }
        hipGetDevice(&dev); hipDeviceGetAttribute(&cus, hipDeviceAttributeMultiprocessorCount, dev);
        if (hipFuncSetAttribute((const void*)mega, hipFuncAttributeMaxDynamicSharedMemorySize, LDS_BYTES) != hipSuccess) { fprintf(stderr, "kernel_launch: hipFuncSetAttribute failed\n"); grid = -1; return; }
        if (hipOccupancyMaxActiveBlocksPerMultiprocessor(&per_cu, (const void*)mega, NTHREADS, LDS_BYTES) != hipSuccess || per_cu < 1) { fprintf(stderr, "kernel_launch: occupancy query says %d\n", per_cu); per_cu = 1; }
        (void)hipGetLastError();
        grid = cus * 1;
    }
    if (grid < 0) return;
    (void)hipMemsetAsync((unsigned char*)d_ws + WS_BAR, 0, 32768, stream);
    Ctx a{};
    const float** ap = (const float**)&a;
    for (int i = 0; i < 22; ++i) ap[i] = (const float*)d_in[i];
    a.out = (float*)d_out; a.ws = (unsigned char*)d_ws;
#if N_LAUNCH_MODE == 1
    a.ph_lo = 0; a.ph_hi = 8;
    void* args[] = {&a};
    hipError_t e = hipLaunchCooperativeKernel((const void*)mega, dim3(grid), dim3(NTHREADS), args, LDS_BYTES, stream);
    if (e != hipSuccess) fprintf(stderr, "cooperative launch failed: %s (grid %d)\n", hipGetErrorString(e), grid);
#else
    for (int ph = 0; ph < 8; ++ph) { a.ph_lo = ph; a.ph_hi = ph + 1; hipLaunchKernelGGL(mega, dim3(grid), dim3(NTHREADS), LDS_BYTES, stream, a); }
#endif
}
```
